# Optimizing an MI355X kernel written in HIP

```python
import math
import jax
import jax.numpy as jnp
from jax import lax
import numpy as np

D_MODEL = 1024
BATCH = 8
SEQ = 8192
DEPTH = 1

N_NSA_HEADS = 8
NSA_KV_GROUPS = 2
NSA_HEAD_DIM = 64
CMP_LEN = 32
CMP_STRIDE = 16
CMP_HIDDEN = 256
SLC_BLOCK = 64
SLC_TOP_N = 16
WINDOW = 512
N_MLA_HEADS = 8
MLA_NOPE_DIM = 64
MLA_ROPE_DIM = 32
MLA_V_DIM = 64
MLA_Q_LORA = 256
MLA_KV_LORA = 128
ROPE_THETA = 10000.0
MIX_WIDTH = N_NSA_HEADS * NSA_HEAD_DIM + N_MLA_HEADS * MLA_V_DIM
D_FF = -(-8 * D_MODEL // (3 * 256)) * 256
D_PLE = 256
QBLK = 128
ALPHA = (2 * DEPTH) ** 0.25
BETA = (8 * DEPTH) ** -0.25
LN_EPS = 1e-5
RMS_EPS = 1e-6
NEG_INF = -1e30
FORCE_SCORE = 1e6
NSA_KV_W = NSA_KV_GROUPS * NSA_HEAD_DIM
IN_SPLITS = (N_NSA_HEADS * NSA_HEAD_DIM, NSA_KV_W, NSA_KV_W, NSA_KV_W, NSA_KV_W, NSA_KV_W, NSA_KV_W,
             3 * N_NSA_HEADS, MLA_Q_LORA, MLA_KV_LORA, MLA_ROPE_DIM)
D_IN = sum(IN_SPLITS)

kernel_name = 'hybrid_nsa_mla_deepnorm_block'


def _split_cols(h):
    parts, off = [], 0
    for n in IN_SPLITS:
        parts.append(h[..., off:off + n])
        off += n
    return parts


def _layer_norm(x, g, b):
    xf = x.astype(jnp.float32)
    mu = xf.mean(-1, keepdims=True)
    var = jnp.square(xf - mu).mean(-1, keepdims=True)
    return ((xf - mu) * lax.rsqrt(var + LN_EPS) * g + b).astype(x.dtype)


def _rms_norm(x, g):
    xf = x.astype(jnp.float32)
    return (xf * lax.rsqrt(jnp.square(xf).mean(-1, keepdims=True) + RMS_EPS) * g).astype(x.dtype)


def _rope(x, cos, sin):
    half = x.shape[-1] // 2
    x1 = x[..., :half].astype(jnp.float32)
    x2 = x[..., half:].astype(jnp.float32)
    return jnp.concatenate([x1 * cos - x2 * sin, x2 * cos + x1 * sin], axis=-1).astype(x.dtype)


def _masked_softmax(s, mask):
    p = jax.nn.softmax(jnp.where(mask, s, NEG_INF), axis=-1)
    return jnp.where(mask, p, 0.0)


def _alibi_slopes(n):
    return jnp.exp2(-8.0 * jnp.arange(1, n + 1, dtype=jnp.float32) / n)


def _compress(kv, pos, w1, w2):
    B, T, G, D = kv.shape
    n_sub = T // CMP_STRIDE
    r = CMP_LEN // CMP_STRIDE
    nc = n_sub - r + 1
    sub = kv.reshape(B, n_sub, CMP_STRIDE, G, D)
    blk = jnp.concatenate([sub[:, j:j + nc] for j in range(r)], axis=2) + pos[None, None, :, None, :]
    blk = blk.transpose(0, 1, 3, 2, 4).reshape(B, nc, G, CMP_LEN * D)
    return jax.nn.gelu(blk @ w1) @ w2


def _nsa(q, kc, vc, ks, vs, kw, vw, gate_logits, w_ck1, w_ck2, pos_ck, w_cv1, w_cv2, pos_cv):
    B, T = q.shape[:2]
    G, H, D = NSA_KV_GROUPS, N_NSA_HEADS // NSA_KV_GROUPS, NSA_HEAD_DIM
    f32 = jnp.float32
    q = q.reshape(B, T, G, H, D) * (D ** -0.5)
    k_cmp = _compress(kc.reshape(B, T, G, D), pos_ck, w_ck1, w_ck2)
    v_cmp = _compress(vc.reshape(B, T, G, D), pos_cv, w_cv1, w_cv2)
    nc = k_cmp.shape[1]
    r = CMP_LEN // CMP_STRIDE
    cmp_end = jnp.arange(nc) * CMP_STRIDE + (CMP_LEN - 1)
    nb = T // SLC_BLOCK
    ratio = SLC_BLOCK // CMP_STRIDE
    n_top = min(SLC_TOP_N, nb)
    k_blk = ks.reshape(B, nb, SLC_BLOCK, G, D).transpose(0, 3, 1, 2, 4)
    v_blk = vs.reshape(B, nb, SLC_BLOCK, G, D).transpose(0, 3, 1, 2, 4)
    pad = ((0, 0), (WINDOW, 0), (0, 0), (0, 0))
    k_win = jnp.pad(kw.reshape(B, T, G, D), pad)
    v_win = jnp.pad(vw.reshape(B, T, G, D), pad)
    gates = jax.nn.sigmoid(gate_logits.reshape(B, T, G, H, 3).astype(f32)).astype(q.dtype)
    slopes = _alibi_slopes(N_NSA_HEADS).reshape(G, H)
    b_ix = jnp.arange(B)[:, None, None, None]
    g_ix = jnp.arange(G)[None, None, :, None]
    jb = jnp.arange(nb)

    def block(qb):
        q0 = qb * QBLK
        t = q0 + jnp.arange(QBLK)
        qblk = lax.dynamic_slice_in_dim(q, q0, QBLK, axis=1)
        s = jnp.einsum('bqghd,bcgd->bqghc', qblk, k_cmp).astype(f32)
        dist = (t[:, None] - cmp_end[None, :]).astype(f32)
        bias = -slopes[:, :, None] * dist[:, None, None, :]
        mask = (cmp_end[None, :] <= t[:, None])[:, None, None, :]
        p_cmp = _masked_softmax(s + bias, mask)
        o_cmp = jnp.einsum('bqghc,bcgd->bqghd', p_cmp.astype(v_cmp.dtype), v_cmp)
        cpad = ((0, 0),) * 4
        p_sub = sum(jnp.pad(p_cmp, cpad + ((j, r - 1 - j),)) for j in range(r))
        imp = p_sub.sum(3).reshape(B, QBLK, G, nb, ratio).sum(-1)
        cur = t // SLC_BLOCK
        forced = (jb[None, :] == 0) | (jb[None, :] == cur[:, None]) | (jb[None, :] == cur[:, None] - 1)
        future = jb[None, :] > cur[:, None]
        imp = jnp.where(forced[None, :, None, :], FORCE_SCORE, imp)
        imp = jnp.where(future[None, :, None, :], -1.0, imp)
        _, idx = lax.top_k(imp, n_top)
        k_sel = k_blk[b_ix, g_ix, idx]
        v_sel = v_blk[b_ix, g_ix, idx]
        s_pos = idx[..., None] * SLC_BLOCK + jnp.arange(SLC_BLOCK)
        dist = t[None, :, None, None, None] - s_pos
        s = jnp.einsum('bqghd,bqgnsd->bqghns', qblk, k_sel).astype(f32)
        bias = -slopes[None, None, :, :, None, None] * dist[:, :, :, None].astype(f32)
        mask = (dist >= 0)[:, :, :, None].reshape(B, QBLK, G, 1, n_top * SLC_BLOCK)
        p = _masked_softmax((s + bias).reshape(B, QBLK, G, H, n_top * SLC_BLOCK), mask)
        p = p.reshape(B, QBLK, G, H, n_top, SLC_BLOCK).astype(v_sel.dtype)
        o_slc = jnp.einsum('bqghns,bqgnsd->bqghd', p, v_sel)
        kwb = lax.dynamic_slice_in_dim(k_win, q0, QBLK + WINDOW, axis=1)
        vwb = lax.dynamic_slice_in_dim(v_win, q0, QBLK + WINDOW, axis=1)
        w_pos = q0 - WINDOW + jnp.arange(QBLK + WINDOW)
        dist = t[:, None] - w_pos[None, :]
        mask = ((dist >= 0) & (dist < WINDOW) & (w_pos[None, :] >= 0))[:, None, None, :]
        s = jnp.einsum('bqghd,bkgd->bqghk', qblk, kwb).astype(f32)
        bias = -slopes[:, :, None] * dist[:, None, None, :].astype(f32)
        p = _masked_softmax(s + bias, mask)
        o_win = jnp.einsum('bqghk,bkgd->bqghd', p.astype(vwb.dtype), vwb)
        g = lax.dynamic_slice_in_dim(gates, q0, QBLK, axis=1)
        o = g[..., 0:1] * o_cmp + g[..., 1:2] * o_slc + g[..., 2:3] * o_win
        return o.reshape(B, QBLK, N_NSA_HEADS * D)

    out = lax.map(block, jnp.arange(T // QBLK))
    return out.transpose(1, 0, 2, 3).reshape(B, T, N_NSA_HEADS * D)


def _mla(c_q, c_kv, k_pe, g_qn, w_uq, g_kvn, w_ukv, cos, sin):
    B, T = c_q.shape[:2]
    H = N_MLA_HEADS
    f32 = jnp.float32
    q = (_rms_norm(c_q, g_qn) @ w_uq).reshape(B, T, H, MLA_NOPE_DIM + MLA_ROPE_DIM)
    scale = (MLA_NOPE_DIM + MLA_ROPE_DIM) ** -0.5
    q_nope = q[..., :MLA_NOPE_DIM] * scale
    q_pe = _rope(q[..., MLA_NOPE_DIM:], cos[:, None, :], sin[:, None, :]) * scale
    kv = (_rms_norm(c_kv, g_kvn) @ w_ukv).reshape(B, T, H, MLA_NOPE_DIM + MLA_V_DIM)
    k_nope = kv[..., :MLA_NOPE_DIM]
    v = kv[..., MLA_NOPE_DIM:]
    k_pe = _rope(k_pe, cos, sin)
    kpos = jnp.arange(T)

    def block(qb):
        q0 = qb * QBLK
        t = q0 + jnp.arange(QBLK)
        qn = lax.dynamic_slice_in_dim(q_nope, q0, QBLK, axis=1)
        qr = lax.dynamic_slice_in_dim(q_pe, q0, QBLK, axis=1)
        s = (jnp.einsum('bqhd,bkhd->bhqk', qn, k_nope)
             + jnp.einsum('bqhr,bkr->bhqk', qr, k_pe)).astype(f32)
        p = _masked_softmax(s, (kpos[None, :] <= t[:, None])[None, None])
        o = jnp.einsum('bhqk,bkhd->bqhd', p.astype(v.dtype), v)
        return o.reshape(B, QBLK, H * MLA_V_DIM)

    out = lax.map(block, jnp.arange(T // QBLK))
    return out.transpose(1, 0, 2, 3).reshape(B, T, H * MLA_V_DIM)


def setup_inputs(seed: int = 0) -> dict:
    key = jax.random.key(seed)
    ks = jax.random.split(key, 26)

    def nrm(k, shape, scale):
        return jax.random.normal(k, shape, jnp.float32) * scale

    def gain(k, shape):
        return 1.0 + 0.01 * jax.random.normal(k, shape, jnp.float32)

    L, D, DH = DEPTH, D_MODEL, NSA_HEAD_DIM
    return {
        'x': nrm(ks[0], (BATCH, SEQ, D), 1.0),
        'p': nrm(ks[1], (DEPTH, BATCH, SEQ, D_PLE), 1.0),
        'w_in': nrm(ks[2], (L, D, D_IN), D ** -0.5),
        'w_ck1': nrm(ks[3], (L, CMP_LEN * DH, CMP_HIDDEN), (CMP_LEN * DH) ** -0.5),
        'w_ck2': nrm(ks[4], (L, CMP_HIDDEN, DH), CMP_HIDDEN ** -0.5),
        'pos_ck': nrm(ks[5], (L, CMP_LEN, DH), 0.1),
        'w_cv1': nrm(ks[6], (L, CMP_LEN * DH, CMP_HIDDEN), (CMP_LEN * DH) ** -0.5),
        'w_cv2': nrm(ks[7], (L, CMP_HIDDEN, DH), CMP_HIDDEN ** -0.5),
        'pos_cv': nrm(ks[8], (L, CMP_LEN, DH), 0.1),
        'mla_q_norm': gain(ks[9], (L, MLA_Q_LORA)),
        'w_uq': nrm(ks[10], (L, MLA_Q_LORA, N_MLA_HEADS * (MLA_NOPE_DIM + MLA_ROPE_DIM)), MLA_Q_LORA ** -0.5),
        'mla_kv_norm': gain(ks[11], (L, MLA_KV_LORA)),
        'w_ukv': nrm(ks[12], (L, MLA_KV_LORA, N_MLA_HEADS * (MLA_NOPE_DIM + MLA_V_DIM)), MLA_KV_LORA ** -0.5),
        'w_out': nrm(ks[13], (L, MIX_WIDTH, D), BETA * MIX_WIDTH ** -0.5),
        'ln1_g': gain(ks[14], (L, D)),
        'ln1_b': nrm(ks[15], (L, D), 0.01),
        'w_up': nrm(ks[16], (L, D, 2 * D_FF), D ** -0.5),
        'w_down': nrm(ks[17], (L, D_FF, D), BETA * D_FF ** -0.5),
        'ln2_g': gain(ks[18], (L, D)),
        'ln2_b': nrm(ks[19], (L, D), 0.01),
        'w_ple_gate': nrm(ks[20], (L, D, D), D ** -0.5),
        'w_ple': nrm(ks[21], (L, D_PLE, D), BETA * D_PLE ** -0.5),
        'ln3_g': gain(ks[22], (L, D)),
        'ln3_b': nrm(ks[23], (L, D), 0.01),
    }


def reference(x, p, w_in, w_ck1, w_ck2, pos_ck, w_cv1, w_cv2, pos_cv, mla_q_norm, w_uq,
              mla_kv_norm, w_ukv, w_out, ln1_g, ln1_b, w_up, w_down, ln2_g, ln2_b,
              w_ple_gate, w_ple, ln3_g, ln3_b):
    T = x.shape[1]
    pos = jnp.arange(T, dtype=jnp.float32)
    half = MLA_ROPE_DIM // 2
    inv_freq = ROPE_THETA ** (-jnp.arange(half, dtype=jnp.float32) / half)
    ang = pos[:, None] * inv_freq[None, :]
    cos, sin = jnp.cos(ang), jnp.sin(ang)
    for i in range(DEPTH):
        (nq, kc, vc, ks_, vs_, kw, vw, gl, c_q, c_kv, k_pe) = _split_cols(x @ w_in[i])
        o_nsa = _nsa(nq, kc, vc, ks_, vs_, kw, vw, gl,
                     w_ck1[i], w_ck2[i], pos_ck[i], w_cv1[i], w_cv2[i], pos_cv[i])
        o_mla = _mla(c_q, c_kv, k_pe, mla_q_norm[i], w_uq[i], mla_kv_norm[i], w_ukv[i], cos, sin)
        mix = jnp.concatenate([o_nsa, o_mla], axis=-1) @ w_out[i]
        x = _layer_norm(ALPHA * x + mix, ln1_g[i], ln1_b[i])
        gu = x @ w_up[i]
        ffn = (jax.nn.silu(gu[..., :D_FF]) * gu[..., D_FF:]) @ w_down[i]
        x = _layer_norm(ALPHA * x + ffn, ln2_g[i], ln2_b[i])
        gate = jax.nn.sigmoid((x @ w_ple_gate[i]).astype(jnp.float32)).astype(x.dtype)
        ple = gate * (p[i] @ w_ple[i])
        x = _layer_norm(ALPHA * x + ple, ln3_g[i], ln3_b[i])
    return x
```

```cpp
#include <hip/hip_runtime.h>
#include <hip/hip_cooperative_groups.h>
#include <cstdio>
#include <cstdint>
namespace cg = cooperative_groups;

#define DI __device__ __forceinline__
typedef unsigned short u16;
typedef unsigned long long u64;
typedef __attribute__((ext_vector_type(8))) short bf16x8;
typedef __attribute__((ext_vector_type(4))) short s16x4;
typedef __attribute__((ext_vector_type(4))) float f32x4;
typedef __attribute__((ext_vector_type(16))) float f32x16;
typedef __attribute__((ext_vector_type(2))) __bf16 bf2_t;

constexpr int T_ = 8192;
constexpr int M_ = 65536;
constexpr float ALPHA_ = 1.189207115002721f;
constexpr float LOG2E_ = 1.4426950408889634f;

constexpr size_t AL(size_t x) { return (x + 255) & ~(size_t)255; }
constexpr size_t O_WT_IN   = 0;
constexpr size_t O_WT_UQ   = O_WT_IN   + AL((size_t)1792 * 1024 * 2);
constexpr size_t O_WT_UKV  = O_WT_UQ   + AL((size_t)768 * 256 * 2);
constexpr size_t O_WT_CK1  = O_WT_UKV  + AL((size_t)1024 * 128 * 2);
constexpr size_t O_WT_CV1  = O_WT_CK1  + AL((size_t)256 * 2048 * 2);
constexpr size_t O_WT_CK2  = O_WT_CV1  + AL((size_t)256 * 2048 * 2);
constexpr size_t O_WT_CV2  = O_WT_CK2  + AL((size_t)128 * 256 * 2);
constexpr size_t O_WT_OUT  = O_WT_CV2  + AL((size_t)128 * 256 * 2);
constexpr size_t O_WT_UP   = O_WT_OUT  + AL((size_t)1024 * 1024 * 2);
constexpr size_t O_WT_DOWN = O_WT_UP   + AL((size_t)5632 * 1024 * 2);
constexpr size_t O_WT_GATE = O_WT_DOWN + AL((size_t)1024 * 2816 * 2);
constexpr size_t O_WT_PLE  = O_WT_GATE + AL((size_t)1024 * 1024 * 2);
constexpr size_t O_BIAS1K  = O_WT_PLE  + AL((size_t)1024 * 256 * 2);
constexpr size_t O_BIAS1V  = O_BIAS1K  + AL(256 * 4);
constexpr size_t O_BIAS_UP = O_BIAS1V  + AL(256 * 4);
constexpr size_t O_BIAS_G  = O_BIAS_UP + AL(5632 * 4);
constexpr size_t O_CSUM_UP = O_BIAS_G  + AL(1024 * 4);
constexpr size_t O_CSUM_G  = O_CSUM_UP + AL(5632 * 4);
constexpr size_t O_ROPE_C  = O_CSUM_G  + AL(1024 * 4);
constexpr size_t O_ROPE_S  = O_ROPE_C  + AL((size_t)8192 * 16 * 4);
constexpr size_t O_STATS   = O_ROPE_S  + AL((size_t)8192 * 16 * 4);
constexpr size_t O_SSQ     = O_STATS   + AL((size_t)3 * M_ * 2 * 4);
constexpr size_t O_CTR     = O_SSQ     + AL((size_t)2 * M_ * 4);
constexpr size_t O_BAR     = O_CTR     + 256;
constexpr size_t O_HID     = O_BAR     + 16384;
constexpr size_t O_CMPK    = O_HID     + AL((size_t)2 * 8192 * 256 * 2);
constexpr size_t O_CMPVT   = O_CMPK    + AL((size_t)16 * 512 * 64 * 2);
constexpr size_t O_CONCAT  = O_CMPVT   + AL((size_t)16 * 64 * 512 * 2);
constexpr size_t O_Y2      = O_CONCAT  + AL((size_t)M_ * 1024 * 2);
constexpr size_t O_R1      = O_Y2      + AL((size_t)M_ * 1024 * 4);
constexpr size_t O_QN      = O_R1;
constexpr size_t O_KC      = O_QN   + AL((size_t)M_ * 512 * 2);
constexpr size_t O_VC      = O_KC   + AL((size_t)M_ * 128 * 2);
constexpr size_t O_KS      = O_VC   + AL((size_t)M_ * 128 * 2);
constexpr size_t O_VST     = O_KS   + AL((size_t)M_ * 128 * 2);
constexpr size_t O_KW      = O_VST  + AL((size_t)M_ * 128 * 2);
constexpr size_t O_VWT     = O_KW   + AL((size_t)M_ * 128 * 2);
constexpr size_t O_CQ      = O_VWT  + AL((size_t)M_ * 128 * 2);
constexpr size_t O_CKV     = O_CQ   + AL((size_t)M_ * 256 * 2);
constexpr size_t O_KPE     = O_CKV  + AL((size_t)M_ * 128 * 2);
constexpr size_t O_GATES   = O_KPE  + AL((size_t)M_ * 32 * 2);
constexpr size_t O_QM      = O_GATES + AL((size_t)M_ * 24 * 4);
constexpr size_t O_KN      = O_QM   + AL((size_t)M_ * 768 * 2);
constexpr size_t O_VMT     = O_KN   + AL((size_t)M_ * 512 * 2);
constexpr size_t O_R1_END  = O_VMT  + AL((size_t)M_ * 512 * 2);
constexpr size_t O_HBUF    = O_R1;
constexpr size_t O_PB      = O_R1 + AL((size_t)M_ * 2816 * 2);
static_assert(O_PB + (size_t)M_ * 256 * 2 <= O_R1_END, "PB alias");
static_assert(O_R1_END - O_R1 >= (size_t)M_ * 2816 * 2, "HBUF alias too small");
constexpr size_t O_YB      = O_R1_END;
constexpr size_t WS_NEED   = O_YB + AL((size_t)M_ * 1024 * 2);
static_assert(WS_NEED <= (size_t)1073741824, "workspace budget (4 x largest tensor)");

struct Params {
  const float *x, *p, *w_in, *w_ck1, *w_ck2, *pos_ck, *w_cv1, *w_cv2, *pos_cv, *qn_g, *w_uq, *kvn_g, *w_ukv, *w_out,
      *ln1_g, *ln1_b, *w_up, *w_down, *ln2_g, *ln2_b, *w_pg, *w_ple, *ln3_g, *ln3_b;
  float* out;
  unsigned char* ws;
};

DI unsigned pack2(float a, float b) { bf2_t v; v[0] = (__bf16)a; v[1] = (__bf16)b; return __builtin_bit_cast(unsigned, v); }
DI void store4bf(u16* p, float a, float b, float c, float d) { *(uint2*)p = make_uint2(pack2(a, b), pack2(c, d)); }
DI float bflo(unsigned u) { return __uint_as_float(u << 16); }
DI float bfhi(unsigned u) { return __uint_as_float(u & 0xffff0000u); }
DI float sigmoid_(float x) { return 1.f / (1.f + __expf(-x)); }
DI float gelu_tanh_(float x) {
  float u = 0.7978845608028654f * (x + 0.044715f * x * x * x);
  float e = __expf(2.f * u);
  float th = 1.f - 2.f / (e + 1.f);
  return 0.5f * x * (1.f + th);
}
DI float ex2(float x) { return __builtin_amdgcn_exp2f(x); }
DI float xhalf_max(float t) {
  auto r = __builtin_amdgcn_permlane32_swap(__float_as_uint(t), __float_as_uint(t), false, false);
  return fmaxf(__uint_as_float(r[0]), __uint_as_float(r[1]));
}
#define MFMA16(a, b, c) __builtin_amdgcn_mfma_f32_16x16x32_bf16((a), (b), (c), 0, 0, 0)
#define MFMA32(a, b, c) __builtin_amdgcn_mfma_f32_32x32x16_bf16((a), (b), (c), 0, 0, 0)

DI int map_in(int n) {
  if (n < 1280) return n;
  if (n < 1536) return 1304 + (n - 1280);
  if (n < 1664) return 1560 + (n - 1536);
  if (n < 1696) return 1688 + (n - 1664);
  if (n < 1720) return 1280 + (n - 1696);
  return -1;
}
DI int map_up(int n) {
  int t = n >> 7, c = n & 127, wc = c >> 6, j = (c >> 4) & 3, i = c & 15;
  int base = 64 * t + wc * 32 + (i >> 2) * 8 + (j & 1) * 4 + (i & 3);
  return (j < 2) ? base : 2816 + base;
}

struct TJob { const float* src; u16* dst; const float* scale; int K, Nsrc, map; };
DI TJob get_tjob(const Params& P, int j) {
  TJob t; t.scale = nullptr; t.map = 0;
  unsigned char* ws = P.ws;
  switch (j) {
    case 0: t.src = P.w_in; t.dst = (u16*)(ws + O_WT_IN); t.K = 1024; t.Nsrc = 1720; t.map = 1; break;
    case 1: t.src = P.w_uq; t.dst = (u16*)(ws + O_WT_UQ); t.K = 256; t.Nsrc = 768; t.scale = P.qn_g; break;
    case 2: t.src = P.w_ukv; t.dst = (u16*)(ws + O_WT_UKV); t.K = 128; t.Nsrc = 1024; t.scale = P.kvn_g; break;
    case 3: t.src = P.w_ck1; t.dst = (u16*)(ws + O_WT_CK1); t.K = 2048; t.Nsrc = 256; break;
    case 4: t.src = P.w_cv1; t.dst = (u16*)(ws + O_WT_CV1); t.K = 2048; t.Nsrc = 256; break;
    case 5: t.src = P.w_ck2; t.dst = (u16*)(ws + O_WT_CK2); t.K = 256; t.Nsrc = 64; break;
    case 6: t.src = P.w_cv2; t.dst = (u16*)(ws + O_WT_CV2); t.K = 256; t.Nsrc = 64; break;
    case 7: t.src = P.w_out; t.dst = (u16*)(ws + O_WT_OUT); t.K = 1024; t.Nsrc = 1024; break;
    case 8: t.src = P.w_up; t.dst = (u16*)(ws + O_WT_UP); t.K = 1024; t.Nsrc = 5632; t.map = 2; t.scale = P.ln1_g; break;
    case 9: t.src = P.w_down; t.dst = (u16*)(ws + O_WT_DOWN); t.K = 2816; t.Nsrc = 1024; break;
    case 10: t.src = P.w_pg; t.dst = (u16*)(ws + O_WT_GATE); t.K = 1024; t.Nsrc = 1024; t.scale = P.ln2_g; break;
    default: t.src = P.w_ple; t.dst = (u16*)(ws + O_WT_PLE); t.K = 256; t.Nsrc = 1024; break;
  }
  return t;
}

DI void phase0(const Params& P, unsigned char* smem, int tid) {
  const int NTL[12] = {448, 48, 32, 128, 128, 4, 4, 256, 1408, 704, 256, 64};
  constexpr int TOT_T = 3480;
  constexpr int TOT_U = TOT_T + 1728;
  float* tl = (float*)smem;
  for (int pass = 0; pass < 2; ++pass) {
  if ((pass ^ (int)(blockIdx.x >> 3)) & 1) {
  for (int u = blockIdx.x; u < TOT_U; u += gridDim.x) {
    __syncthreads();
    if (u < TOT_T) {
      int j = 0, ti = u;
#pragma unroll
      for (int q = 0; q < 12; ++q) { if (j == q && ti >= NTL[q]) { ti -= NTL[q]; j = q + 1; } }
      TJob jb = get_tjob(P, j);
      const int nkt = jb.K >> 6;
      const int k0 = (ti % nkt) * 64, n0 = (ti / nkt) * 64;
#pragma unroll
      for (int i = 0; i < 16; ++i) {
        int kk = i * 4 + (tid >> 6), nn = tid & 63;
        int n = n0 + nn;
        int sn = (jb.map == 1) ? map_in(n) : (jb.map == 2 ? map_up(n) : n);
        float v = 0.f;
        if (sn >= 0) v = jb.src[(long)(k0 + kk) * jb.Nsrc + sn];
        if (jb.scale) v *= jb.scale[k0 + kk];
        tl[kk * 65 + nn] = v;
      }
      __syncthreads();
      {
        int n = tid >> 2, kq = tid & 3;
        unsigned w[8];
#pragma unroll
        for (int e = 0; e < 8; ++e) w[e] = pack2(tl[(kq * 16 + 2 * e) * 65 + n], tl[(kq * 16 + 2 * e + 1) * 65 + n]);
        u16* d = jb.dst + (long)(n0 + n) * jb.K + k0 + kq * 16;
        *(uint4*)d = make_uint4(w[0], w[1], w[2], w[3]);
        *(uint4*)(d + 8) = make_uint4(w[4], w[5], w[6], w[7]);
      }
    } else {
      int bu = u - TOT_T;
      const float* vec; const float* W; float* dst; int K, Nsrc, mp = 0;
      if (bu < 32) { vec = P.pos_ck; W = P.w_ck1; dst = (float*)(P.ws + O_BIAS1K); K = 2048; Nsrc = 256; }
      else if (bu < 64) { bu -= 32; vec = P.pos_cv; W = P.w_cv1; dst = (float*)(P.ws + O_BIAS1V); K = 2048; Nsrc = 256; }
      else if (bu < 768) { bu -= 64; vec = P.ln1_b; W = P.w_up; dst = (float*)(P.ws + O_BIAS_UP); K = 1024; Nsrc = 5632; mp = 2; }
      else if (bu < 896) { bu -= 768; vec = P.ln2_b; W = P.w_pg; dst = (float*)(P.ws + O_BIAS_G); K = 1024; Nsrc = 1024; }
      else if (bu < 1600) { bu -= 896; vec = P.ln1_g; W = P.w_up; dst = (float*)(P.ws + O_CSUM_UP); K = 1024; Nsrc = 5632; mp = 2; }
      else { bu -= 1600; vec = P.ln2_g; W = P.w_pg; dst = (float*)(P.ws + O_CSUM_G); K = 1024; Nsrc = 1024; }
      int c = tid & 7, kg = tid >> 3;
      int n = bu * 8 + c;
      int sn = (mp == 2) ? map_up(n) : n;
      float s = 0.f;
#pragma unroll 8
      for (int k = kg; k < K; k += 32) s += vec[k] * W[(long)k * Nsrc + sn];
      tl[kg * 8 + c] = s;
      __syncthreads();
      if (tid < 8) {
        float a = 0.f;
#pragma unroll
        for (int q = 0; q < 32; ++q) a += tl[q * 8 + tid];
        dst[bu * 8 + tid] = a;
      }
    }
  }
  } else {
    const long gtid0 = (long)blockIdx.x * 256 + tid, gstr0 = (long)gridDim.x * 256;
    u16* xb = (u16*)(P.ws + O_CONCAT);
    for (long i = gtid0; i < (long)M_ * 1024 / 8; i += gstr0) {
      const float4 a = *(const float4*)(P.x + i * 8), b = *(const float4*)(P.x + i * 8 + 4);
      *(uint4*)(xb + i * 8) = make_uint4(pack2(a.x, a.y), pack2(a.z, a.w), pack2(b.x, b.y), pack2(b.z, b.w));
    }
  }
  }
  const long gtid = (long)blockIdx.x * 256 + tid, gstr = (long)gridDim.x * 256;
  float* rc = (float*)(P.ws + O_ROPE_C);
  float* rs = (float*)(P.ws + O_ROPE_S);
  for (long i = gtid; i < 8192 * 16; i += gstr) {
    int pos = (int)(i >> 4), f = (int)(i & 15);
    float inv = powf(10000.0f, -(float)f / 16.0f);
    float ang = (float)pos * inv;
    rc[i] = cosf(ang); rs[i] = sinf(ang);
  }
  float* st = (float*)(P.ws + O_STATS);
  for (long i = gtid; i < (long)3 * M_ * 2; i += gstr) st[i] = 0.f;
  { float* sq = (float*)(P.ws + O_SSQ); for (long i = gtid; i < (long)2 * M_; i += gstr) sq[i] = 0.f; }
  if (gtid < 64) ((int*)(P.ws + O_CTR))[gtid] = 0;
}

struct NextTile { const void* A; const u16* Bt; long lda; int m0, n0, K; bool valid; };
constexpr int LDS_BUF = 32768;
constexpr int LDS_RS_OFF = 2 * LDS_BUF;

template <int AMODE, int FAKE = 0>
DI void gemm_mainloop(f32x4 (&acc)[4][4], unsigned char* smem, const void* A, long lda, int m0, int K,
                      const u16* Bt, int n0, const float* stats, bool ns, int tid, bool pre = false, NextTile nx = NextTile{nullptr, nullptr, 0, 0, 0, 0, false}) {
  const int lane = tid & 63, wave = tid >> 6, wm = wave >> 1, wn = wave & 1;
  const int l16 = lane & 15, lq = lane >> 4;
  const int crow = tid >> 3, cch = tid & 7;
  int gtok0 = 0;
  const int nk = K >> 6;
  const int swz = (cch ^ (crow & 7)) * 8;
  const unsigned boff = ((unsigned)(n0 + crow) * (unsigned)K + (unsigned)cch * 8u) * 2u;
  const unsigned bstrb = 64u * (unsigned)K;
  unsigned aoff = 0u; const unsigned astrb = 64u * (unsigned)lda;
  if constexpr (AMODE == 0) aoff = ((unsigned)(m0 + crow) * (unsigned)lda + (unsigned)cch * 8u) * 2u;
  if constexpr (AMODE == 3) { const int r_ = m0 + crow; const int bg_ = r_ >> 9; gtok0 = (r_ & 511) * 16;
    aoff = ((unsigned)(bg_ >> 1) * (unsigned)T_ * 128u + (unsigned)(bg_ & 1) * 64u + (unsigned)cch * 8u) * 2u; }
  const unsigned gch = (unsigned)(cch ^ (crow & 7)) * 16u;
  const unsigned boffd = ((unsigned)(n0 + crow) * (unsigned)K) * 2u + gch;
  unsigned aoffd = 0u;
  if constexpr (AMODE == 0) aoffd = ((unsigned)(m0 + crow) * (unsigned)lda) * 2u + gch;
  if constexpr (AMODE == 3) { const int r_ = m0 + crow; const int bg_ = r_ >> 9;
    aoffd = ((unsigned)(bg_ >> 1) * (unsigned)T_ * 128u + (unsigned)(bg_ & 1) * 64u) * 2u + gch; }
  const int wbase = __builtin_amdgcn_readfirstlane(wave) * 1024;
#define GP(base_, off_) ((const unsigned*)((const char*)(base_) + (unsigned)(off_)))
#define LP(BUF, off_) ((unsigned*)(smem + (BUF) * LDS_BUF + wbase + (off_)))
#define D_LOAD(BUF, ks) { const unsigned qb_ = boffd + (unsigned)(ks) * 128u; \
    __builtin_amdgcn_global_load_lds(GP(Bt, qb_), LP(BUF, 16384), 16, 0, 0); \
    __builtin_amdgcn_global_load_lds(GP(Bt, qb_ + bstrb), LP(BUF, 16384 + 4096), 16, 0, 0); \
    __builtin_amdgcn_global_load_lds(GP(Bt, qb_ + 2u * bstrb), LP(BUF, 16384 + 8192), 16, 0, 0); \
    __builtin_amdgcn_global_load_lds(GP(Bt, qb_ + 3u * bstrb), LP(BUF, 16384 + 12288), 16, 0, 0); \
    if constexpr (AMODE == 0) { const unsigned qa_ = aoffd + (unsigned)(ks) * 128u; \
      __builtin_amdgcn_global_load_lds(GP(A, qa_), LP(BUF, 0), 16, 0, 0); \
      __builtin_amdgcn_global_load_lds(GP(A, qa_ + astrb), LP(BUF, 4096), 16, 0, 0); \
      __builtin_amdgcn_global_load_lds(GP(A, qa_ + 2u * astrb), LP(BUF, 8192), 16, 0, 0); \
      __builtin_amdgcn_global_load_lds(GP(A, qa_ + 3u * astrb), LP(BUF, 12288), 16, 0, 0); } \
    else { \
      __builtin_amdgcn_global_load_lds(GP(A, aoffd + (unsigned)min(gtok0 + (ks), T_ - 1) * 256u), LP(BUF, 0), 16, 0, 0); \
      __builtin_amdgcn_global_load_lds(GP(A, aoffd + (unsigned)min(gtok0 + 512 + (ks), T_ - 1) * 256u), LP(BUF, 4096), 16, 0, 0); \
      __builtin_amdgcn_global_load_lds(GP(A, aoffd + (unsigned)min(gtok0 + 1024 + (ks), T_ - 1) * 256u), LP(BUF, 8192), 16, 0, 0); \
      __builtin_amdgcn_global_load_lds(GP(A, aoffd + (unsigned)min(gtok0 + 1536 + (ks), T_ - 1) * 256u), LP(BUF, 12288), 16, 0, 0); } }
#define D_SYNC() { asm volatile("s_waitcnt vmcnt(0)" ::: "memory"); asm volatile("s_waitcnt lgkmcnt(0)" ::: "memory"); __builtin_amdgcn_s_barrier(); asm volatile("" ::: "memory"); }
#define G_ROW(mi, fa_) \
      if (ns) { acc[mi][0] = MFMA16(fa_, fb0, acc[mi][0]); acc[mi][1] = MFMA16(fa_, fb1, acc[mi][1]); acc[mi][2] = MFMA16(fa_, fb2, acc[mi][2]); acc[mi][3] = MFMA16(fa_, fb3, acc[mi][3]); } \
      else    { acc[mi][0] = MFMA16(fb0, fa_, acc[mi][0]); acc[mi][1] = MFMA16(fb1, fa_, acc[mi][1]); acc[mi][2] = MFMA16(fb2, fa_, acc[mi][2]); acc[mi][3] = MFMA16(fb3, fa_, acc[mi][3]); }
#define G_HALF(BUF, kk) { \
      const int co = (((kk) * 4 + lq) ^ (l16 & 7)) * 8; \
      const u16* pa = (const u16*)(smem + (BUF) * LDS_BUF) + (wm * 64 + l16) * 64 + co; \
      const u16* pb = (const u16*)(smem + (BUF) * LDS_BUF) + 8192 + (wn * 64 + l16) * 64 + co; \
      const bf16x8 fa0 = *(const bf16x8*)pa, fa1 = *(const bf16x8*)(pa + 16 * 64), fa2 = *(const bf16x8*)(pa + 32 * 64), fa3 = *(const bf16x8*)(pa + 48 * 64); \
      const bf16x8 fb0 = *(const bf16x8*)pb, fb1 = *(const bf16x8*)(pb + 16 * 64), fb2 = *(const bf16x8*)(pb + 32 * 64), fb3 = *(const bf16x8*)(pb + 48 * 64); \
      G_ROW(0, fa0) G_ROW(1, fa1) G_ROW(2, fa2) G_ROW(3, fa3) }
#define R_STEP(CUR, ks) { \
    if ((ks) + 1 < nk && FAKE != 1) D_LOAD((CUR) ^ 1, (ks) + 1) \
    __builtin_amdgcn_sched_barrier(0); \
    if (FAKE != 2) { G_HALF(CUR, 0) G_HALF(CUR, 1) } \
    D_SYNC() }
  if (!pre) {
    __syncthreads();
    D_LOAD(0, 0)
  }
  D_SYNC()
  for (int ks = 0; ks < nk; ks += 2) {
    R_STEP(0, ks)
    if (ks + 1 < nk) R_STEP(1, ks + 1)
  }
  if constexpr (AMODE == 0) {
    if (nx.valid && FAKE == 0) {
      const unsigned aoffn = ((unsigned)(nx.m0 + crow) * (unsigned)nx.lda) * 2u + gch;
      const unsigned boffn = ((unsigned)(nx.n0 + crow) * (unsigned)nx.K) * 2u + gch;
      const unsigned astrn = 64u * (unsigned)nx.lda, bstrn = 64u * (unsigned)nx.K;
      __builtin_amdgcn_global_load_lds(GP(nx.Bt, boffn), LP(0, 16384), 16, 0, 0);
      __builtin_amdgcn_global_load_lds(GP(nx.Bt, boffn + bstrn), LP(0, 16384 + 4096), 16, 0, 0);
      __builtin_amdgcn_global_load_lds(GP(nx.Bt, boffn + 2u * bstrn), LP(0, 16384 + 8192), 16, 0, 0);
      __builtin_amdgcn_global_load_lds(GP(nx.Bt, boffn + 3u * bstrn), LP(0, 16384 + 12288), 16, 0, 0);
      __builtin_amdgcn_global_load_lds(GP(nx.A, aoffn), LP(0, 0), 16, 0, 0);
      __builtin_amdgcn_global_load_lds(GP(nx.A, aoffn + astrn), LP(0, 4096), 16, 0, 0);
      __builtin_amdgcn_global_load_lds(GP(nx.A, aoffn + 2u * astrn), LP(0, 8192), 16, 0, 0);
      __builtin_amdgcn_global_load_lds(GP(nx.A, aoffn + 3u * astrn), LP(0, 12288), 16, 0, 0);
    }
  }
#undef GP
#undef LP
#undef D_LOAD
#undef D_SYNC
#undef G_ROW
#undef G_HALF
#undef R_STEP
}

constexpr int LDS_BIG = 24576;
template <int FAKE = 0>
DI void gemm_mainloop_big(f32x4 (&acc)[8][4], unsigned char* smem, const void* A, long lda, int m0, int K,
                          const u16* Bt, int n0, bool ns, int tid, bool pre = false, NextTile nx = NextTile{nullptr, nullptr, 0, 0, 0, 0, false}) {
  const int lane = tid & 63, wave = tid >> 6, wm = wave >> 1, wn = wave & 1;
  const int l16 = lane & 15, lq = lane >> 4;
  const int nk = K >> 5;
  const int prow = lane >> 2, ppos = lane & 3;
  const unsigned gch = (unsigned)(ppos ^ ((4 - ((lane >> 4) & 3)) & 3)) * 16u;
  const unsigned aoffd = ((unsigned)(m0 + 16 * wave + prow) * (unsigned)lda) * 2u + gch;
  const unsigned boffd = ((unsigned)(n0 + 16 * wave + prow) * (unsigned)K) * 2u + gch;
  const unsigned astrb = 128u * (unsigned)lda, bstrb = 128u * (unsigned)K;
  const int wbase = __builtin_amdgcn_readfirstlane(wave) * 1024;
#define GP(base_, off_) ((const unsigned*)((const char*)(base_) + (unsigned)(off_)))
#define LP(BUF, off_) ((unsigned*)(smem + (BUF) * LDS_BIG + wbase + (off_)))
#define D_LOAD(BUF, ks) { const unsigned ko_ = (unsigned)(ks) * 64u; \
    __builtin_amdgcn_global_load_lds(GP(A, aoffd + ko_), LP(BUF, 0), 16, 0, 0); \
    __builtin_amdgcn_global_load_lds(GP(A, aoffd + ko_ + astrb), LP(BUF, 4096), 16, 0, 0); \
    __builtin_amdgcn_global_load_lds(GP(A, aoffd + ko_ + 2u * astrb), LP(BUF, 8192), 16, 0, 0); \
    __builtin_amdgcn_global_load_lds(GP(A, aoffd + ko_ + 3u * astrb), LP(BUF, 12288), 16, 0, 0); \
    __builtin_amdgcn_global_load_lds(GP(Bt, boffd + ko_), LP(BUF, 16384), 16, 0, 0); \
    __builtin_amdgcn_global_load_lds(GP(Bt, boffd + ko_ + bstrb), LP(BUF, 16384 + 4096), 16, 0, 0); }
#define D_SYNC() { asm volatile("s_waitcnt vmcnt(0)" ::: "memory"); asm volatile("s_waitcnt lgkmcnt(0)" ::: "memory"); __builtin_amdgcn_s_barrier(); asm volatile("" ::: "memory"); }
  const int pp = (lq ^ ((4 - ((l16 >> 2) & 3)) & 3)) * 8;
#define B_ROW(mi) { const bf16x8 fa_ = *(const bf16x8*)(pa + (mi) * 16 * 32); \
      if (ns) { acc[mi][0] = MFMA16(fa_, fb0, acc[mi][0]); acc[mi][1] = MFMA16(fa_, fb1, acc[mi][1]); acc[mi][2] = MFMA16(fa_, fb2, acc[mi][2]); acc[mi][3] = MFMA16(fa_, fb3, acc[mi][3]); } \
      else    { acc[mi][0] = MFMA16(fb0, fa_, acc[mi][0]); acc[mi][1] = MFMA16(fb1, fa_, acc[mi][1]); acc[mi][2] = MFMA16(fb2, fa_, acc[mi][2]); acc[mi][3] = MFMA16(fb3, fa_, acc[mi][3]); } }
#define B_COMPUTE(BUF) { \
      const u16* pa = (const u16*)(smem + (BUF) * LDS_BIG) + (wm * 128 + l16) * 32 + pp; \
      const u16* pb = (const u16*)(smem + (BUF) * LDS_BIG + 16384) + (wn * 64 + l16) * 32 + pp; \
      const bf16x8 fb0 = *(const bf16x8*)pb, fb1 = *(const bf16x8*)(pb + 16 * 32), fb2 = *(const bf16x8*)(pb + 32 * 32), fb3 = *(const bf16x8*)(pb + 48 * 32); \
      B_ROW(0) B_ROW(1) B_ROW(2) B_ROW(3) B_ROW(4) B_ROW(5) B_ROW(6) B_ROW(7) }
#define B_STEP(CUR, ks) { \
    if ((ks) + 1 < nk && FAKE != 1) D_LOAD((CUR) ^ 1, (ks) + 1) \
    __builtin_amdgcn_sched_barrier(0); \
    if (FAKE != 2) B_COMPUTE(CUR) \
    D_SYNC() }
  if (!pre) {
    __syncthreads();
    D_LOAD(0, 0)
  }
  D_SYNC()
  for (int ks = 0; ks < nk; ks += 2) {
    B_STEP(0, ks)
    if (ks + 1 < nk) B_STEP(1, ks + 1)
  }
  if (nx.valid && FAKE == 0) {
    const unsigned aoffn = ((unsigned)(nx.m0 + 16 * wave + prow) * (unsigned)nx.lda) * 2u + gch;
    const unsigned boffn = ((unsigned)(nx.n0 + 16 * wave + prow) * (unsigned)nx.K) * 2u + gch;
    const unsigned astrn = 128u * (unsigned)nx.lda, bstrn = 128u * (unsigned)nx.K;
    __builtin_amdgcn_global_load_lds(GP(nx.A, aoffn), LP(0, 0), 16, 0, 0);
    __builtin_amdgcn_global_load_lds(GP(nx.A, aoffn + astrn), LP(0, 4096), 16, 0, 0);
    __builtin_amdgcn_global_load_lds(GP(nx.A, aoffn + 2u * astrn), LP(0, 8192), 16, 0, 0);
    __builtin_amdgcn_global_load_lds(GP(nx.A, aoffn + 3u * astrn), LP(0, 12288), 16, 0, 0);
    __builtin_amdgcn_global_load_lds(GP(nx.Bt, boffn), LP(0, 16384), 16, 0, 0);
    __builtin_amdgcn_global_load_lds(GP(nx.Bt, boffn + bstrn), LP(0, 16384 + 4096), 16, 0, 0);
  }
#undef GP
#undef LP
#undef D_LOAD
#undef D_SYNC
#undef B_ROW
#undef B_COMPUTE
#undef B_STEP
}

template <int MI>
DI void zero_acc(f32x4 (&acc)[MI][4]) {
#pragma unroll
  for (int i = 0; i < MI; ++i)
#pragma unroll
    for (int j = 0; j < 4; ++j) acc[i][j] = f32x4{0.f, 0.f, 0.f, 0.f};
}

DI void stat_push(float* stats, int tok, float s1, float s2, int lq) {
  s1 += __shfl_xor(s1, 16); s2 += __shfl_xor(s2, 16);
  s1 += __shfl_xor(s1, 32); s2 += __shfl_xor(s2, 32);
  if (lq == 0) { atomicAdd(stats + 2 * (long)tok, s1); atomicAdd(stats + 2 * (long)tok + 1, s2); }
}

enum { PH_IN = 1, PH_UQ, PH_UKV, PH_C1, PH_C2, PH_OUT, PH_UP, PH_DOWN, PH_PLE };

template <int PH, int FAKE = 0>
DI void gemm_tile(const Params& P, unsigned char* smem, int mt, int nt, int which, int tid_in, int nmt = 0, int nnt = 0, bool hn = false, bool pre = false) {
  int tid = tid_in;
  asm volatile("" : "+v"(tid));
  unsigned char* ws = P.ws;
  const int lane = tid & 63, wave = tid >> 6, wm = wave >> 1, wn = wave & 1;
  const int l16 = lane & 15, lq = lane >> 4;
  constexpr int MI = (PH == PH_OUT || PH == PH_UP || PH == PH_DOWN || PH == PH_PLE) ? 8 : 4;
  constexpr int WR = MI * 16;
  const int m0 = mt * (2 * WR), n0 = nt * 128;
  f32x4 acc[MI][4];
  zero_acc<MI>(acc);
  float* rsq = (float*)(smem + LDS_RS_OFF);

  if constexpr (PH == PH_IN) {
    const bool ns = (nt == 7 || nt == 9);
    gemm_mainloop<0>(acc, smem, (const u16*)(ws + O_CONCAT), 1024, m0, 1024, (const u16*)(ws + O_WT_IN), n0, nullptr, ns, tid, pre,
                     NextTile{(const void*)(ws + O_CONCAT), (const u16*)(ws + O_WT_IN), 1024, nmt * 128, nnt * 128, 1024, hn});
    const float QSC = 0.125f * LOG2E_;
#pragma unroll
    for (int mi = 0; mi < MI; ++mi) {
      if (!ns) {
        const int tok = m0 + wm * WR + mi * 16 + l16;
        if (nt < 4) {
#pragma unroll
          for (int nj = 0; nj < 4; ++nj) {
            int col = n0 + wn * 64 + nj * 16 + lq * 4;
            f32x4 a = acc[mi][nj];
            store4bf((u16*)(ws + O_QN) + (long)tok * 512 + col, a[0] * QSC, a[1] * QSC, a[2] * QSC, a[3] * QSC);
          }
        } else if (nt == 4 || nt == 5 || nt == 6 || nt == 8 || nt == 12) {
          u16* dst = (u16*)(ws + (nt == 4 ? O_KC : nt == 5 ? O_VC : nt == 6 ? O_KS : nt == 8 ? O_KW : O_CKV));
          float ss = 0.f;
#pragma unroll
          for (int nj = 0; nj < 4; ++nj) {
            int col = wn * 64 + nj * 16 + lq * 4;
            f32x4 a = acc[mi][nj];
            ss += a[0] * a[0] + a[1] * a[1] + a[2] * a[2] + a[3] * a[3];
            store4bf(dst + (long)tok * 128 + col, a[0], a[1], a[2], a[3]);
          }
          if (nt == 12) {
            ss += __shfl_xor(ss, 16); ss += __shfl_xor(ss, 32);
            if (lq == 0) atomicAdd((float*)(ws + O_SSQ) + M_ + tok, ss);
          }
        } else if (nt == 10 || nt == 11) {
          float ss = 0.f;
#pragma unroll
          for (int nj = 0; nj < 4; ++nj) {
            int col = (nt - 10) * 128 + wn * 64 + nj * 16 + lq * 4;
            f32x4 a = acc[mi][nj];
            ss += a[0] * a[0] + a[1] * a[1] + a[2] * a[2] + a[3] * a[3];
            store4bf((u16*)(ws + O_CQ) + (long)tok * 256 + col, a[0], a[1], a[2], a[3]);
          }
          ss += __shfl_xor(ss, 16); ss += __shfl_xor(ss, 32);
          if (lq == 0) atomicAdd((float*)(ws + O_SSQ) + tok, ss);
        } else {
          if (wn == 0) {
            const int pos = tok & (T_ - 1);
            const float4 cs = *(const float4*)((const float*)(ws + O_ROPE_C) + pos * 16 + lq * 4);
            const float4 sn = *(const float4*)((const float*)(ws + O_ROPE_S) + pos * 16 + lq * 4);
            f32x4 x1 = acc[mi][0], x2 = acc[mi][1];
            u16* kp = (u16*)(ws + O_KPE) + (long)tok * 32;
            store4bf(kp + lq * 4, x1[0] * cs.x - x2[0] * sn.x, x1[1] * cs.y - x2[1] * sn.y, x1[2] * cs.z - x2[2] * sn.z, x1[3] * cs.w - x2[3] * sn.w);
            store4bf(kp + 16 + lq * 4, x2[0] * cs.x + x1[0] * sn.x, x2[1] * cs.y + x1[1] * sn.y, x2[2] * cs.z + x1[2] * sn.z, x2[3] * cs.w + x1[3] * sn.w);
            float* gp = (float*)(ws + O_GATES) + (long)tok * 24;
            f32x4 g0 = acc[mi][2], g1 = acc[mi][3];
            *(float4*)(gp + lq * 4) = make_float4(sigmoid_(g0[0]), sigmoid_(g0[1]), sigmoid_(g0[2]), sigmoid_(g0[3]));
            if (lq < 2) *(float4*)(gp + 16 + lq * 4) = make_float4(sigmoid_(g1[0]), sigmoid_(g1[1]), sigmoid_(g1[2]), sigmoid_(g1[3]));
          }
        }
      } else {
        const int tok4 = m0 + wm * WR + mi * 16 + lq * 4;
        const int b = tok4 >> 13, t = tok4 & (T_ - 1);
        u16* dstb = (u16*)(ws + (nt == 7 ? O_VST : O_VWT));
#pragma unroll
        for (int nj = 0; nj < 4; ++nj) {
          int c = wn * 64 + nj * 16 + l16, g = c >> 6, d = c & 63;
          f32x4 a = acc[mi][nj];
          store4bf(dstb + ((long)((b * 2 + g) * 64 + d)) * T_ + t, a[0], a[1], a[2], a[3]);
        }
      }
    }
  }

  if constexpr (PH == PH_UQ || PH == PH_UKV) {
    constexpr int K = (PH == PH_UQ) ? 256 : 128;
    const u16* A = (const u16*)(ws + (PH == PH_UQ ? O_CQ : O_CKV));
    __syncthreads();
    if (tid < 128) {
      const float ss = ((const float*)(ws + O_SSQ))[(PH == PH_UQ ? 0 : M_) + m0 + tid];
      rsq[tid] = rsqrtf(ss * (1.f / K) + 1e-6f);
    }
    if constexpr (PH == PH_UQ) {
      gemm_mainloop<0>(acc, smem, A, 256, m0, 256, (const u16*)(ws + O_WT_UQ), n0, nullptr, false, tid, pre,
                       NextTile{(const void*)A, (const u16*)(ws + O_WT_UQ), 256, nmt * 128, nnt * 128, 256, hn});
      const float SC = 0.10206207261596577f * LOG2E_;
#pragma unroll
      for (int mi = 0; mi < MI; ++mi) {
        const int tok = m0 + wm * WR + mi * 16 + l16;
        const float rs = rsq[wm * WR + mi * 16 + l16] * SC;
        const int pos = tok & (T_ - 1);
        const int ct0 = nt * 8 + wn * 4;
#pragma unroll
        for (int njp = 0; njp < 4; njp += 2) {
          f32x4 a = acc[mi][njp], b2 = acc[mi][njp + 1];
          if (((ct0 + njp) % 6) == 4) {
            const float4 cs = *(const float4*)((const float*)(ws + O_ROPE_C) + pos * 16 + lq * 4);
            const float4 sn = *(const float4*)((const float*)(ws + O_ROPE_S) + pos * 16 + lq * 4);
            f32x4 o1, o2;
            o1[0] = a[0] * cs.x - b2[0] * sn.x; o2[0] = b2[0] * cs.x + a[0] * sn.x;
            o1[1] = a[1] * cs.y - b2[1] * sn.y; o2[1] = b2[1] * cs.y + a[1] * sn.y;
            o1[2] = a[2] * cs.z - b2[2] * sn.z; o2[2] = b2[2] * cs.z + a[2] * sn.z;
            o1[3] = a[3] * cs.w - b2[3] * sn.w; o2[3] = b2[3] * cs.w + a[3] * sn.w;
            a = o1; b2 = o2;
          }
          u16* dst = (u16*)(ws + O_QM) + (long)tok * 768 + n0 + wn * 64 + njp * 16 + lq * 4;
          store4bf(dst, a[0] * rs, a[1] * rs, a[2] * rs, a[3] * rs);
          store4bf(dst + 16, b2[0] * rs, b2[1] * rs, b2[2] * rs, b2[3] * rs);
        }
      }
    } else {
      const bool ns = (wn == 1);
      gemm_mainloop<0>(acc, smem, A, 128, m0, 128, (const u16*)(ws + O_WT_UKV), n0, nullptr, ns, tid, pre,
                       NextTile{(const void*)A, (const u16*)(ws + O_WT_UKV), 128, nmt * 128, nnt * 128, 128, hn});
#pragma unroll
      for (int mi = 0; mi < MI; ++mi) {
        if (!ns) {
          const int tok = m0 + wm * WR + mi * 16 + l16;
          const float rs = rsq[wm * WR + mi * 16 + l16];
#pragma unroll
          for (int nj = 0; nj < 4; ++nj) {
            f32x4 a = acc[mi][nj];
            store4bf((u16*)(ws + O_KN) + (long)tok * 512 + nt * 64 + nj * 16 + lq * 4, a[0] * rs, a[1] * rs, a[2] * rs, a[3] * rs);
          }
        } else {
          const int lr = wm * WR + mi * 16 + lq * 4;
          const int tok4 = m0 + lr;
          const int b = tok4 >> 13, t = tok4 & (T_ - 1);
          const float r0 = rsq[lr], r1 = rsq[lr + 1], r2 = rsq[lr + 2], r3 = rsq[lr + 3];
#pragma unroll
          for (int nj = 0; nj < 4; ++nj) {
            int d = nj * 16 + l16;
            f32x4 a = acc[mi][nj];
            store4bf((u16*)(ws + O_VMT) + ((long)((b * 8 + nt) * 64 + d)) * T_ + t, a[0] * r0, a[1] * r1, a[2] * r2, a[3] * r3);
          }
        }
      }
    }
  }

  if constexpr (PH == PH_C1) {
    const u16* A = (const u16*)(ws + (which ? O_VC : O_KC));
    const u16* Bt = (const u16*)(ws + (which ? O_WT_CV1 : O_WT_CK1));
    const float* bias = (const float*)(ws + (which ? O_BIAS1V : O_BIAS1K));
    gemm_mainloop<3>(acc, smem, A, 128, m0, 2048, Bt, n0, nullptr, false, tid);
    u16* hid = (u16*)(ws + O_HID) + (long)which * 8192 * 256;
#pragma unroll
    for (int mi = 0; mi < MI; ++mi) {
      const int row = m0 + wm * WR + mi * 16 + l16;
#pragma unroll
      for (int nj = 0; nj < 4; ++nj) {
        int col = n0 + wn * 64 + nj * 16 + lq * 4;
        const float4 bb = *(const float4*)(bias + col);
        f32x4 a = acc[mi][nj];
        store4bf(hid + (long)row * 256 + col, gelu_tanh_(a[0] + bb.x), gelu_tanh_(a[1] + bb.y), gelu_tanh_(a[2] + bb.z), gelu_tanh_(a[3] + bb.w));
      }
    }
  }

  if constexpr (PH == PH_C2) {
    const u16* A = (const u16*)(ws + O_HID) + (long)which * 8192 * 256;
    const u16* Bt = (const u16*)(ws + (which ? O_WT_CV2 : O_WT_CK2));
    const bool ns = (which == 1);
    gemm_mainloop<0>(acc, smem, A, 256, m0, 256, Bt, 0, nullptr, ns, tid);
    if (wn == 0) {
#pragma unroll
      for (int mi = 0; mi < MI; ++mi) {
        if (!ns) {
          const int row = m0 + wm * WR + mi * 16 + l16;
#pragma unroll
          for (int nj = 0; nj < 4; ++nj) {
            f32x4 a = acc[mi][nj];
            store4bf((u16*)(ws + O_CMPK) + (long)row * 64 + nj * 16 + lq * 4, a[0], a[1], a[2], a[3]);
          }
        } else {
          const int r4 = m0 + wm * WR + mi * 16 + lq * 4;
          const int bg = r4 >> 9, c = r4 & 511;
#pragma unroll
          for (int nj = 0; nj < 4; ++nj) {
            int d = nj * 16 + l16;
            f32x4 a = acc[mi][nj];
            store4bf((u16*)(ws + O_CMPVT) + ((long)(bg * 64 + d)) * 512 + c, a[0], a[1], a[2], a[3]);
          }
        }
      }
    }
  }

  if constexpr (PH == PH_OUT) {
    gemm_mainloop_big<0>(acc, smem, (const u16*)(ws + O_CONCAT), 1024, m0, 1024, (const u16*)(ws + O_WT_OUT), n0, false, tid, pre,
                         NextTile{(const void*)(ws + O_CONCAT), (const u16*)(ws + O_WT_OUT), 1024, nmt * 256, nnt * 128, 1024, hn});
    float* stats = (float*)(ws + O_STATS);
#pragma unroll
    for (int mi = 0; mi < MI; ++mi) {
      const int tok = m0 + wm * WR + mi * 16 + l16;
      float s1 = 0.f, s2 = 0.f;
#pragma unroll
      for (int nj = 0; nj < 4; ++nj) {
        int col = n0 + wn * 64 + nj * 16 + lq * 4;
        const float4 xv = *(const float4*)(P.x + (long)tok * 1024 + col);
        f32x4 a = acc[mi][nj];
        float4 y = make_float4(ALPHA_ * xv.x + a[0], ALPHA_ * xv.y + a[1], ALPHA_ * xv.z + a[2], ALPHA_ * xv.w + a[3]);
        store4bf((u16*)(ws + O_YB) + (long)tok * 1024 + col, y.x, y.y, y.z, y.w);
        s1 += y.x + y.y + y.z + y.w;
        s2 += y.x * y.x + y.y * y.y + y.z * y.z + y.w * y.w;
      }
      stat_push(stats, tok, s1, s2, lq);
    }
  }

  if constexpr (PH == PH_UP) {
    gemm_mainloop_big<FAKE>(acc, smem, (const u16*)(ws + O_YB), 1024, m0, 1024, (const u16*)(ws + O_WT_UP), n0, false, tid, pre,
                            NextTile{(const void*)(ws + O_YB), (const u16*)(ws + O_WT_UP), 1024, nmt * 256, nnt * 128, 1024, hn});
    if (FAKE != 0 && acc[0][0][0] + acc[3][3][3] + acc[1][2][1] != 123456.75f) return;
    const float* bias = (const float*)(ws + O_BIAS_UP);
    const float* csum = (const float*)(ws + O_CSUM_UP);
    const float* st1 = (const float*)(ws + O_STATS);
#pragma unroll
    for (int mi = 0; mi < MI; ++mi) {
      const int tok = m0 + wm * WR + mi * 16 + l16;
      const float mean = st1[2 * tok] * (1.f / 1024.f);
      const float rstd = rsqrtf(st1[2 * tok + 1] * (1.f / 1024.f) - mean * mean + 1e-5f);
      unsigned hw[4];
#pragma unroll
      for (int nj = 0; nj < 2; ++nj) {
        const int cb = n0 + wn * 64 + nj * 16 + lq * 4;
        const float4 bg = *(const float4*)(bias + cb);
        const float4 bu = *(const float4*)(bias + cb + 32);
        const float4 cg = *(const float4*)(csum + cb);
        const float4 cu = *(const float4*)(csum + cb + 32);
        f32x4 g = acc[mi][nj], u = acc[mi][nj + 2];
        float h0, h1, h2, h3, v;
        v = rstd * (g[0] - mean * cg.x) + bg.x; h0 = v * sigmoid_(v) * (rstd * (u[0] - mean * cu.x) + bu.x);
        v = rstd * (g[1] - mean * cg.y) + bg.y; h1 = v * sigmoid_(v) * (rstd * (u[1] - mean * cu.y) + bu.y);
        v = rstd * (g[2] - mean * cg.z) + bg.z; h2 = v * sigmoid_(v) * (rstd * (u[2] - mean * cu.z) + bu.z);
        v = rstd * (g[3] - mean * cg.w) + bg.w; h3 = v * sigmoid_(v) * (rstd * (u[3] - mean * cu.w) + bu.w);
        hw[2 * nj] = pack2(h0, h1); hw[2 * nj + 1] = pack2(h2, h3);
      }
      *(uint4*)((u16*)(ws + O_HBUF) + (long)tok * 2816 + nt * 64 + wn * 32 + lq * 8) = make_uint4(hw[0], hw[1], hw[2], hw[3]);
    }
  }

  if constexpr (PH == PH_DOWN) {
    gemm_mainloop_big<0>(acc, smem, (const u16*)(ws + O_HBUF), 2816, m0, 2816, (const u16*)(ws + O_WT_DOWN), n0, false, tid, pre,
                         NextTile{(const void*)(ws + O_HBUF), (const u16*)(ws + O_WT_DOWN), 2816, nmt * 256, nnt * 128, 2816, hn});
    const float* st1 = (const float*)(ws + O_STATS);
    float* st2 = (float*)(ws + O_STATS) + (long)M_ * 2;
    u16* yb = (u16*)(ws + O_YB);
#pragma unroll
    for (int mi = 0; mi < MI; ++mi) {
      const int tok = m0 + wm * WR + mi * 16 + l16;
      const float mean = st1[2 * tok] * (1.f / 1024.f);
      const float rstd = rsqrtf(st1[2 * tok + 1] * (1.f / 1024.f) - mean * mean + 1e-5f);
      float s1 = 0.f, s2 = 0.f;
#pragma unroll
      for (int nj = 0; nj < 4; ++nj) {
        int col = n0 + wn * 64 + nj * 16 + lq * 4;
        const uint2 yq = *(const uint2*)(yb + (long)tok * 1024 + col);
        const float4 yv = make_float4(bflo(yq.x), bfhi(yq.x), bflo(yq.y), bfhi(yq.y));
        const float4 gg = *(const float4*)(P.ln1_g + col);
        const float4 bb = *(const float4*)(P.ln1_b + col);
        f32x4 a = acc[mi][nj];
        float4 y;
        y.x = ALPHA_ * ((yv.x - mean) * rstd * gg.x + bb.x) + a[0];
        y.y = ALPHA_ * ((yv.y - mean) * rstd * gg.y + bb.y) + a[1];
        y.z = ALPHA_ * ((yv.z - mean) * rstd * gg.z + bb.z) + a[2];
        y.w = ALPHA_ * ((yv.w - mean) * rstd * gg.w + bb.w) + a[3];
        store4bf(yb + (long)tok * 1024 + col, y.x, y.y, y.z, y.w);
        s1 += y.x + y.y + y.z + y.w;
        s2 += y.x * y.x + y.y * y.y + y.z * y.z + y.w * y.w;
      }
      stat_push(st2, tok, s1, s2, lq);
    }
  }

  if constexpr (PH == PH_PLE) {
    const float* st2 = (const float*)(ws + O_STATS) + (long)M_ * 2;
    float* st3 = (float*)(ws + O_STATS) + (long)M_ * 4;
    u16* yb = (u16*)(ws + O_YB);
    gemm_mainloop_big<0>(acc, smem, (const u16*)(ws + O_YB), 1024, m0, 1024, (const u16*)(ws + O_WT_GATE), n0, false, tid, pre,
                         NextTile{(const void*)(ws + O_PB), (const u16*)(ws + O_WT_PLE), 256, m0, n0, 256, true});
    const float* bias = (const float*)(ws + O_BIAS_G);
    u16* gsp = (u16*)(ws + O_HBUF);
#pragma unroll
    for (int mi = 0; mi < MI; ++mi) {
      const int tok = m0 + wm * WR + mi * 16 + l16;
      const float mean_g = st2[2 * tok] * (1.f / 1024.f);
      const float rstd_g = rsqrtf(st2[2 * tok + 1] * (1.f / 1024.f) - mean_g * mean_g + 1e-5f);
#pragma unroll
      for (int nj = 0; nj < 4; ++nj) {
        int col = n0 + wn * 64 + nj * 16 + lq * 4;
        const float4 bb = *(const float4*)(bias + col);
        const float4 cs = *(const float4*)((const float*)(ws + O_CSUM_G) + col);
        f32x4 a = acc[mi][nj];
        store4bf(gsp + (long)tok * 1024 + col, sigmoid_(rstd_g * (a[0] - mean_g * cs.x) + bb.x), sigmoid_(rstd_g * (a[1] - mean_g * cs.y) + bb.y),
                 sigmoid_(rstd_g * (a[2] - mean_g * cs.z) + bb.z), sigmoid_(rstd_g * (a[3] - mean_g * cs.w) + bb.w));
      }
    }
    zero_acc<MI>(acc);
    gemm_mainloop_big<0>(acc, smem, (const u16*)(ws + O_PB), 256, m0, 256, (const u16*)(ws + O_WT_PLE), n0, false, tid, true,
                         NextTile{(const void*)(ws + O_YB), (const u16*)(ws + O_WT_GATE), 1024, nmt * 256, nnt * 128, 1024, hn});
#pragma unroll
    for (int mi = 0; mi < MI; ++mi) {
      const int tok = m0 + wm * WR + mi * 16 + l16;
      const float mean = st2[2 * tok] * (1.f / 1024.f);
      const float rstd = rsqrtf(st2[2 * tok + 1] * (1.f / 1024.f) - mean * mean + 1e-5f);
      float s1 = 0.f, s2 = 0.f;
#pragma unroll
      for (int nj = 0; nj < 4; ++nj) {
        int col = n0 + wn * 64 + nj * 16 + lq * 4;
        const uint2 yq = *(const uint2*)(yb + (long)tok * 1024 + col);
        const float4 yv = make_float4(bflo(yq.x), bfhi(yq.x), bflo(yq.y), bfhi(yq.y));
        const float4 gg = *(const float4*)(P.ln2_g + col);
        const float4 bb = *(const float4*)(P.ln2_b + col);
        f32x4 a = acc[mi][nj];
        const uint2 gq = *(const uint2*)(gsp + (long)tok * 1024 + col);
        const unsigned g01 = gq.x, g23 = gq.y;
        float4 y;
        y.x = ALPHA_ * ((yv.x - mean) * rstd * gg.x + bb.x) + bflo(g01) * a[0];
        y.y = ALPHA_ * ((yv.y - mean) * rstd * gg.y + bb.y) + bfhi(g01) * a[1];
        y.z = ALPHA_ * ((yv.z - mean) * rstd * gg.z + bb.z) + bflo(g23) * a[2];
        y.w = ALPHA_ * ((yv.w - mean) * rstd * gg.w + bb.w) + bfhi(g23) * a[3];
        store4bf((u16*)(ws + O_CONCAT) + (long)tok * 1024 + col, y.x, y.y, y.z, y.w);
        s1 += y.x + y.y + y.z + y.w;
        s2 += y.x * y.x + y.y * y.y + y.z * y.z + y.w * y.w;
      }
      stat_push(st3, tok, s1, s2, lq);
    }
  }
}

constexpr int LDS_TOTAL = 2 * LDS_BUF + 512;
constexpr int CTL_OFF = 53248;
constexpr int SEL_OFF = CTL_OFF + 1024;
constexpr int IMP_OFF = 35840;
static_assert(IMP_OFF + 32 * 130 * 4 <= CTL_OFF, "lds");
static_assert(SEL_OFF + 512 <= LDS_TOTAL, "lds");

struct AttnSrc { const u16* K; long ldk; const u16* K2; const u16* V; long ldv; };
enum { AM_MLA = 0, AM_WIN = 1, AM_SLC = 2, AM_CMP = 3 };

template <int MODE, int DQ, bool DO_PV, bool FIXED_M, bool DO_IMP, bool USE_LIST, int FK = 0>
DI void attn_loop(unsigned char* smem, const AttnSrc src, int ntiles, int tile_lo, const int* tlist,
                  const bf16x8 (&qf)[DQ / 16], float& m, float& l, f32x16 (&O)[2], int t, float slope2,
                  unsigned sw0, unsigned sw1, unsigned sw2, unsigned sw3, float inv_l, unsigned* imp, int tid_in) {
  int tid = tid_in;
  asm volatile("" : "+v"(tid));
  constexpr int KST = DQ + 8;
  constexpr int KCH = DQ / 8;
  constexpr int NKL = KCH * 64 / 256;
  constexpr int KBYTES = 64 * KST * 2;
  constexpr int VST = 68;
  constexpr int VBYTES = 64 * VST * 2;
  const int lane = tid & 63, l32 = lane & 31, h = lane >> 5;
  u16* sK0 = (u16*)smem;
  u16* sV0 = (u16*)(smem + 2 * KBYTES);
  uint4 rk0, rk1, rk2, rv0, rv1;
  const int kr0 = tid / KCH, kc0 = tid % KCH;
  const int kr1 = (tid + 256) / KCH, kc1 = (tid + 256) % KCH;
  const int kr2 = (tid + 512) / KCH, kc2 = (tid + 512) % KCH;
  const int vr0 = tid >> 3, vc0 = tid & 7;
#define A_KLD(dst_, row_, ch_, tile_) { \
    if constexpr (MODE == AM_MLA) { \
      if ((ch_) < 8) dst_ = *(const uint4*)(src.K + ((long)(tile_) * 64 + (row_)) * src.ldk + (ch_) * 8); \
      else dst_ = *(const uint4*)(src.K2 + ((long)(tile_) * 64 + (row_)) * 32 + ((ch_) - 8) * 8); \
    } else dst_ = *(const uint4*)(src.K + ((long)(tile_) * 64 + (row_)) * src.ldk + (ch_) * 8); }
#define A_GLOAD(tile_) { \
    A_KLD(rk0, kr0, kc0, tile_) A_KLD(rk1, kr1, kc1, tile_) \
    if constexpr (NKL == 3) A_KLD(rk2, kr2, kc2, tile_) \
    if constexpr (DO_PV) { \
      rv0 = *(const uint4*)(src.V + (long)vr0 * src.ldv + (long)(tile_) * 64 + vc0 * 8); \
      rv1 = *(const uint4*)(src.V + (long)(vr0 + 32) * src.ldv + (long)(tile_) * 64 + vc0 * 8); } }
#define A_LSTORE(buf_) { \
    u16* sK_ = sK0 + (buf_) * (KBYTES / 2); u16* sV_ = sV0 + (buf_) * (VBYTES / 2); \
    *(uint4*)(sK_ + kr0 * KST + kc0 * 8) = rk0; *(uint4*)(sK_ + kr1 * KST + kc1 * 8) = rk1; \
    if constexpr (NKL == 3) *(uint4*)(sK_ + kr2 * KST + kc2 * 8) = rk2; \
    if constexpr (DO_PV) { \
      *(uint2*)(sV_ + vr0 * VST + vc0 * 8) = make_uint2(rv0.x, rv0.y); *(uint2*)(sV_ + vr0 * VST + vc0 * 8 + 4) = make_uint2(rv0.z, rv0.w); \
      *(uint2*)(sV_ + (vr0 + 32) * VST + vc0 * 8) = make_uint2(rv1.x, rv1.y); *(uint2*)(sV_ + (vr0 + 32) * VST + vc0 * 8 + 4) = make_uint2(rv1.z, rv1.w); } }
  __syncthreads();
  if (ntiles > 0) { const int tf = USE_LIST ? tlist[0] : tile_lo; A_GLOAD(tf) A_LSTORE(0) }
  __syncthreads();
  for (int it = 0; it < ntiles; ++it) {
    const int tile = USE_LIST ? tlist[it] : tile_lo + it;
    if (it + 1 < ntiles && FK != 1) { const int tn = USE_LIST ? tlist[it + 1] : tile_lo + it + 1; A_GLOAD(tn) }
    __builtin_amdgcn_sched_barrier(0);
    const u16* sK = sK0 + (it & 1) * (KBYTES / 2);
    const u16* sV = sV0 + (it & 1) * (VBYTES / 2);
    f32x16 S[2];
#pragma unroll
    for (int kb = 0; kb < 2; ++kb) {
#pragma unroll
      for (int i = 0; i < 16; ++i) S[kb][i] = 0.f;
#pragma unroll
      for (int s = 0; s < DQ / 16; ++s) {
        bf16x8 kf = *(const bf16x8*)(sK + (kb * 32 + l32) * KST + s * 16 + h * 8);
        S[kb] = MFMA32(kf, qf[s], S[kb]);
      }
    }
    float c0 = 0.f;
    {
      constexpr int MUL = (MODE == AM_CMP) ? 16 : 1;
      int d0;
      if constexpr (MODE == AM_CMP) d0 = t - 31 - 16 * (tile * 64 + 4 * h);
      else d0 = t - tile * 64 - 4 * h;
      bool need = true;
      if constexpr (MODE == AM_MLA) need = (tile * 64 + 63 > t - l32);
      bool selbit = true;
      if constexpr (MODE == AM_SLC) {
        const int w = tile >> 5;
        const unsigned swd = (w == 0) ? sw0 : (w == 1) ? sw1 : (w == 2) ? sw2 : sw3;
        selbit = (swd >> (tile & 31)) & 1u;
      }
      bool full = false;
      if constexpr (MODE != AM_MLA) {
        const int tw = t - l32;
        if constexpr (MODE == AM_CMP) full = ((tile * 64 + 63) * 16 + 31 <= tw);
        if constexpr (MODE == AM_WIN) full = (tile * 64 + 63 <= tw) && (tw + 31 - tile * 64 < 512);
        if constexpr (MODE == AM_SLC) full = (tile * 64 + 63 <= tw) && __all(selbit);
      }
      const float fd0 = (float)d0;
      if constexpr (MODE != AM_MLA) {
#pragma unroll
        for (int kb = 0; kb < 2; ++kb)
#pragma unroll
          for (int i = 0; i < 16; ++i) {
            const float ci = (float)(MUL * ((i & 3) + 8 * (i >> 2) + 32 * kb));
            S[kb][i] = fmaf(slope2, ci, S[kb][i]);
          }
      }
      c0 = (MODE != AM_MLA) ? -slope2 * fd0 : 0.f;
      if (need && !full) {
#pragma unroll
        for (int kb = 0; kb < 2; ++kb)
#pragma unroll
          for (int i = 0; i < 16; ++i) {
            const float ci = (float)(MUL * ((i & 3) + 8 * (i >> 2) + 32 * kb));
            const float dist = fd0 - ci;
            bool valid = dist >= 0.f;
            if constexpr (MODE == AM_WIN) valid = valid && (dist < 512.f);
            if constexpr (MODE == AM_SLC) valid = valid && selbit;
            S[kb][i] = valid ? S[kb][i] : -INFINITY;
          }
      }
    }
    if constexpr (FK != 2) {
    if constexpr (!FIXED_M) {
      float tmax = -INFINITY;
#pragma unroll
      for (int kb = 0; kb < 2; ++kb)
#pragma unroll
        for (int i = 0; i < 16; ++i) tmax = fmaxf(tmax, S[kb][i]);
      tmax += c0;
      tmax = xhalf_max(tmax);
      const bool need = tmax > m + 8.f;
      if (__any(need)) {
        const float mnew = need ? tmax : m;
        const float alpha = ex2(m - mnew);
        m = mnew;
        l *= alpha;
        if constexpr (DO_PV) {
#pragma unroll
          for (int db = 0; db < 2; ++db)
#pragma unroll
            for (int i = 0; i < 16; ++i) O[db][i] *= alpha;
        }
      }
    }
    const float mx = m - c0;
    {
      float ps = 0.f;
#pragma unroll
      for (int kb = 0; kb < 2; ++kb)
#pragma unroll
        for (int i = 0; i < 16; ++i) { float p = ex2(S[kb][i] - mx); S[kb][i] = p; ps += p; }
      l += ps;
    }
    }
    if constexpr (DO_IMP) {
#pragma unroll
      for (int kb = 0; kb < 2; ++kb)
#pragma unroll
        for (int a = 0; a < 4; ++a) {
          const float p0 = S[kb][4 * a] * inv_l, p1 = S[kb][4 * a + 1] * inv_l, p2 = S[kb][4 * a + 2] * inv_l, p3 = S[kb][4 * a + 3] * inv_l;
          const float mainv = 2.f * (p0 + p1 + p2) + p3;
          const int n = tile * 16 + kb * 8 + 2 * a + h;
          atomicAdd(imp + l32 * 130 + n, (unsigned)(mainv * 268435456.f));
          atomicAdd(imp + l32 * 130 + n + 1, (unsigned)(p3 * 268435456.f));
        }
    }
    if (it + 1 < ntiles) { A_LSTORE((it + 1) & 1) }
    if constexpr (DO_PV) {
#pragma unroll
      for (int sp = 0; sp < 4; ++sp) {
        const int kb = sp >> 1, hf = sp & 1;
        unsigned w0 = pack2(S[kb][8 * hf + 0], S[kb][8 * hf + 1]);
        unsigned w1 = pack2(S[kb][8 * hf + 2], S[kb][8 * hf + 3]);
        unsigned w2 = pack2(S[kb][8 * hf + 4], S[kb][8 * hf + 5]);
        unsigned w3 = pack2(S[kb][8 * hf + 6], S[kb][8 * hf + 7]);
        uint4 pw = make_uint4(w0, w1, w2, w3);
        bf16x8 pf = __builtin_bit_cast(bf16x8, pw);
#pragma unroll
        for (int db = 0; db < 2; ++db) {
          const u16* vp = sV + (db * 32 + l32) * VST + 16 * sp + 4 * h;
          s16x4 lo = *(const s16x4*)vp;
          s16x4 hi = *(const s16x4*)(vp + 8);
          bf16x8 vf = __builtin_shufflevector(lo, hi, 0, 1, 2, 3, 4, 5, 6, 7);
          O[db] = MFMA32(vf, pf, O[db]);
        }
      }
    }
    __syncthreads();
  }
  l += __shfl_xor(l, 32);
#undef A_KLD
#undef A_GLOAD
#undef A_LSTORE
}

DI void zero_o(f32x16 (&O)[2]) {
#pragma unroll
  for (int db = 0; db < 2; ++db)
#pragma unroll
    for (int i = 0; i < 16; ++i) O[db][i] = 0.f;
}

template <int FK = 0>
DI void mla_item(const Params& P, unsigned char* smem, int b, int hh, int qt, int tid_in) {
  int tid = tid_in;
  asm volatile("" : "+v"(tid));
  unsigned char* ws = P.ws;
  const int lane = tid & 63, w = tid >> 6, l32 = lane & 31, h = lane >> 5;
  const int t = qt * 128 + w * 32 + l32;
  const long tok = (long)b * T_ + t;
  bf16x8 qf[6];
#pragma unroll
  for (int s = 0; s < 6; ++s) qf[s] = *(const bf16x8*)((const u16*)(ws + O_QM) + tok * 768 + hh * 96 + s * 16 + h * 8);
  float m = -1e30f, l = 0.f;
  f32x16 O[2];
  zero_o(O);
  AttnSrc src;
  src.K = (const u16*)(ws + O_KN) + (long)b * T_ * 512 + hh * 64; src.ldk = 512;
  src.K2 = (const u16*)(ws + O_KPE) + (long)b * T_ * 32;
  src.V = (const u16*)(ws + O_VMT) + ((long)(b * 8 + hh) * 64) * T_; src.ldv = T_;
  attn_loop<AM_MLA, 96, true, false, false, false, FK>(smem, src, 2 * qt + 2, 0, nullptr, qf, m, l, O, t, 0.f, 0, 0, 0, 0, 0.f, nullptr, tid);
  if (FK != 0 && O[0][0] + O[1][5] + l != 123456.75f) return;
  const float lt = l;
  const float inv = lt > 0.f ? 1.f / lt : 0.f;
  u16* dst = (u16*)(ws + O_CONCAT) + tok * 1024 + 512 + hh * 64;
#pragma unroll
  for (int db = 0; db < 2; ++db)
#pragma unroll
    for (int a = 0; a < 4; ++a)
      store4bf(dst + db * 32 + 8 * a + 4 * h, O[db][4 * a] * inv, O[db][4 * a + 1] * inv, O[db][4 * a + 2] * inv, O[db][4 * a + 3] * inv);
}

DI u64 mk_key(int n, unsigned v, int cur) {
  if (n > cur) return 0ull;
  if (n == 0 || n == cur || n == cur - 1) v = 0xFFFFFFFFu;
  return ((u64)v << 8) | (u64)(128 - n);
}

DI void nsa_item(const Params& P, unsigned char* smem, int b, int g, int tt, int tid_in) {
  int tid = tid_in;
  asm volatile("" : "+v"(tid));
  unsigned char* ws = P.ws;
  const int lane = tid & 63, w = tid >> 6, l32 = lane & 31, h = lane >> 5;
  const int t0 = tt * 32;
  const int t = t0 + l32;
  const long tok = (long)b * T_ + t;
  const int head8 = g * 4 + w;
  int* ctl = (int*)(smem + CTL_OFF);
  unsigned* sel = (unsigned*)(smem + SEL_OFF);
  unsigned* imp = (unsigned*)(smem + IMP_OFF);
  bf16x8 qf[4];
#pragma unroll
  for (int s = 0; s < 4; ++s) qf[s] = *(const bf16x8*)((const u16*)(ws + O_QN) + tok * 512 + head8 * 64 + s * 16 + h * 8);
  const float* gp = (const float*)(ws + O_GATES) + tok * 24 + head8 * 3;
  const float g0 = gp[0], g1 = gp[1], g2 = gp[2];
  const float slope2 = LOG2E_ * exp2f(-(float)(head8 + 1));
  __syncthreads();
  for (int i = tid; i < 32 * 130; i += 256) imp[i] = 0u;
  if (tid < 4) ctl[4 + tid] = 0;
  f32x16 O[2];
  float m = -1e30f, l = 0.f;
  float* osp = (float*)(ws + O_Y2) + (long)blockIdx.x * 16384 + tid;
  AttnSrc sc;
  sc.K = (const u16*)(ws + O_CMPK) + ((long)(b * 2 + g) * 512) * 64; sc.ldk = 64; sc.K2 = nullptr;
  sc.V = (const u16*)(ws + O_CMPVT) + ((long)(b * 2 + g) * 64) * 512; sc.ldv = 512;
  const int ntc = (t0 >> 10) + 1;
  attn_loop<AM_CMP, 64, false, false, false, false>(smem, sc, ntc, 0, nullptr, qf, m, l, O, t, slope2, 0, 0, 0, 0, 0.f, nullptr, tid);
  {
    const float lt = l;
    const float inv_l = lt > 0.f ? 1.f / lt : 0.f;
    zero_o(O);
    float l2 = 0.f;
    attn_loop<AM_CMP, 64, true, true, true, false>(smem, sc, ntc, 0, nullptr, qf, m, l2, O, t, slope2, 0, 0, 0, 0, inv_l, imp, tid);
    const float sc0 = g0 * inv_l;
#pragma unroll
    for (int db = 0; db < 2; ++db)
#pragma unroll
      for (int i = 0; i < 16; ++i) osp[(db * 16 + i) * 256] = O[db][i] * sc0;
  }
  for (int tk = 0; tk < 8; ++tk) {
    const int token = w * 8 + tk;
    const int cur = (t0 + token) >> 6;
    const u64 k0 = mk_key(lane, imp[token * 130 + lane], cur);
    const u64 k1 = mk_key(lane + 64, imp[token * 130 + lane + 64], cur);
    u64 thr = 0ull;
    for (int bit = 39; bit >= 0; --bit) {
      const u64 cand = thr | (1ull << bit);
      const int c = __popcll(__ballot(k0 >= cand)) + __popcll(__ballot(k1 >= cand));
      if (c >= 16) thr = cand;
    }
    const u64 m0 = __ballot(k0 >= thr && k0 > 0ull);
    const u64 m1 = __ballot(k1 >= thr && k1 > 0ull);
    if (lane == 0) {
      sel[token * 4 + 0] = (unsigned)m0; sel[token * 4 + 1] = (unsigned)(m0 >> 32);
      sel[token * 4 + 2] = (unsigned)m1; sel[token * 4 + 3] = (unsigned)(m1 >> 32);
      atomicOr((unsigned*)&ctl[4], (unsigned)m0); atomicOr((unsigned*)&ctl[5], (unsigned)(m0 >> 32));
      atomicOr((unsigned*)&ctl[6], (unsigned)m1); atomicOr((unsigned*)&ctl[7], (unsigned)(m1 >> 32));
    }
  }
  __syncthreads();
  if (tid == 0) {
    int c = 0;
    for (int q = 0; q < 4; ++q) {
      unsigned u = (unsigned)ctl[4 + q];
      while (u) { int bp = __ffs(u) - 1; ctl[8 + c] = q * 32 + bp; ++c; u &= u - 1; }
    }
    ctl[1] = c;
  }
  __syncthreads();
  const int nsl = ctl[1];
  const unsigned sw0 = sel[l32 * 4 + 0], sw1 = sel[l32 * 4 + 1], sw2 = sel[l32 * 4 + 2], sw3 = sel[l32 * 4 + 3];
  {
    AttnSrc ss;
    ss.K = (const u16*)(ws + O_KS) + (long)b * T_ * 128 + g * 64; ss.ldk = 128; ss.K2 = nullptr;
    ss.V = (const u16*)(ws + O_VST) + ((long)(b * 2 + g) * 64) * T_; ss.ldv = T_;
    m = -1e30f; l = 0.f; zero_o(O);
    attn_loop<AM_SLC, 64, true, false, false, true>(smem, ss, nsl, 0, ctl + 8, qf, m, l, O, t, slope2, sw0, sw1, sw2, sw3, 0.f, nullptr, tid);
    const float lt = l;
    const float sc1 = lt > 0.f ? g1 / lt : 0.f;
#pragma unroll
    for (int db = 0; db < 2; ++db)
#pragma unroll
      for (int i = 0; i < 16; ++i) osp[8192 + (db * 16 + i) * 256] = O[db][i] * sc1;
  }
  {
    AttnSrc sw;
    sw.K = (const u16*)(ws + O_KW) + (long)b * T_ * 128 + g * 64; sw.ldk = 128; sw.K2 = nullptr;
    sw.V = (const u16*)(ws + O_VWT) + ((long)(b * 2 + g) * 64) * T_; sw.ldv = T_;
    const int lo = (t0 > 511 ? (t0 - 511) : 0) >> 6, hi = (t0 + 31) >> 6;
    m = -1e30f; l = 0.f; zero_o(O);
    attn_loop<AM_WIN, 64, true, false, false, false>(smem, sw, hi - lo + 1, lo, nullptr, qf, m, l, O, t, slope2, 0, 0, 0, 0, 0.f, nullptr, tid);
    const float lt = l;
    const float sc2 = lt > 0.f ? g2 / lt : 0.f;
#pragma unroll
    for (int db = 0; db < 2; ++db)
#pragma unroll
      for (int i = 0; i < 16; ++i) O[db][i] = O[db][i] * sc2 + osp[(db * 16 + i) * 256] + osp[8192 + (db * 16 + i) * 256];
  }
  u16* dst = (u16*)(ws + O_CONCAT) + tok * 1024 + head8 * 64;
#pragma unroll
  for (int db = 0; db < 2; ++db)
#pragma unroll
    for (int a = 0; a < 4; ++a)
      store4bf(dst + db * 32 + 8 * a + 4 * h, O[db][4 * a], O[db][4 * a + 1], O[db][4 * a + 2], O[db][4 * a + 3]);
}

DI void ln_apply_pass(const u16* src, const float* st, u16* dst, int tid, int nb) {
  const int lane = tid & 63;
  for (int row = blockIdx.x * 4 + (tid >> 6); row < M_; row += nb * 4) {
    const float mean = st[2 * row] * (1.f / 1024.f);
    const float rstd = rsqrtf(st[2 * row + 1] * (1.f / 1024.f) - mean * mean + 1e-5f);
    const u16* o = src + (long)row * 1024;
#pragma unroll
    for (int i = 0; i < 2; ++i) {
      const int c = lane * 8 + 512 * i;
      const uint4 v = *(const uint4*)(o + c);
      *(uint4*)(dst + (long)row * 1024 + c) = make_uint4(pack2((bflo(v.x) - mean) * rstd, (bfhi(v.x) - mean) * rstd), pack2((bflo(v.y) - mean) * rstd, (bfhi(v.y) - mean) * rstd),
                                                        pack2((bflo(v.z) - mean) * rstd, (bfhi(v.z) - mean) * rstd), pack2((bflo(v.w) - mean) * rstd, (bfhi(v.w) - mean) * rstd));
    }
  }
}

#ifndef REP
#define REP 0
#endif
#ifndef FAKEV
#define FAKEV 0
#endif
DI void tile_map(int i, int NT, int& mt, int& nt, int mpx = 64) {
  const int xcd = i & 7, j = i >> 3;
  const int ms = j / (8 * NT), r = j - ms * 8 * NT;
  nt = r >> 3;
  mt = xcd * mpx + ms * 8 + (r & 7);
}

template <int PMODE = 0, int FK = 0>
DI void phase4(const Params& P, unsigned char* smem, int tid, int cbase) {
  {
    int* ctr = (int*)(P.ws + O_CTR) + cbase;
    int* ctl = (int*)(smem + CTL_OFF);
    const int xcd = blockIdx.x & 7;
    bool mla_done = false;
    for (;;) {
      __syncthreads();
      if (tid == 0) {
        int it = -1;
        if (!mla_done) { int k = atomicAdd(ctr + xcd, 1); if (k < 512) it = k; }
        if (it < 0) { if (PMODE == 1) it = 8192; else { int j = atomicAdd(ctr + 8, 1); it = (j < 4096) ? 4096 + j : 8192; } }
        ctl[0] = it;
      }
      __syncthreads();
      const int item = ctl[0];
      if (item >= 8192) break;
#ifndef SKIP_MLA
      if (item < 4096) {
        const int qt = 63 - (item & 63), bh = (item >> 6) * 8 + xcd;
        mla_item<FK>(P, smem, bh >> 3, bh & 7, qt, tid);
      }
#endif
      if (item >= 4096) mla_done = true;
#ifndef SKIP_NSA
      if (item >= 4096) {
        const int j = item - 4096;
        const int tt = 255 - (j >> 4), bg = j & 15;
        nsa_item(P, smem, bg >> 1, bg & 1, tt, tid);
      }
#endif
    }
  }
}

#define XB_XCNT(j)  (64 * (j))
#define XB_XSUB(j)  (1024 + 64 * (j))
#define XB_XGEN(j)  (2048 + 64 * (j))
#define XB_TOP      3072
#define XB_TOPGEN   3136
#define XB_WORDS    3200
DI unsigned xb_ld(unsigned* p) { return __hip_atomic_load(p, __ATOMIC_RELAXED, __HIP_MEMORY_SCOPE_AGENT); }
DI unsigned xb_add(unsigned* p, unsigned v) { return __hip_atomic_fetch_add(p, v, __ATOMIC_RELAXED, __HIP_MEMORY_SCOPE_AGENT); }
DI unsigned xb_xcc_id() { return (unsigned)__builtin_amdgcn_s_getreg((3 << 11) | 20) & 0xFu; }
struct XBar { unsigned* bar; unsigned x, nloc, nx; };
DI void gsync(const XBar& b, int tid) {
  asm volatile("s_waitcnt vmcnt(0)" ::: "memory");
  __syncthreads();
  if (tid == 0) {
    unsigned* bar = b.bar;
    __builtin_amdgcn_s_waitcnt(0);
    const unsigned old = xb_add(&bar[XB_XSUB(b.x)], 1u);
    const unsigned gen = old / b.nloc;
    if (old + 1u == (gen + 1u) * b.nloc) {
      __builtin_amdgcn_fence(__ATOMIC_RELEASE, "agent");
      asm volatile("s_waitcnt vmcnt(0)" ::: "memory");
      const unsigned og = xb_add(&bar[XB_TOP], 1u);
      const unsigned tg = og / b.nx;
      if (og + 1u == (tg + 1u) * b.nx) xb_add(&bar[XB_TOPGEN], 1u);
      else while (xb_ld(&bar[XB_TOPGEN]) == tg) __builtin_amdgcn_s_sleep(1);
      __builtin_amdgcn_fence(__ATOMIC_ACQUIRE, "agent");
      xb_add(&bar[XB_XGEN(b.x)], 1u);
      asm volatile("s_waitcnt vmcnt(0)" ::: "memory");
    } else {
      while (xb_ld(&bar[XB_XGEN(b.x)]) == gen) __builtin_amdgcn_s_sleep(1);
      __builtin_amdgcn_fence(__ATOMIC_ACQUIRE, "agent");
      asm volatile("s_waitcnt vmcnt(0)" ::: "memory");
    }
  }
  __syncthreads();
}

__global__ void __launch_bounds__(256, 2) fwd_megakernel(Params P) {
  cg::grid_group grid = cg::this_grid();
  extern __shared__ __attribute__((aligned(16))) unsigned char smem[];
  const int tid = threadIdx.x;
  const int nb = gridDim.x;
  XBar xb; xb.bar = (unsigned*)(P.ws + O_BAR); xb.x = xb_xcc_id(); xb.nloc = 1u; xb.nx = 1u;
  if (tid == 0) (void)xb_add(&xb.bar[XB_XCNT(xb.x)], 1u);

#ifndef SKIP_P0
  phase0(P, smem, tid);
#endif
  if (P.ws == nullptr) grid.sync();
  if (tid == 0) {
    unsigned mine = 0u, cnt = 0u, sum = 0u;
    for (;;) {
      mine = 0u; cnt = 0u; sum = 0u;
#pragma unroll
      for (unsigned j = 0; j < 16; ++j) { const unsigned c = xb_ld(&xb.bar[XB_XCNT(j)]); sum += c; cnt += (c > 0u) ? 1u : 0u; mine = (j == xb.x) ? c : mine; }
      if (sum == gridDim.x) break;
      __builtin_amdgcn_s_sleep(1);
    }
    xb.nloc = mine > 0u ? mine : 1u; xb.nx = cnt > 0u ? cnt : 1u;
  }
  gsync(xb, tid);
#ifndef SKIP_P1
  { bool pre = false; for (int i = blockIdx.x; i < 512 * 14; i += nb) { int mt, nt, mt2 = 0, nt2 = 0; tile_map(i, 14, mt, nt); const bool hn = (i + nb < 512 * 14); if (hn) tile_map(i + nb, 14, mt2, nt2); gemm_tile<PH_IN>(P, smem, mt, nt, 0, tid, mt2, nt2, hn, pre); pre = hn; } }
#if REP == 11
  for (int q = 0; q < 20; ++q) gsync(xb, tid);
#endif
#if REP == 1
  gsync(xb, tid);
  for (int i = blockIdx.x; i < 512 * 14; i += nb) { int mt, nt; tile_map(i, 14, mt, nt); gemm_tile<PH_IN>(P, smem, mt, nt, 0, tid); }
#endif
#endif
  gsync(xb, tid);
#ifndef SKIP_P2
  {
    bool pre = false;
    for (int i = blockIdx.x; i < 256 + 3072 + 4096; i += nb) {
      const int i2 = i + nb;
      if (i < 256) { gemm_tile<PH_C1>(P, smem, (i >> 1) & 63, i & 1, i >> 7, tid); pre = false; }
      else if (i < 256 + 3072) {
        int mt, nt, mt2 = 0, nt2 = 0; tile_map(i - 256, 6, mt, nt);
        const bool hn = (i2 < 256 + 3072); if (hn) tile_map(i2 - 256, 6, mt2, nt2);
        gemm_tile<PH_UQ>(P, smem, mt, nt, 0, tid, mt2, nt2, hn, pre); pre = hn;
      } else {
        int mt, nt, mt2 = 0, nt2 = 0; tile_map(i - 256 - 3072, 8, mt, nt);
        const bool hn = (i2 < 256 + 3072 + 4096); if (hn) tile_map(i2 - 256 - 3072, 8, mt2, nt2);
        gemm_tile<PH_UKV>(P, smem, mt, nt, 0, tid, mt2, nt2, hn, pre); pre = hn;
      }
    }
  }
#endif
#if REP == 2
  gsync(xb, tid);
  for (int i = blockIdx.x; i < 256 + 3072 + 4096; i += nb) {
    if (i < 256) gemm_tile<PH_C1>(P, smem, (i >> 1) & 63, i & 1, i >> 7, tid);
    else if (i < 256 + 3072) { int mt, nt; tile_map(i - 256, 6, mt, nt); gemm_tile<PH_UQ>(P, smem, mt, nt, 0, tid); }
    else { int mt, nt; tile_map(i - 256 - 3072, 8, mt, nt); gemm_tile<PH_UKV>(P, smem, mt, nt, 0, tid); }
  }
#endif
  gsync(xb, tid);
#ifndef SKIP_P3
  for (int i = blockIdx.x; i < 128; i += nb) gemm_tile<PH_C2>(P, smem, i & 63, 0, i >> 6, tid);
#endif
  gsync(xb, tid);
  phase4(P, smem, tid, 0);
#if REP == 4
  gsync(xb, tid);
  phase4<0, 0>(P, smem, tid, 16);
#endif
#if REP == 41
  gsync(xb, tid);
  phase4<1, FAKEV>(P, smem, tid, 16);
#endif
  gsync(xb, tid);
  {
    u16* pb = (u16*)(P.ws + O_PB);
    for (long i = (long)blockIdx.x * 256 + tid; i < (long)M_ * 256 / 8; i += (long)nb * 256) {
      const float4 a = *(const float4*)(P.p + i * 8), b = *(const float4*)(P.p + i * 8 + 4);
      *(uint4*)(pb + i * 8) = make_uint4(pack2(a.x, a.y), pack2(a.z, a.w), pack2(b.x, b.y), pack2(b.z, b.w));
    }
  }
#ifndef SKIP_P5
  { bool pre = false; for (int i = blockIdx.x; i < 256 * 8; i += nb) { int mt, nt, mt2 = 0, nt2 = 0; tile_map(i, 8, mt, nt, 32); const bool hn = (i + nb < 256 * 8); if (hn) tile_map(i + nb, 8, mt2, nt2, 32); gemm_tile<PH_OUT>(P, smem, mt, nt, 0, tid, mt2, nt2, hn, pre); pre = hn; } }
#endif
  gsync(xb, tid);
#ifndef SKIP_P6
  { bool pre = false; for (int i = blockIdx.x; i < 256 * 44; i += nb) { int mt, nt, mt2 = 0, nt2 = 0; tile_map(i, 44, mt, nt, 32); const bool hn = (i + nb < 256 * 44); if (hn) tile_map(i + nb, 44, mt2, nt2, 32); gemm_tile<PH_UP>(P, smem, mt, nt, 0, tid, mt2, nt2, hn, pre); pre = hn; } }
#if REP == 6
  gsync(xb, tid);
  for (int i = blockIdx.x; i < 256 * 44; i += nb) { int mt, nt; tile_map(i, 44, mt, nt, 32); gemm_tile<PH_UP, FAKEV>(P, smem, mt, nt, 0, tid); }
#endif
#endif
  gsync(xb, tid);
#ifndef SKIP_P7
  { bool pre = false; for (int i = blockIdx.x; i < 256 * 8; i += nb) { int mt, nt, mt2 = 0, nt2 = 0; tile_map(i, 8, mt, nt, 32); const bool hn = (i + nb < 256 * 8); if (hn) tile_map(i + nb, 8, mt2, nt2, 32); gemm_tile<PH_DOWN>(P, smem, mt, nt, 0, tid, mt2, nt2, hn, pre); pre = hn; } }
#endif
  gsync(xb, tid);
#ifndef SKIP_P8
  { bool pre = false; for (int i = blockIdx.x; i < 256 * 8; i += nb) { int mt, nt, mt2 = 0, nt2 = 0; tile_map(i, 8, mt, nt, 32); const bool hn = (i + nb < 256 * 8); if (hn) tile_map(i + nb, 8, mt2, nt2, 32); gemm_tile<PH_PLE>(P, smem, mt, nt, 0, tid, mt2, nt2, hn, pre); pre = hn; } }
#endif
  gsync(xb, tid);
  {
    const float* st3 = (const float*)(P.ws + O_STATS) + (long)M_ * 4;
    const int lane = tid & 63;
    for (int row = blockIdx.x * 4 + (tid >> 6); row < M_; row += nb * 4) {
      const float mean = st3[2 * row] * (1.f / 1024.f);
      const float rstd = rsqrtf(st3[2 * row + 1] * (1.f / 1024.f) - mean * mean + 1e-5f);
      float* o = P.out + (long)row * 1024;
      const u16* yb = (const u16*)(P.ws + O_CONCAT) + (long)row * 1024;
#pragma unroll
      for (int i = 0; i < 4; ++i) {
        const int c = lane * 4 + 256 * i;
        const uint2 yq = *(const uint2*)(yb + c);
        float4 v = make_float4(bflo(yq.x), bfhi(yq.x), bflo(yq.y), bfhi(yq.y));
        const float4 gg = *(const float4*)(P.ln3_g + c);
        const float4 bb = *(const float4*)(P.ln3_b + c);
        v.x = (v.x - mean) * rstd * gg.x + bb.x;
        v.y = (v.y - mean) * rstd * gg.y + bb.y;
        v.z = (v.z - mean) * rstd * gg.z + bb.z;
        v.w = (v.w - mean) * rstd * gg.w + bb.w;
        *(float4*)(o + c) = v;
      }
    }
  }
}

extern "C" void kernel_launch(void* const* d_in, const int* in_sizes, int n_in,
                              void* d_out, int out_size, void* d_ws, size_t ws_size,
                              hipStream_t stream) {
  static int grid_blocks = 0;
  if (!grid_blocks) {
    int dev = 0, cus = 0, per_cu = 0;
    (void)hipGetDevice(&dev);
    (void)hipDeviceGetAttribute(&cus, hipDeviceAttributeMultiprocessorCount, dev);
    (void)hipFuncSetAttribute((const void*)fwd_megakernel, hipFuncAttributeMaxDynamicSharedMemorySize, LDS_TOTAL);
    (void)hipOccupancyMaxActiveBlocksPerMultiprocessor(&per_cu, fwd_megakernel, 256, LDS_TOTAL);
    if (per_cu < 1) per_cu = 1;
    if (per_cu > 2) per_cu = 2;
    grid_blocks = cus * per_cu;
    fprintf(stderr, "grid_blocks=%d (cus=%d per_cu=%d) ws_need=%zu ws_size=%zu\n", grid_blocks, cus, per_cu, (size_t)WS_NEED, ws_size);
  }
  if (ws_size < WS_NEED || n_in < 24) { fprintf(stderr, "kernel_launch: workspace too small or bad inputs\n"); return; }
  (void)hipMemsetAsync((unsigned char*)d_ws + O_BAR, 0, 16384, stream);
  Params p{};
  const float** pp = (const float**)&p;
  for (int i = 0; i < 24; ++i) pp[i] = (const float*)d_in[i];
  p.out = (float*)d_out;
  p.ws = (unsigned char*)d_ws;
  void* args[] = {&p};
  hipError_t e = hipLaunchCooperativeKernel((void*)fwd_megakernel, dim3(grid_blocks), dim3(256), args, LDS_TOTAL, stream);
  if (e != hipSuccess) fprintf(stderr, "cooperative launch failed: %s (grid %d)\n", hipGetErrorString(e), grid_blocks);
}
```

```cpp
#include <hip/hip_runtime.h>
#include <hip/hip_cooperative_groups.h>
#include <cstdio>
#include <cstdint>
namespace cg = cooperative_groups;

#define DI __device__ __forceinline__
typedef unsigned short u16;
typedef unsigned long long u64;
typedef __attribute__((ext_vector_type(8))) short bf16x8;
typedef __attribute__((ext_vector_type(4))) short s16x4;
typedef __attribute__((ext_vector_type(4))) float f32x4;
typedef __attribute__((ext_vector_type(16))) float f32x16;
typedef __attribute__((ext_vector_type(2))) __bf16 bf2_t;

constexpr int T_ = 8192;
constexpr int M_ = 65536;
constexpr float ALPHA_ = 1.189207115002721f;
constexpr float LOG2E_ = 1.4426950408889634f;

constexpr size_t AL(size_t x) { return (x + 255) & ~(size_t)255; }
constexpr size_t O_WT_IN   = 0;
constexpr size_t O_WT_UQ   = O_WT_IN   + AL((size_t)1792 * 1024 * 2);
constexpr size_t O_WT_UKV  = O_WT_UQ   + AL((size_t)768 * 256 * 2);
constexpr size_t O_WT_CK1  = O_WT_UKV  + AL((size_t)1024 * 128 * 2);
constexpr size_t O_WT_CV1  = O_WT_CK1  + AL((size_t)256 * 2048 * 2);
constexpr size_t O_WT_CK2  = O_WT_CV1  + AL((size_t)256 * 2048 * 2);
constexpr size_t O_WT_CV2  = O_WT_CK2  + AL((size_t)128 * 256 * 2);
constexpr size_t O_WT_OUT  = O_WT_CV2  + AL((size_t)128 * 256 * 2);
constexpr size_t O_WT_UP   = O_WT_OUT  + AL((size_t)1024 * 1024 * 2);
constexpr size_t O_WT_DOWN = O_WT_UP   + AL((size_t)5632 * 1024 * 2);
constexpr size_t O_WT_GATE = O_WT_DOWN + AL((size_t)1024 * 2816 * 2);
constexpr size_t O_WT_PLE  = O_WT_GATE + AL((size_t)1024 * 1024 * 2);
constexpr size_t O_BIAS1K  = O_WT_PLE  + AL((size_t)1024 * 256 * 2);
constexpr size_t O_BIAS1V  = O_BIAS1K  + AL(256 * 4);
constexpr size_t O_BIAS_UP = O_BIAS1V  + AL(256 * 4);
constexpr size_t O_BIAS_G  = O_BIAS_UP + AL(5632 * 4);
constexpr size_t O_CSUM_UP = O_BIAS_G  + AL(1024 * 4);
constexpr size_t O_CSUM_G  = O_CSUM_UP + AL(5632 * 4);
constexpr size_t O_ROPE_C  = O_CSUM_G  + AL(1024 * 4);
constexpr size_t O_ROPE_S  = O_ROPE_C  + AL((size_t)8192 * 16 * 4);
constexpr size_t O_STATS   = O_ROPE_S  + AL((size_t)8192 * 16 * 4);
constexpr size_t O_SSQ     = O_STATS   + AL((size_t)3 * M_ * 2 * 4);
constexpr size_t O_CTR     = O_SSQ     + AL((size_t)2 * M_ * 4);
constexpr size_t O_BAR     = O_CTR     + 256;
constexpr size_t O_HID     = O_BAR     + 16384;
constexpr size_t O_CMPK    = O_HID     + AL((size_t)2 * 8192 * 256 * 2);
constexpr size_t O_CMPVT   = O_CMPK    + AL((size_t)16 * 512 * 64 * 2);
constexpr size_t O_CONCAT  = O_CMPVT   + AL((size_t)16 * 64 * 512 * 2);
constexpr size_t O_Y2      = O_CONCAT  + AL((size_t)M_ * 1024 * 2);
constexpr size_t O_R1      = O_Y2      + AL((size_t)M_ * 1024 * 4);
constexpr size_t O_QN      = O_R1;
constexpr size_t O_KC      = O_QN   + AL((size_t)M_ * 512 * 2);
constexpr size_t O_VC      = O_KC   + AL((size_t)M_ * 128 * 2);
constexpr size_t O_KS      = O_VC   + AL((size_t)M_ * 128 * 2);
constexpr size_t O_VST     = O_KS   + AL((size_t)M_ * 128 * 2);
constexpr size_t O_KW      = O_VST  + AL((size_t)M_ * 128 * 2);
constexpr size_t O_VWT     = O_KW   + AL((size_t)M_ * 128 * 2);
constexpr size_t O_CQ      = O_VWT  + AL((size_t)M_ * 128 * 2);
constexpr size_t O_CKV     = O_CQ   + AL((size_t)M_ * 256 * 2);
constexpr size_t O_KPE     = O_CKV  + AL((size_t)M_ * 128 * 2);
constexpr size_t O_GATES   = O_KPE  + AL((size_t)M_ * 32 * 2);
constexpr size_t O_QM      = O_GATES + AL((size_t)M_ * 24 * 4);
constexpr size_t O_KN      = O_QM   + AL((size_t)M_ * 768 * 2);
constexpr size_t O_VMT     = O_KN   + AL((size_t)M_ * 512 * 2);
constexpr size_t O_R1_END  = O_VMT  + AL((size_t)M_ * 512 * 2);
constexpr size_t O_HBUF    = O_R1;
constexpr size_t O_PB      = O_R1 + AL((size_t)M_ * 2816 * 2);
static_assert(O_PB + (size_t)M_ * 256 * 2 <= O_R1_END, "PB alias");
static_assert(O_R1_END - O_R1 >= (size_t)M_ * 2816 * 2, "HBUF alias too small");
constexpr size_t O_YB      = O_R1_END;
constexpr size_t WS_NEED   = O_YB + AL((size_t)M_ * 1024 * 2);
static_assert(WS_NEED <= (size_t)1073741824, "workspace budget (4 x largest tensor)");

struct Params {
  const float *x, *p, *w_in, *w_ck1, *w_ck2, *pos_ck, *w_cv1, *w_cv2, *pos_cv, *qn_g, *w_uq, *kvn_g, *w_ukv, *w_out,
      *ln1_g, *ln1_b, *w_up, *w_down, *ln2_g, *ln2_b, *w_pg, *w_ple, *ln3_g, *ln3_b;
  float* out;
  unsigned char* ws;
};

DI unsigned pack2(float a, float b) { bf2_t v; v[0] = (__bf16)a; v[1] = (__bf16)b; return __builtin_bit_cast(unsigned, v); }
DI void store4bf(u16* p, float a, float b, float c, float d) { *(uint2*)p = make_uint2(pack2(a, b), pack2(c, d)); }
DI float bflo(unsigned u) { return __uint_as_float(u << 16); }
DI float bfhi(unsigned u) { return __uint_as_float(u & 0xffff0000u); }
DI float sigmoid_(float x) { return 1.f / (1.f + __expf(-x)); }
DI float gelu_tanh_(float x) {
  float u = 0.7978845608028654f * (x + 0.044715f * x * x * x);
  float e = __expf(2.f * u);
  float th = 1.f - 2.f / (e + 1.f);
  return 0.5f * x * (1.f + th);
}
DI float ex2(float x) { return __builtin_amdgcn_exp2f(x); }
#define MFMA16(a, b, c) __builtin_amdgcn_mfma_f32_16x16x32_bf16((a), (b), (c), 0, 0, 0)
#define MFMA32(a, b, c) __builtin_amdgcn_mfma_f32_32x32x16_bf16((a), (b), (c), 0, 0, 0)

DI int map_in(int n) {
  if (n < 1280) return n;
  if (n < 1536) return 1304 + (n - 1280);
  if (n < 1664) return 1560 + (n - 1536);
  if (n < 1696) return 1688 + (n - 1664);
  if (n < 1720) return 1280 + (n - 1696);
  return -1;
}
DI int map_up(int n) {
  int t = n >> 7, c = n & 127, wc = c >> 6, j = (c >> 4) & 3, i = c & 15;
  int base = 64 * t + wc * 32 + (i >> 2) * 8 + (j & 1) * 4 + (i & 3);
  return (j < 2) ? base : 2816 + base;
}

struct TJob { const float* src; u16* dst; const float* scale; int K, Nsrc, map; };
DI TJob get_tjob(const Params& P, int j) {
  TJob t; t.scale = nullptr; t.map = 0;
  unsigned char* ws = P.ws;
  switch (j) {
    case 0: t.src = P.w_in; t.dst = (u16*)(ws + O_WT_IN); t.K = 1024; t.Nsrc = 1720; t.map = 1; break;
    case 1: t.src = P.w_uq; t.dst = (u16*)(ws + O_WT_UQ); t.K = 256; t.Nsrc = 768; t.scale = P.qn_g; break;
    case 2: t.src = P.w_ukv; t.dst = (u16*)(ws + O_WT_UKV); t.K = 128; t.Nsrc = 1024; t.scale = P.kvn_g; break;
    case 3: t.src = P.w_ck1; t.dst = (u16*)(ws + O_WT_CK1); t.K = 2048; t.Nsrc = 256; break;
    case 4: t.src = P.w_cv1; t.dst = (u16*)(ws + O_WT_CV1); t.K = 2048; t.Nsrc = 256; break;
    case 5: t.src = P.w_ck2; t.dst = (u16*)(ws + O_WT_CK2); t.K = 256; t.Nsrc = 64; break;
    case 6: t.src = P.w_cv2; t.dst = (u16*)(ws + O_WT_CV2); t.K = 256; t.Nsrc = 64; break;
    case 7: t.src = P.w_out; t.dst = (u16*)(ws + O_WT_OUT); t.K = 1024; t.Nsrc = 1024; break;
    case 8: t.src = P.w_up; t.dst = (u16*)(ws + O_WT_UP); t.K = 1024; t.Nsrc = 5632; t.map = 2; t.scale = P.ln1_g; break;
    case 9: t.src = P.w_down; t.dst = (u16*)(ws + O_WT_DOWN); t.K = 2816; t.Nsrc = 1024; break;
    case 10: t.src = P.w_pg; t.dst = (u16*)(ws + O_WT_GATE); t.K = 1024; t.Nsrc = 1024; t.scale = P.ln2_g; break;
    default: t.src = P.w_ple; t.dst = (u16*)(ws + O_WT_PLE); t.K = 256; t.Nsrc = 1024; break;
  }
  return t;
}

DI void phase0(const Params& P, unsigned char* smem, int tid) {
  const int NTL[12] = {448, 48, 32, 128, 128, 4, 4, 256, 1408, 704, 256, 64};
  constexpr int TOT_T = 3480;
  constexpr int TOT_U = TOT_T + 1728;
  float* tl = (float*)smem;
  for (int pass = 0; pass < 2; ++pass) {
  if ((pass ^ (int)(blockIdx.x >> 3)) & 1) {
  for (int u = blockIdx.x; u < TOT_U; u += gridDim.x) {
    __syncthreads();
    if (u < TOT_T) {
      int j = 0, ti = u;
#pragma unroll
      for (int q = 0; q < 12; ++q) { if (j == q && ti >= NTL[q]) { ti -= NTL[q]; j = q + 1; } }
      TJob jb = get_tjob(P, j);
      const int nkt = jb.K >> 6;
      const int k0 = (ti % nkt) * 64, n0 = (ti / nkt) * 64;
#pragma unroll
      for (int i = 0; i < 16; ++i) {
        int kk = i * 4 + (tid >> 6), nn = tid & 63;
        int n = n0 + nn;
        int sn = (jb.map == 1) ? map_in(n) : (jb.map == 2 ? map_up(n) : n);
        float v = 0.f;
        if (sn >= 0) v = jb.src[(long)(k0 + kk) * jb.Nsrc + sn];
        if (jb.scale) v *= jb.scale[k0 + kk];
        tl[kk * 65 + nn] = v;
      }
      __syncthreads();
      {
        int n = tid >> 2, kq = tid & 3;
        unsigned w[8];
#pragma unroll
        for (int e = 0; e < 8; ++e) w[e] = pack2(tl[(kq * 16 + 2 * e) * 65 + n], tl[(kq * 16 + 2 * e + 1) * 65 + n]);
        u16* d = jb.dst + (long)(n0 + n) * jb.K + k0 + kq * 16;
        *(uint4*)d = make_uint4(w[0], w[1], w[2], w[3]);
        *(uint4*)(d + 8) = make_uint4(w[4], w[5], w[6], w[7]);
      }
    } else {
      int bu = u - TOT_T;
      const float* vec; const float* W; float* dst; int K, Nsrc, mp = 0;
      if (bu < 32) { vec = P.pos_ck; W = P.w_ck1; dst = (float*)(P.ws + O_BIAS1K); K = 2048; Nsrc = 256; }
      else if (bu < 64) { bu -= 32; vec = P.pos_cv; W = P.w_cv1; dst = (float*)(P.ws + O_BIAS1V); K = 2048; Nsrc = 256; }
      else if (bu < 768) { bu -= 64; vec = P.ln1_b; W = P.w_up; dst = (float*)(P.ws + O_BIAS_UP); K = 1024; Nsrc = 5632; mp = 2; }
      else if (bu < 896) { bu -= 768; vec = P.ln2_b; W = P.w_pg; dst = (float*)(P.ws + O_BIAS_G); K = 1024; Nsrc = 1024; }
      else if (bu < 1600) { bu -= 896; vec = P.ln1_g; W = P.w_up; dst = (float*)(P.ws + O_CSUM_UP); K = 1024; Nsrc = 5632; mp = 2; }
      else { bu -= 1600; vec = P.ln2_g; W = P.w_pg; dst = (float*)(P.ws + O_CSUM_G); K = 1024; Nsrc = 1024; }
      int c = tid & 7, kg = tid >> 3;
      int n = bu * 8 + c;
      int sn = (mp == 2) ? map_up(n) : n;
      float s = 0.f;
#pragma unroll 8
      for (int k = kg; k < K; k += 32) s += vec[k] * W[(long)k * Nsrc + sn];
      tl[kg * 8 + c] = s;
      __syncthreads();
      if (tid < 8) {
        float a = 0.f;
#pragma unroll
        for (int q = 0; q < 32; ++q) a += tl[q * 8 + tid];
        dst[bu * 8 + tid] = a;
      }
    }
  }
  } else {
    const long gtid0 = (long)blockIdx.x * 256 + tid, gstr0 = (long)gridDim.x * 256;
    u16* xb = (u16*)(P.ws + O_CONCAT);
    for (long i = gtid0; i < (long)M_ * 1024 / 8; i += gstr0) {
      const float4 a = *(const float4*)(P.x + i * 8), b = *(const float4*)(P.x + i * 8 + 4);
      *(uint4*)(xb + i * 8) = make_uint4(pack2(a.x, a.y), pack2(a.z, a.w), pack2(b.x, b.y), pack2(b.z, b.w));
    }
  }
  }
  const long gtid = (long)blockIdx.x * 256 + tid, gstr = (long)gridDim.x * 256;
  float* rc = (float*)(P.ws + O_ROPE_C);
  float* rs = (float*)(P.ws + O_ROPE_S);
  for (long i = gtid; i < 8192 * 16; i += gstr) {
    int pos = (int)(i >> 4), f = (int)(i & 15);
    float inv = powf(10000.0f, -(float)f / 16.0f);
    float ang = (float)pos * inv;
    rc[i] = cosf(ang); rs[i] = sinf(ang);
  }
  float* st = (float*)(P.ws + O_STATS);
  for (long i = gtid; i < (long)3 * M_ * 2; i += gstr) st[i] = 0.f;
  { float* sq = (float*)(P.ws + O_SSQ); for (long i = gtid; i < (long)2 * M_; i += gstr) sq[i] = 0.f; }
  if (gtid < 64) ((int*)(P.ws + O_CTR))[gtid] = 0;
}

constexpr int LDS_BUF = 32768;
constexpr int LDS_RS_OFF = 2 * LDS_BUF;

template <int AMODE, int FAKE = 0>
DI void gemm_mainloop(f32x4 (&acc)[4][4], unsigned char* smem, const void* A, long lda, int m0, int K,
                      const u16* Bt, int n0, const float* stats, bool ns, int tid) {
  const int lane = tid & 63, wave = tid >> 6, wm = wave >> 1, wn = wave & 1;
  const int l16 = lane & 15, lq = lane >> 4;
  const int crow = tid >> 3, cch = tid & 7;
  int gtok0 = 0;
  const int nk = K >> 6;
  const int swz = (cch ^ (crow & 7)) * 8;
  const unsigned boff = ((unsigned)(n0 + crow) * (unsigned)K + (unsigned)cch * 8u) * 2u;
  const unsigned bstrb = 64u * (unsigned)K;
  unsigned aoff = 0u; const unsigned astrb = 64u * (unsigned)lda;
  if constexpr (AMODE == 0) aoff = ((unsigned)(m0 + crow) * (unsigned)lda + (unsigned)cch * 8u) * 2u;
  if constexpr (AMODE == 3) { const int r_ = m0 + crow; const int bg_ = r_ >> 9; gtok0 = (r_ & 511) * 16;
    aoff = ((unsigned)(bg_ >> 1) * (unsigned)T_ * 128u + (unsigned)(bg_ & 1) * 64u + (unsigned)cch * 8u) * 2u; }
  const unsigned gch = (unsigned)(cch ^ (crow & 7)) * 16u;
  const unsigned boffd = ((unsigned)(n0 + crow) * (unsigned)K) * 2u + gch;
  unsigned aoffd = 0u;
  if constexpr (AMODE == 0) aoffd = ((unsigned)(m0 + crow) * (unsigned)lda) * 2u + gch;
  if constexpr (AMODE == 3) { const int r_ = m0 + crow; const int bg_ = r_ >> 9;
    aoffd = ((unsigned)(bg_ >> 1) * (unsigned)T_ * 128u + (unsigned)(bg_ & 1) * 64u) * 2u + gch; }
  const int wbase = __builtin_amdgcn_readfirstlane(wave) * 1024;
#define GP(base_, off_) ((const unsigned*)((const char*)(base_) + (unsigned)(off_)))
#define LP(BUF, off_) ((unsigned*)(smem + (BUF) * LDS_BUF + wbase + (off_)))
#define D_LOAD(BUF, ks) { const unsigned qb_ = boffd + (unsigned)(ks) * 128u; \
    __builtin_amdgcn_global_load_lds(GP(Bt, qb_), LP(BUF, 16384), 16, 0, 0); \
    __builtin_amdgcn_global_load_lds(GP(Bt, qb_ + bstrb), LP(BUF, 16384 + 4096), 16, 0, 0); \
    __builtin_amdgcn_global_load_lds(GP(Bt, qb_ + 2u * bstrb), LP(BUF, 16384 + 8192), 16, 0, 0); \
    __builtin_amdgcn_global_load_lds(GP(Bt, qb_ + 3u * bstrb), LP(BUF, 16384 + 12288), 16, 0, 0); \
    if constexpr (AMODE == 0) { const unsigned qa_ = aoffd + (unsigned)(ks) * 128u; \
      __builtin_amdgcn_global_load_lds(GP(A, qa_), LP(BUF, 0), 16, 0, 0); \
      __builtin_amdgcn_global_load_lds(GP(A, qa_ + astrb), LP(BUF, 4096), 16, 0, 0); \
      __builtin_amdgcn_global_load_lds(GP(A, qa_ + 2u * astrb), LP(BUF, 8192), 16, 0, 0); \
      __builtin_amdgcn_global_load_lds(GP(A, qa_ + 3u * astrb), LP(BUF, 12288), 16, 0, 0); } \
    else { \
      __builtin_amdgcn_global_load_lds(GP(A, aoffd + (unsigned)min(gtok0 + (ks), T_ - 1) * 256u), LP(BUF, 0), 16, 0, 0); \
      __builtin_amdgcn_global_load_lds(GP(A, aoffd + (unsigned)min(gtok0 + 512 + (ks), T_ - 1) * 256u), LP(BUF, 4096), 16, 0, 0); \
      __builtin_amdgcn_global_load_lds(GP(A, aoffd + (unsigned)min(gtok0 + 1024 + (ks), T_ - 1) * 256u), LP(BUF, 8192), 16, 0, 0); \
      __builtin_amdgcn_global_load_lds(GP(A, aoffd + (unsigned)min(gtok0 + 1536 + (ks), T_ - 1) * 256u), LP(BUF, 12288), 16, 0, 0); } }
#define D_SYNC() { asm volatile("s_waitcnt vmcnt(0)" ::: "memory"); asm volatile("s_waitcnt lgkmcnt(0)" ::: "memory"); __builtin_amdgcn_s_barrier(); asm volatile("" ::: "memory"); }
#define G_ROW(mi, fa_) \
      if (ns) { acc[mi][0] = MFMA16(fa_, fb0, acc[mi][0]); acc[mi][1] = MFMA16(fa_, fb1, acc[mi][1]); acc[mi][2] = MFMA16(fa_, fb2, acc[mi][2]); acc[mi][3] = MFMA16(fa_, fb3, acc[mi][3]); } \
      else    { acc[mi][0] = MFMA16(fb0, fa_, acc[mi][0]); acc[mi][1] = MFMA16(fb1, fa_, acc[mi][1]); acc[mi][2] = MFMA16(fb2, fa_, acc[mi][2]); acc[mi][3] = MFMA16(fb3, fa_, acc[mi][3]); }
#define G_HALF(BUF, kk) { \
      const int co = (((kk) * 4 + lq) ^ (l16 & 7)) * 8; \
      const u16* pa = (const u16*)(smem + (BUF) * LDS_BUF) + (wm * 64 + l16) * 64 + co; \
      const u16* pb = (const u16*)(smem + (BUF) * LDS_BUF) + 8192 + (wn * 64 + l16) * 64 + co; \
      const bf16x8 fa0 = *(const bf16x8*)pa, fa1 = *(const bf16x8*)(pa + 16 * 64), fa2 = *(const bf16x8*)(pa + 32 * 64), fa3 = *(const bf16x8*)(pa + 48 * 64); \
      const bf16x8 fb0 = *(const bf16x8*)pb, fb1 = *(const bf16x8*)(pb + 16 * 64), fb2 = *(const bf16x8*)(pb + 32 * 64), fb3 = *(const bf16x8*)(pb + 48 * 64); \
      G_ROW(0, fa0) G_ROW(1, fa1) G_ROW(2, fa2) G_ROW(3, fa3) }
#define R_STEP(CUR, ks) { \
    if ((ks) + 1 < nk && FAKE != 1) D_LOAD((CUR) ^ 1, (ks) + 1) \
    __builtin_amdgcn_sched_barrier(0); \
    if (FAKE != 2) { G_HALF(CUR, 0) G_HALF(CUR, 1) } \
    D_SYNC() }
  __syncthreads();
  D_LOAD(0, 0)
  D_SYNC()
  for (int ks = 0; ks < nk; ks += 2) {
    R_STEP(0, ks)
    if (ks + 1 < nk) R_STEP(1, ks + 1)
  }
#undef GP
#undef LP
#undef D_LOAD
#undef D_SYNC
#undef G_ROW
#undef G_HALF
#undef R_STEP
}

constexpr int LDS_BIG = 24576;
template <int FAKE = 0>
DI void gemm_mainloop_big(f32x4 (&acc)[8][4], unsigned char* smem, const void* A, long lda, int m0, int K,
                          const u16* Bt, int n0, bool ns, int tid) {
  const int lane = tid & 63, wave = tid >> 6, wm = wave >> 1, wn = wave & 1;
  const int l16 = lane & 15, lq = lane >> 4;
  const int nk = K >> 5;
  const int prow = lane >> 2, ppos = lane & 3;
  const unsigned gch = (unsigned)(ppos ^ ((4 - ((lane >> 4) & 3)) & 3)) * 16u;
  const unsigned aoffd = ((unsigned)(m0 + 16 * wave + prow) * (unsigned)lda) * 2u + gch;
  const unsigned boffd = ((unsigned)(n0 + 16 * wave + prow) * (unsigned)K) * 2u + gch;
  const unsigned astrb = 128u * (unsigned)lda, bstrb = 128u * (unsigned)K;
  const int wbase = __builtin_amdgcn_readfirstlane(wave) * 1024;
#define GP(base_, off_) ((const unsigned*)((const char*)(base_) + (unsigned)(off_)))
#define LP(BUF, off_) ((unsigned*)(smem + (BUF) * LDS_BIG + wbase + (off_)))
#define D_LOAD(BUF, ks) { const unsigned ko_ = (unsigned)(ks) * 64u; \
    __builtin_amdgcn_global_load_lds(GP(A, aoffd + ko_), LP(BUF, 0), 16, 0, 0); \
    __builtin_amdgcn_global_load_lds(GP(A, aoffd + ko_ + astrb), LP(BUF, 4096), 16, 0, 0); \
    __builtin_amdgcn_global_load_lds(GP(A, aoffd + ko_ + 2u * astrb), LP(BUF, 8192), 16, 0, 0); \
    __builtin_amdgcn_global_load_lds(GP(A, aoffd + ko_ + 3u * astrb), LP(BUF, 12288), 16, 0, 0); \
    __builtin_amdgcn_global_load_lds(GP(Bt, boffd + ko_), LP(BUF, 16384), 16, 0, 0); \
    __builtin_amdgcn_global_load_lds(GP(Bt, boffd + ko_ + bstrb), LP(BUF, 16384 + 4096), 16, 0, 0); }
#define D_SYNC() { asm volatile("s_waitcnt vmcnt(0)" ::: "memory"); asm volatile("s_waitcnt lgkmcnt(0)" ::: "memory"); __builtin_amdgcn_s_barrier(); asm volatile("" ::: "memory"); }
  const int pp = (lq ^ ((4 - ((l16 >> 2) & 3)) & 3)) * 8;
#define B_ROW(mi) { const bf16x8 fa_ = *(const bf16x8*)(pa + (mi) * 16 * 32); \
      if (ns) { acc[mi][0] = MFMA16(fa_, fb0, acc[mi][0]); acc[mi][1] = MFMA16(fa_, fb1, acc[mi][1]); acc[mi][2] = MFMA16(fa_, fb2, acc[mi][2]); acc[mi][3] = MFMA16(fa_, fb3, acc[mi][3]); } \
      else    { acc[mi][0] = MFMA16(fb0, fa_, acc[mi][0]); acc[mi][1] = MFMA16(fb1, fa_, acc[mi][1]); acc[mi][2] = MFMA16(fb2, fa_, acc[mi][2]); acc[mi][3] = MFMA16(fb3, fa_, acc[mi][3]); } }
#define B_COMPUTE(BUF) { \
      const u16* pa = (const u16*)(smem + (BUF) * LDS_BIG) + (wm * 128 + l16) * 32 + pp; \
      const u16* pb = (const u16*)(smem + (BUF) * LDS_BIG + 16384) + (wn * 64 + l16) * 32 + pp; \
      const bf16x8 fb0 = *(const bf16x8*)pb, fb1 = *(const bf16x8*)(pb + 16 * 32), fb2 = *(const bf16x8*)(pb + 32 * 32), fb3 = *(const bf16x8*)(pb + 48 * 32); \
      B_ROW(0) B_ROW(1) B_ROW(2) B_ROW(3) B_ROW(4) B_ROW(5) B_ROW(6) B_ROW(7) }
#define B_STEP(CUR, ks) { \
    if ((ks) + 1 < nk && FAKE != 1) D_LOAD((CUR) ^ 1, (ks) + 1) \
    __builtin_amdgcn_sched_barrier(0); \
    if (FAKE != 2) B_COMPUTE(CUR) \
    D_SYNC() }
  __syncthreads();
  D_LOAD(0, 0)
  D_SYNC()
  for (int ks = 0; ks < nk; ks += 2) {
    B_STEP(0, ks)
    if (ks + 1 < nk) B_STEP(1, ks + 1)
  }
#undef GP
#undef LP
#undef D_LOAD
#undef D_SYNC
#undef B_ROW
#undef B_COMPUTE
#undef B_STEP
}

template <int MI>
DI void zero_acc(f32x4 (&acc)[MI][4]) {
#pragma unroll
  for (int i = 0; i < MI; ++i)
#pragma unroll
    for (int j = 0; j < 4; ++j) acc[i][j] = f32x4{0.f, 0.f, 0.f, 0.f};
}

DI void stat_push(float* stats, int tok, float s1, float s2, int lq) {
  s1 += __shfl_xor(s1, 16); s2 += __shfl_xor(s2, 16);
  s1 += __shfl_xor(s1, 32); s2 += __shfl_xor(s2, 32);
  if (lq == 0) { atomicAdd(stats + 2 * (long)tok, s1); atomicAdd(stats + 2 * (long)tok + 1, s2); }
}

enum { PH_IN = 1, PH_UQ, PH_UKV, PH_C1, PH_C2, PH_OUT, PH_UP, PH_DOWN, PH_PLE };

template <int PH, int FAKE = 0>
DI void gemm_tile(const Params& P, unsigned char* smem, int mt, int nt, int which, int tid_in) {
  int tid = tid_in;
  asm volatile("" : "+v"(tid));
  unsigned char* ws = P.ws;
  const int lane = tid & 63, wave = tid >> 6, wm = wave >> 1, wn = wave & 1;
  const int l16 = lane & 15, lq = lane >> 4;
  constexpr int MI = (PH == PH_OUT || PH == PH_UP || PH == PH_DOWN || PH == PH_PLE) ? 8 : 4;
  constexpr int WR = MI * 16;
  const int m0 = mt * (2 * WR), n0 = nt * 128;
  f32x4 acc[MI][4];
  zero_acc<MI>(acc);
  float* rsq = (float*)(smem + LDS_RS_OFF);

  if constexpr (PH == PH_IN) {
    const bool ns = (nt == 7 || nt == 9);
    gemm_mainloop<0>(acc, smem, (const u16*)(ws + O_CONCAT), 1024, m0, 1024, (const u16*)(ws + O_WT_IN), n0, nullptr, ns, tid);
    const float QSC = 0.125f * LOG2E_;
#pragma unroll
    for (int mi = 0; mi < MI; ++mi) {
      if (!ns) {
        const int tok = m0 + wm * WR + mi * 16 + l16;
        if (nt < 4) {
#pragma unroll
          for (int nj = 0; nj < 4; ++nj) {
            int col = n0 + wn * 64 + nj * 16 + lq * 4;
            f32x4 a = acc[mi][nj];
            store4bf((u16*)(ws + O_QN) + (long)tok * 512 + col, a[0] * QSC, a[1] * QSC, a[2] * QSC, a[3] * QSC);
          }
        } else if (nt == 4 || nt == 5 || nt == 6 || nt == 8 || nt == 12) {
          u16* dst = (u16*)(ws + (nt == 4 ? O_KC : nt == 5 ? O_VC : nt == 6 ? O_KS : nt == 8 ? O_KW : O_CKV));
          float ss = 0.f;
#pragma unroll
          for (int nj = 0; nj < 4; ++nj) {
            int col = wn * 64 + nj * 16 + lq * 4;
            f32x4 a = acc[mi][nj];
            ss += a[0] * a[0] + a[1] * a[1] + a[2] * a[2] + a[3] * a[3];
            store4bf(dst + (long)tok * 128 + col, a[0], a[1], a[2], a[3]);
          }
          if (nt == 12) {
            ss += __shfl_xor(ss, 16); ss += __shfl_xor(ss, 32);
            if (lq == 0) atomicAdd((float*)(ws + O_SSQ) + M_ + tok, ss);
          }
        } else if (nt == 10 || nt == 11) {
          float ss = 0.f;
#pragma unroll
          for (int nj = 0; nj < 4; ++nj) {
            int col = (nt - 10) * 128 + wn * 64 + nj * 16 + lq * 4;
            f32x4 a = acc[mi][nj];
            ss += a[0] * a[0] + a[1] * a[1] + a[2] * a[2] + a[3] * a[3];
            store4bf((u16*)(ws + O_CQ) + (long)tok * 256 + col, a[0], a[1], a[2], a[3]);
          }
          ss += __shfl_xor(ss, 16); ss += __shfl_xor(ss, 32);
          if (lq == 0) atomicAdd((float*)(ws + O_SSQ) + tok, ss);
        } else {
          if (wn == 0) {
            const int pos = tok & (T_ - 1);
            const float4 cs = *(const float4*)((const float*)(ws + O_ROPE_C) + pos * 16 + lq * 4);
            const float4 sn = *(const float4*)((const float*)(ws + O_ROPE_S) + pos * 16 + lq * 4);
            f32x4 x1 = acc[mi][0], x2 = acc[mi][1];
            u16* kp = (u16*)(ws + O_KPE) + (long)tok * 32;
            store4bf(kp + lq * 4, x1[0] * cs.x - x2[0] * sn.x, x1[1] * cs.y - x2[1] * sn.y, x1[2] * cs.z - x2[2] * sn.z, x1[3] * cs.w - x2[3] * sn.w);
            store4bf(kp + 16 + lq * 4, x2[0] * cs.x + x1[0] * sn.x, x2[1] * cs.y + x1[1] * sn.y, x2[2] * cs.z + x1[2] * sn.z, x2[3] * cs.w + x1[3] * sn.w);
            float* gp = (float*)(ws + O_GATES) + (long)tok * 24;
            f32x4 g0 = acc[mi][2], g1 = acc[mi][3];
            *(float4*)(gp + lq * 4) = make_float4(sigmoid_(g0[0]), sigmoid_(g0[1]), sigmoid_(g0[2]), sigmoid_(g0[3]));
            if (lq < 2) *(float4*)(gp + 16 + lq * 4) = make_float4(sigmoid_(g1[0]), sigmoid_(g1[1]), sigmoid_(g1[2]), sigmoid_(g1[3]));
          }
        }
      } else {
        const int tok4 = m0 + wm * WR + mi * 16 + lq * 4;
        const int b = tok4 >> 13, t = tok4 & (T_ - 1);
        u16* dstb = (u16*)(ws + (nt == 7 ? O_VST : O_VWT));
#pragma unroll
        for (int nj = 0; nj < 4; ++nj) {
          int c = wn * 64 + nj * 16 + l16, g = c >> 6, d = c & 63;
          f32x4 a = acc[mi][nj];
          store4bf(dstb + ((long)((b * 2 + g) * 64 + d)) * T_ + t, a[0], a[1], a[2], a[3]);
        }
      }
    }
  }

  if constexpr (PH == PH_UQ || PH == PH_UKV) {
    constexpr int K = (PH == PH_UQ) ? 256 : 128;
    const u16* A = (const u16*)(ws + (PH == PH_UQ ? O_CQ : O_CKV));
    __syncthreads();
    if (tid < 128) {
      const float ss = ((const float*)(ws + O_SSQ))[(PH == PH_UQ ? 0 : M_) + m0 + tid];
      rsq[tid] = rsqrtf(ss * (1.f / K) + 1e-6f);
    }
    if constexpr (PH == PH_UQ) {
      gemm_mainloop<0>(acc, smem, A, 256, m0, 256, (const u16*)(ws + O_WT_UQ), n0, nullptr, false, tid);
      const float SC = 0.10206207261596577f * LOG2E_;
#pragma unroll
      for (int mi = 0; mi < MI; ++mi) {
        const int tok = m0 + wm * WR + mi * 16 + l16;
        const float rs = rsq[wm * WR + mi * 16 + l16] * SC;
        const int pos = tok & (T_ - 1);
        const int ct0 = nt * 8 + wn * 4;
#pragma unroll
        for (int njp = 0; njp < 4; njp += 2) {
          f32x4 a = acc[mi][njp], b2 = acc[mi][njp + 1];
          if (((ct0 + njp) % 6) == 4) {
            const float4 cs = *(const float4*)((const float*)(ws + O_ROPE_C) + pos * 16 + lq * 4);
            const float4 sn = *(const float4*)((const float*)(ws + O_ROPE_S) + pos * 16 + lq * 4);
            f32x4 o1, o2;
            o1[0] = a[0] * cs.x - b2[0] * sn.x; o2[0] = b2[0] * cs.x + a[0] * sn.x;
            o1[1] = a[1] * cs.y - b2[1] * sn.y; o2[1] = b2[1] * cs.y + a[1] * sn.y;
            o1[2] = a[2] * cs.z - b2[2] * sn.z; o2[2] = b2[2] * cs.z + a[2] * sn.z;
            o1[3] = a[3] * cs.w - b2[3] * sn.w; o2[3] = b2[3] * cs.w + a[3] * sn.w;
            a = o1; b2 = o2;
          }
          u16* dst = (u16*)(ws + O_QM) + (long)tok * 768 + n0 + wn * 64 + njp * 16 + lq * 4;
          store4bf(dst, a[0] * rs, a[1] * rs, a[2] * rs, a[3] * rs);
          store4bf(dst + 16, b2[0] * rs, b2[1] * rs, b2[2] * rs, b2[3] * rs);
        }
      }
    } else {
      const bool ns = (wn == 1);
      gemm_mainloop<0>(acc, smem, A, 128, m0, 128, (const u16*)(ws + O_WT_UKV), n0, nullptr, ns, tid);
#pragma unroll
      for (int mi = 0; mi < MI; ++mi) {
        if (!ns) {
          const int tok = m0 + wm * WR + mi * 16 + l16;
          const float rs = rsq[wm * WR + mi * 16 + l16];
#pragma unroll
          for (int nj = 0; nj < 4; ++nj) {
            f32x4 a = acc[mi][nj];
            store4bf((u16*)(ws + O_KN) + (long)tok * 512 + nt * 64 + nj * 16 + lq * 4, a[0] * rs, a[1] * rs, a[2] * rs, a[3] * rs);
          }
        } else {
          const int lr = wm * WR + mi * 16 + lq * 4;
          const int tok4 = m0 + lr;
          const int b = tok4 >> 13, t = tok4 & (T_ - 1);
          const float r0 = rsq[lr], r1 = rsq[lr + 1], r2 = rsq[lr + 2], r3 = rsq[lr + 3];
#pragma unroll
          for (int nj = 0; nj < 4; ++nj) {
            int d = nj * 16 + l16;
            f32x4 a = acc[mi][nj];
            store4bf((u16*)(ws + O_VMT) + ((long)((b * 8 + nt) * 64 + d)) * T_ + t, a[0] * r0, a[1] * r1, a[2] * r2, a[3] * r3);
          }
        }
      }
    }
  }

  if constexpr (PH == PH_C1) {
    const u16* A = (const u16*)(ws + (which ? O_VC : O_KC));
    const u16* Bt = (const u16*)(ws + (which ? O_WT_CV1 : O_WT_CK1));
    const float* bias = (const float*)(ws + (which ? O_BIAS1V : O_BIAS1K));
    gemm_mainloop<3>(acc, smem, A, 128, m0, 2048, Bt, n0, nullptr, false, tid);
    u16* hid = (u16*)(ws + O_HID) + (long)which * 8192 * 256;
#pragma unroll
    for (int mi = 0; mi < MI; ++mi) {
      const int row = m0 + wm * WR + mi * 16 + l16;
#pragma unroll
      for (int nj = 0; nj < 4; ++nj) {
        int col = n0 + wn * 64 + nj * 16 + lq * 4;
        const float4 bb = *(const float4*)(bias + col);
        f32x4 a = acc[mi][nj];
        store4bf(hid + (long)row * 256 + col, gelu_tanh_(a[0] + bb.x), gelu_tanh_(a[1] + bb.y), gelu_tanh_(a[2] + bb.z), gelu_tanh_(a[3] + bb.w));
      }
    }
  }

  if constexpr (PH == PH_C2) {
    const u16* A = (const u16*)(ws + O_HID) + (long)which * 8192 * 256;
    const u16* Bt = (const u16*)(ws + (which ? O_WT_CV2 : O_WT_CK2));
    const bool ns = (which == 1);
    gemm_mainloop<0>(acc, smem, A, 256, m0, 256, Bt, 0, nullptr, ns, tid);
    if (wn == 0) {
#pragma unroll
      for (int mi = 0; mi < MI; ++mi) {
        if (!ns) {
          const int row = m0 + wm * WR + mi * 16 + l16;
#pragma unroll
          for (int nj = 0; nj < 4; ++nj) {
            f32x4 a = acc[mi][nj];
            store4bf((u16*)(ws + O_CMPK) + (long)row * 64 + nj * 16 + lq * 4, a[0], a[1], a[2], a[3]);
          }
        } else {
          const int r4 = m0 + wm * WR + mi * 16 + lq * 4;
          const int bg = r4 >> 9, c = r4 & 511;
#pragma unroll
          for (int nj = 0; nj < 4; ++nj) {
            int d = nj * 16 + l16;
            f32x4 a = acc[mi][nj];
            store4bf((u16*)(ws + O_CMPVT) + ((long)(bg * 64 + d)) * 512 + c, a[0], a[1], a[2], a[3]);
          }
        }
      }
    }
  }

  if constexpr (PH == PH_OUT) {
    gemm_mainloop_big<0>(acc, smem, (const u16*)(ws + O_CONCAT), 1024, m0, 1024, (const u16*)(ws + O_WT_OUT), n0, false, tid);
    float* stats = (float*)(ws + O_STATS);
#pragma unroll
    for (int mi = 0; mi < MI; ++mi) {
      const int tok = m0 + wm * WR + mi * 16 + l16;
      float s1 = 0.f, s2 = 0.f;
#pragma unroll
      for (int nj = 0; nj < 4; ++nj) {
        int col = n0 + wn * 64 + nj * 16 + lq * 4;
        const float4 xv = *(const float4*)(P.x + (long)tok * 1024 + col);
        f32x4 a = acc[mi][nj];
        float4 y = make_float4(ALPHA_ * xv.x + a[0], ALPHA_ * xv.y + a[1], ALPHA_ * xv.z + a[2], ALPHA_ * xv.w + a[3]);
        store4bf((u16*)(ws + O_YB) + (long)tok * 1024 + col, y.x, y.y, y.z, y.w);
        s1 += y.x + y.y + y.z + y.w;
        s2 += y.x * y.x + y.y * y.y + y.z * y.z + y.w * y.w;
      }
      stat_push(stats, tok, s1, s2, lq);
    }
  }

  if constexpr (PH == PH_UP) {
    gemm_mainloop_big<FAKE>(acc, smem, (const u16*)(ws + O_YB), 1024, m0, 1024, (const u16*)(ws + O_WT_UP), n0, false, tid);
    if (FAKE != 0 && acc[0][0][0] + acc[3][3][3] + acc[1][2][1] != 123456.75f) return;
    const float* bias = (const float*)(ws + O_BIAS_UP);
    const float* csum = (const float*)(ws + O_CSUM_UP);
    const float* st1 = (const float*)(ws + O_STATS);
#pragma unroll
    for (int mi = 0; mi < MI; ++mi) {
      const int tok = m0 + wm * WR + mi * 16 + l16;
      const float mean = st1[2 * tok] * (1.f / 1024.f);
      const float rstd = rsqrtf(st1[2 * tok + 1] * (1.f / 1024.f) - mean * mean + 1e-5f);
      unsigned hw[4];
#pragma unroll
      for (int nj = 0; nj < 2; ++nj) {
        const int cb = n0 + wn * 64 + nj * 16 + lq * 4;
        const float4 bg = *(const float4*)(bias + cb);
        const float4 bu = *(const float4*)(bias + cb + 32);
        const float4 cg = *(const float4*)(csum + cb);
        const float4 cu = *(const float4*)(csum + cb + 32);
        f32x4 g = acc[mi][nj], u = acc[mi][nj + 2];
        float h0, h1, h2, h3, v;
        v = rstd * (g[0] - mean * cg.x) + bg.x; h0 = v * sigmoid_(v) * (rstd * (u[0] - mean * cu.x) + bu.x);
        v = rstd * (g[1] - mean * cg.y) + bg.y; h1 = v * sigmoid_(v) * (rstd * (u[1] - mean * cu.y) + bu.y);
        v = rstd * (g[2] - mean * cg.z) + bg.z; h2 = v * sigmoid_(v) * (rstd * (u[2] - mean * cu.z) + bu.z);
        v = rstd * (g[3] - mean * cg.w) + bg.w; h3 = v * sigmoid_(v) * (rstd * (u[3] - mean * cu.w) + bu.w);
        hw[2 * nj] = pack2(h0, h1); hw[2 * nj + 1] = pack2(h2, h3);
      }
      *(uint4*)((u16*)(ws + O_HBUF) + (long)tok * 2816 + nt * 64 + wn * 32 + lq * 8) = make_uint4(hw[0], hw[1], hw[2], hw[3]);
    }
  }

  if constexpr (PH == PH_DOWN) {
    gemm_mainloop_big<0>(acc, smem, (const u16*)(ws + O_HBUF), 2816, m0, 2816, (const u16*)(ws + O_WT_DOWN), n0, false, tid);
    const float* st1 = (const float*)(ws + O_STATS);
    float* st2 = (float*)(ws + O_STATS) + (long)M_ * 2;
    u16* yb = (u16*)(ws + O_YB);
#pragma unroll
    for (int mi = 0; mi < MI; ++mi) {
      const int tok = m0 + wm * WR + mi * 16 + l16;
      const float mean = st1[2 * tok] * (1.f / 1024.f);
      const float rstd = rsqrtf(st1[2 * tok + 1] * (1.f / 1024.f) - mean * mean + 1e-5f);
      float s1 = 0.f, s2 = 0.f;
#pragma unroll
      for (int nj = 0; nj < 4; ++nj) {
        int col = n0 + wn * 64 + nj * 16 + lq * 4;
        const uint2 yq = *(const uint2*)(yb + (long)tok * 1024 + col);
        const float4 yv = make_float4(bflo(yq.x), bfhi(yq.x), bflo(yq.y), bfhi(yq.y));
        const float4 gg = *(const float4*)(P.ln1_g + col);
        const float4 bb = *(const float4*)(P.ln1_b + col);
        f32x4 a = acc[mi][nj];
        float4 y;
        y.x = ALPHA_ * ((yv.x - mean) * rstd * gg.x + bb.x) + a[0];
        y.y = ALPHA_ * ((yv.y - mean) * rstd * gg.y + bb.y) + a[1];
        y.z = ALPHA_ * ((yv.z - mean) * rstd * gg.z + bb.z) + a[2];
        y.w = ALPHA_ * ((yv.w - mean) * rstd * gg.w + bb.w) + a[3];
        store4bf(yb + (long)tok * 1024 + col, y.x, y.y, y.z, y.w);
        s1 += y.x + y.y + y.z + y.w;
        s2 += y.x * y.x + y.y * y.y + y.z * y.z + y.w * y.w;
      }
      stat_push(st2, tok, s1, s2, lq);
    }
  }

  if constexpr (PH == PH_PLE) {
    const float* st2 = (const float*)(ws + O_STATS) + (long)M_ * 2;
    float* st3 = (float*)(ws + O_STATS) + (long)M_ * 4;
    u16* yb = (u16*)(ws + O_YB);
    gemm_mainloop_big<0>(acc, smem, (const u16*)(ws + O_YB), 1024, m0, 1024, (const u16*)(ws + O_WT_GATE), n0, false, tid);
    const float* bias = (const float*)(ws + O_BIAS_G);
    uint4* gsp4 = (uint4*)(ws + O_HBUF) + (long)(mt * 8 + nt) * 16 * 256;
#pragma unroll
    for (int mi = 0; mi < MI; ++mi) {
      const int tok = m0 + wm * WR + mi * 16 + l16;
      const float mean_g = st2[2 * tok] * (1.f / 1024.f);
      const float rstd_g = rsqrtf(st2[2 * tok + 1] * (1.f / 1024.f) - mean_g * mean_g + 1e-5f);
      unsigned gw[8];
#pragma unroll
      for (int nj = 0; nj < 4; ++nj) {
        int col = n0 + wn * 64 + nj * 16 + lq * 4;
        const float4 bb = *(const float4*)(bias + col);
        const float4 cs = *(const float4*)((const float*)(ws + O_CSUM_G) + col);
        f32x4 a = acc[mi][nj];
        gw[2 * nj] = pack2(sigmoid_(rstd_g * (a[0] - mean_g * cs.x) + bb.x), sigmoid_(rstd_g * (a[1] - mean_g * cs.y) + bb.y));
        gw[2 * nj + 1] = pack2(sigmoid_(rstd_g * (a[2] - mean_g * cs.z) + bb.z), sigmoid_(rstd_g * (a[3] - mean_g * cs.w) + bb.w));
      }
      gsp4[(mi * 2 + 0) * 256 + tid] = make_uint4(gw[0], gw[1], gw[2], gw[3]);
      gsp4[(mi * 2 + 1) * 256 + tid] = make_uint4(gw[4], gw[5], gw[6], gw[7]);
    }
    zero_acc<MI>(acc);
    gemm_mainloop_big<0>(acc, smem, (const u16*)(ws + O_PB), 256, m0, 256, (const u16*)(ws + O_WT_PLE), n0, false, tid);
#pragma unroll
    for (int mi = 0; mi < MI; ++mi) {
      const int tok = m0 + wm * WR + mi * 16 + l16;
      const float mean = st2[2 * tok] * (1.f / 1024.f);
      const float rstd = rsqrtf(st2[2 * tok + 1] * (1.f / 1024.f) - mean * mean + 1e-5f);
      float s1 = 0.f, s2 = 0.f;
      const uint4 gqa = gsp4[(mi * 2 + 0) * 256 + tid], gqb = gsp4[(mi * 2 + 1) * 256 + tid];
#pragma unroll
      for (int nj = 0; nj < 4; ++nj) {
        int col = n0 + wn * 64 + nj * 16 + lq * 4;
        const uint2 yq = *(const uint2*)(yb + (long)tok * 1024 + col);
        const float4 yv = make_float4(bflo(yq.x), bfhi(yq.x), bflo(yq.y), bfhi(yq.y));
        const float4 gg = *(const float4*)(P.ln2_g + col);
        const float4 bb = *(const float4*)(P.ln2_b + col);
        f32x4 a = acc[mi][nj];
        const unsigned g01 = (nj == 0) ? gqa.x : (nj == 1) ? gqa.z : (nj == 2) ? gqb.x : gqb.z;
        const unsigned g23 = (nj == 0) ? gqa.y : (nj == 1) ? gqa.w : (nj == 2) ? gqb.y : gqb.w;
        float4 y;
        y.x = ALPHA_ * ((yv.x - mean) * rstd * gg.x + bb.x) + bflo(g01) * a[0];
        y.y = ALPHA_ * ((yv.y - mean) * rstd * gg.y + bb.y) + bfhi(g01) * a[1];
        y.z = ALPHA_ * ((yv.z - mean) * rstd * gg.z + bb.z) + bflo(g23) * a[2];
        y.w = ALPHA_ * ((yv.w - mean) * rstd * gg.w + bb.w) + bfhi(g23) * a[3];
        store4bf((u16*)(ws + O_CONCAT) + (long)tok * 1024 + col, y.x, y.y, y.z, y.w);
        s1 += y.x + y.y + y.z + y.w;
        s2 += y.x * y.x + y.y * y.y + y.z * y.z + y.w * y.w;
      }
      stat_push(st3, tok, s1, s2, lq);
    }
  }
}

constexpr int LDS_TOTAL = 2 * LDS_BUF + 512;
constexpr int CTL_OFF = 53248;
constexpr int SEL_OFF = CTL_OFF + 1024;
constexpr int IMP_OFF = 35840;
static_assert(IMP_OFF + 32 * 130 * 4 <= CTL_OFF, "lds");
static_assert(SEL_OFF + 512 <= LDS_TOTAL, "lds");

struct AttnSrc { const u16* K; long ldk; const u16* K2; const u16* V; long ldv; };
enum { AM_MLA = 0, AM_WIN = 1, AM_SLC = 2, AM_CMP = 3 };

template <int MODE, int DQ, bool DO_PV, bool FIXED_M, bool DO_IMP, bool USE_LIST, int FK = 0>
DI void attn_loop(unsigned char* smem, const AttnSrc src, int ntiles, int tile_lo, const int* tlist,
                  const bf16x8 (&qf)[DQ / 16], float& m, float& l, f32x16 (&O)[2], int t, float slope2,
                  unsigned sw0, unsigned sw1, unsigned sw2, unsigned sw3, float inv_l, unsigned* imp, int tid_in) {
  int tid = tid_in;
  asm volatile("" : "+v"(tid));
  constexpr int KST = DQ + 8;
  constexpr int KCH = DQ / 8;
  constexpr int NKL = KCH * 64 / 256;
  constexpr int KBYTES = 64 * KST * 2;
  constexpr int VST = 68;
  constexpr int VBYTES = 64 * VST * 2;
  const int lane = tid & 63, l32 = lane & 31, h = lane >> 5;
  u16* sK0 = (u16*)smem;
  u16* sV0 = (u16*)(smem + 2 * KBYTES);
  uint4 rk0, rk1, rk2, rv0, rv1;
  const int kr0 = tid / KCH, kc0 = tid % KCH;
  const int kr1 = (tid + 256) / KCH, kc1 = (tid + 256) % KCH;
  const int kr2 = (tid + 512) / KCH, kc2 = (tid + 512) % KCH;
  const int vr0 = tid >> 3, vc0 = tid & 7;
#define A_KLD(dst_, row_, ch_, tile_) { \
    if constexpr (MODE == AM_MLA) { \
      if ((ch_) < 8) dst_ = *(const uint4*)(src.K + ((long)(tile_) * 64 + (row_)) * src.ldk + (ch_) * 8); \
      else dst_ = *(const uint4*)(src.K2 + ((long)(tile_) * 64 + (row_)) * 32 + ((ch_) - 8) * 8); \
    } else dst_ = *(const uint4*)(src.K + ((long)(tile_) * 64 + (row_)) * src.ldk + (ch_) * 8); }
#define A_GLOAD(tile_) { \
    A_KLD(rk0, kr0, kc0, tile_) A_KLD(rk1, kr1, kc1, tile_) \
    if constexpr (NKL == 3) A_KLD(rk2, kr2, kc2, tile_) \
    if constexpr (DO_PV) { \
      rv0 = *(const uint4*)(src.V + (long)vr0 * src.ldv + (long)(tile_) * 64 + vc0 * 8); \
      rv1 = *(const uint4*)(src.V + (long)(vr0 + 32) * src.ldv + (long)(tile_) * 64 + vc0 * 8); } }
#define A_LSTORE(buf_) { \
    u16* sK_ = sK0 + (buf_) * (KBYTES / 2); u16* sV_ = sV0 + (buf_) * (VBYTES / 2); \
    *(uint4*)(sK_ + kr0 * KST + kc0 * 8) = rk0; *(uint4*)(sK_ + kr1 * KST + kc1 * 8) = rk1; \
    if constexpr (NKL == 3) *(uint4*)(sK_ + kr2 * KST + kc2 * 8) = rk2; \
    if constexpr (DO_PV) { \
      *(uint2*)(sV_ + vr0 * VST + vc0 * 8) = make_uint2(rv0.x, rv0.y); *(uint2*)(sV_ + vr0 * VST + vc0 * 8 + 4) = make_uint2(rv0.z, rv0.w); \
      *(uint2*)(sV_ + (vr0 + 32) * VST + vc0 * 8) = make_uint2(rv1.x, rv1.y); *(uint2*)(sV_ + (vr0 + 32) * VST + vc0 * 8 + 4) = make_uint2(rv1.z, rv1.w); } }
  __syncthreads();
  if (ntiles > 0) { const int tf = USE_LIST ? tlist[0] : tile_lo; A_GLOAD(tf) A_LSTORE(0) }
  __syncthreads();
  for (int it = 0; it < ntiles; ++it) {
    const int tile = USE_LIST ? tlist[it] : tile_lo + it;
    if (it + 1 < ntiles && FK != 1) { const int tn = USE_LIST ? tlist[it + 1] : tile_lo + it + 1; A_GLOAD(tn) }
    __builtin_amdgcn_sched_barrier(0);
    const u16* sK = sK0 + (it & 1) * (KBYTES / 2);
    const u16* sV = sV0 + (it & 1) * (VBYTES / 2);
    f32x16 S[2];
#pragma unroll
    for (int kb = 0; kb < 2; ++kb) {
#pragma unroll
      for (int i = 0; i < 16; ++i) S[kb][i] = 0.f;
#pragma unroll
      for (int s = 0; s < DQ / 16; ++s) {
        bf16x8 kf = *(const bf16x8*)(sK + (kb * 32 + l32) * KST + s * 16 + h * 8);
        S[kb] = MFMA32(kf, qf[s], S[kb]);
      }
    }
    float c0 = 0.f;
    {
      constexpr int MUL = (MODE == AM_CMP) ? 16 : 1;
      int d0;
      if constexpr (MODE == AM_CMP) d0 = t - 31 - 16 * (tile * 64 + 4 * h);
      else d0 = t - tile * 64 - 4 * h;
      bool need = true;
      if constexpr (MODE == AM_MLA) need = (tile * 64 + 63 > t - l32);
      bool selbit = true;
      if constexpr (MODE == AM_SLC) {
        const int w = tile >> 5;
        const unsigned swd = (w == 0) ? sw0 : (w == 1) ? sw1 : (w == 2) ? sw2 : sw3;
        selbit = (swd >> (tile & 31)) & 1u;
      }
      bool full = false;
      if constexpr (MODE != AM_MLA) {
        const int tw = t - l32;
        if constexpr (MODE == AM_CMP) full = ((tile * 64 + 63) * 16 + 31 <= tw);
        if constexpr (MODE == AM_WIN) full = (tile * 64 + 63 <= tw) && (tw + 31 - tile * 64 < 512);
        if constexpr (MODE == AM_SLC) full = (tile * 64 + 63 <= tw) && __all(selbit);
      }
      const float fd0 = (float)d0;
      if constexpr (MODE != AM_MLA) {
#pragma unroll
        for (int kb = 0; kb < 2; ++kb)
#pragma unroll
          for (int i = 0; i < 16; ++i) {
            const float ci = (float)(MUL * ((i & 3) + 8 * (i >> 2) + 32 * kb));
            S[kb][i] = fmaf(slope2, ci, S[kb][i]);
          }
      }
      c0 = (MODE != AM_MLA) ? -slope2 * fd0 : 0.f;
      if (need && !full) {
#pragma unroll
        for (int kb = 0; kb < 2; ++kb)
#pragma unroll
          for (int i = 0; i < 16; ++i) {
            const float ci = (float)(MUL * ((i & 3) + 8 * (i >> 2) + 32 * kb));
            const float dist = fd0 - ci;
            bool valid = dist >= 0.f;
            if constexpr (MODE == AM_WIN) valid = valid && (dist < 512.f);
            if constexpr (MODE == AM_SLC) valid = valid && selbit;
            S[kb][i] = valid ? S[kb][i] : -INFINITY;
          }
      }
    }
    if constexpr (FK != 2) {
    if constexpr (!FIXED_M) {
      float tmax = -INFINITY;
#pragma unroll
      for (int kb = 0; kb < 2; ++kb)
#pragma unroll
        for (int i = 0; i < 16; ++i) tmax = fmaxf(tmax, S[kb][i]);
      tmax += c0;
      tmax = fmaxf(tmax, __shfl_xor(tmax, 32));
      const bool need = tmax > m + 8.f;
      if (__any(need)) {
        const float mnew = need ? tmax : m;
        const float alpha = ex2(m - mnew);
        m = mnew;
        l *= alpha;
        if constexpr (DO_PV) {
#pragma unroll
          for (int db = 0; db < 2; ++db)
#pragma unroll
            for (int i = 0; i < 16; ++i) O[db][i] *= alpha;
        }
      }
    }
    const float mx = m - c0;
    {
      float ps = 0.f;
#pragma unroll
      for (int kb = 0; kb < 2; ++kb)
#pragma unroll
        for (int i = 0; i < 16; ++i) { float p = ex2(S[kb][i] - mx); S[kb][i] = p; ps += p; }
      l += ps;
    }
    }
    if constexpr (DO_IMP) {
#pragma unroll
      for (int kb = 0; kb < 2; ++kb)
#pragma unroll
        for (int a = 0; a < 4; ++a) {
          const float p0 = S[kb][4 * a] * inv_l, p1 = S[kb][4 * a + 1] * inv_l, p2 = S[kb][4 * a + 2] * inv_l, p3 = S[kb][4 * a + 3] * inv_l;
          const float mainv = 2.f * (p0 + p1 + p2) + p3;
          const int n = tile * 16 + kb * 8 + 2 * a + h;
          atomicAdd(imp + l32 * 130 + n, (unsigned)(mainv * 268435456.f));
          atomicAdd(imp + l32 * 130 + n + 1, (unsigned)(p3 * 268435456.f));
        }
    }
    if (it + 1 < ntiles) { A_LSTORE((it + 1) & 1) }
    if constexpr (DO_PV) {
#pragma unroll
      for (int sp = 0; sp < 4; ++sp) {
        const int kb = sp >> 1, hf = sp & 1;
        unsigned w0 = pack2(S[kb][8 * hf + 0], S[kb][8 * hf + 1]);
        unsigned w1 = pack2(S[kb][8 * hf + 2], S[kb][8 * hf + 3]);
        unsigned w2 = pack2(S[kb][8 * hf + 4], S[kb][8 * hf + 5]);
        unsigned w3 = pack2(S[kb][8 * hf + 6], S[kb][8 * hf + 7]);
        uint4 pw = make_uint4(w0, w1, w2, w3);
        bf16x8 pf = __builtin_bit_cast(bf16x8, pw);
#pragma unroll
        for (int db = 0; db < 2; ++db) {
          const u16* vp = sV + (db * 32 + l32) * VST + 16 * sp + 4 * h;
          s16x4 lo = *(const s16x4*)vp;
          s16x4 hi = *(const s16x4*)(vp + 8);
          bf16x8 vf = __builtin_shufflevector(lo, hi, 0, 1, 2, 3, 4, 5, 6, 7);
          O[db] = MFMA32(vf, pf, O[db]);
        }
      }
    }
    __syncthreads();
  }
  l += __shfl_xor(l, 32);
#undef A_KLD
#undef A_GLOAD
#undef A_LSTORE
}

DI void zero_o(f32x16 (&O)[2]) {
#pragma unroll
  for (int db = 0; db < 2; ++db)
#pragma unroll
    for (int i = 0; i < 16; ++i) O[db][i] = 0.f;
}

template <int FK = 0>
DI void mla_item(const Params& P, unsigned char* smem, int b, int hh, int qt, int tid_in) {
  int tid = tid_in;
  asm volatile("" : "+v"(tid));
  unsigned char* ws = P.ws;
  const int lane = tid & 63, w = tid >> 6, l32 = lane & 31, h = lane >> 5;
  const int t = qt * 128 + w * 32 + l32;
  const long tok = (long)b * T_ + t;
  bf16x8 qf[6];
#pragma unroll
  for (int s = 0; s < 6; ++s) qf[s] = *(const bf16x8*)((const u16*)(ws + O_QM) + tok * 768 + hh * 96 + s * 16 + h * 8);
  float m = -1e30f, l = 0.f;
  f32x16 O[2];
  zero_o(O);
  AttnSrc src;
  src.K = (const u16*)(ws + O_KN) + (long)b * T_ * 512 + hh * 64; src.ldk = 512;
  src.K2 = (const u16*)(ws + O_KPE) + (long)b * T_ * 32;
  src.V = (const u16*)(ws + O_VMT) + ((long)(b * 8 + hh) * 64) * T_; src.ldv = T_;
  attn_loop<AM_MLA, 96, true, false, false, false, FK>(smem, src, 2 * qt + 2, 0, nullptr, qf, m, l, O, t, 0.f, 0, 0, 0, 0, 0.f, nullptr, tid);
  if (FK != 0 && O[0][0] + O[1][5] + l != 123456.75f) return;
  const float lt = l;
  const float inv = lt > 0.f ? 1.f / lt : 0.f;
  u16* dst = (u16*)(ws + O_CONCAT) + tok * 1024 + 512 + hh * 64;
#pragma unroll
  for (int db = 0; db < 2; ++db)
#pragma unroll
    for (int a = 0; a < 4; ++a)
      store4bf(dst + db * 32 + 8 * a + 4 * h, O[db][4 * a] * inv, O[db][4 * a + 1] * inv, O[db][4 * a + 2] * inv, O[db][4 * a + 3] * inv);
}

DI u64 mk_key(int n, unsigned v, int cur) {
  if (n > cur) return 0ull;
  if (n == 0 || n == cur || n == cur - 1) v = 0xFFFFFFFFu;
  return ((u64)v << 8) | (u64)(128 - n);
}

DI void nsa_item(const Params& P, unsigned char* smem, int b, int g, int tt, int tid_in) {
  int tid = tid_in;
  asm volatile("" : "+v"(tid));
  unsigned char* ws = P.ws;
  const int lane = tid & 63, w = tid >> 6, l32 = lane & 31, h = lane >> 5;
  const int t0 = tt * 32;
  const int t = t0 + l32;
  const long tok = (long)b * T_ + t;
  const int head8 = g * 4 + w;
  int* ctl = (int*)(smem + CTL_OFF);
  unsigned* sel = (unsigned*)(smem + SEL_OFF);
  unsigned* imp = (unsigned*)(smem + IMP_OFF);
  bf16x8 qf[4];
#pragma unroll
  for (int s = 0; s < 4; ++s) qf[s] = *(const bf16x8*)((const u16*)(ws + O_QN) + tok * 512 + head8 * 64 + s * 16 + h * 8);
  const float* gp = (const float*)(ws + O_GATES) + tok * 24 + head8 * 3;
  const float g0 = gp[0], g1 = gp[1], g2 = gp[2];
  const float slope2 = LOG2E_ * exp2f(-(float)(head8 + 1));
  __syncthreads();
  for (int i = tid; i < 32 * 130; i += 256) imp[i] = 0u;
  if (tid < 4) ctl[4 + tid] = 0;
  f32x16 O[2];
  float m = -1e30f, l = 0.f;
  float* osp = (float*)(ws + O_Y2) + (long)blockIdx.x * 16384 + tid;
  AttnSrc sc;
  sc.K = (const u16*)(ws + O_CMPK) + ((long)(b * 2 + g) * 512) * 64; sc.ldk = 64; sc.K2 = nullptr;
  sc.V = (const u16*)(ws + O_CMPVT) + ((long)(b * 2 + g) * 64) * 512; sc.ldv = 512;
  const int ntc = (t0 >> 10) + 1;
  attn_loop<AM_CMP, 64, false, false, false, false>(smem, sc, ntc, 0, nullptr, qf, m, l, O, t, slope2, 0, 0, 0, 0, 0.f, nullptr, tid);
  {
    const float lt = l;
    const float inv_l = lt > 0.f ? 1.f / lt : 0.f;
    zero_o(O);
    float l2 = 0.f;
    attn_loop<AM_CMP, 64, true, true, true, false>(smem, sc, ntc, 0, nullptr, qf, m, l2, O, t, slope2, 0, 0, 0, 0, inv_l, imp, tid);
    const float sc0 = g0 * inv_l;
#pragma unroll
    for (int db = 0; db < 2; ++db)
#pragma unroll
      for (int i = 0; i < 16; ++i) osp[(db * 16 + i) * 256] = O[db][i] * sc0;
  }
  for (int tk = 0; tk < 8; ++tk) {
    const int token = w * 8 + tk;
    const int cur = (t0 + token) >> 6;
    const u64 k0 = mk_key(lane, imp[token * 130 + lane], cur);
    const u64 k1 = mk_key(lane + 64, imp[token * 130 + lane + 64], cur);
    u64 thr = 0ull;
    for (int bit = 39; bit >= 0; --bit) {
      const u64 cand = thr | (1ull << bit);
      const int c = __popcll(__ballot(k0 >= cand)) + __popcll(__ballot(k1 >= cand));
      if (c >= 16) thr = cand;
    }
    const u64 m0 = __ballot(k0 >= thr && k0 > 0ull);
    const u64 m1 = __ballot(k1 >= thr && k1 > 0ull);
    if (lane == 0) {
      sel[token * 4 + 0] = (unsigned)m0; sel[token * 4 + 1] = (unsigned)(m0 >> 32);
      sel[token * 4 + 2] = (unsigned)m1; sel[token * 4 + 3] = (unsigned)(m1 >> 32);
      atomicOr((unsigned*)&ctl[4], (unsigned)m0); atomicOr((unsigned*)&ctl[5], (unsigned)(m0 >> 32));
      atomicOr((unsigned*)&ctl[6], (unsigned)m1); atomicOr((unsigned*)&ctl[7], (unsigned)(m1 >> 32));
    }
  }
  __syncthreads();
  if (tid == 0) {
    int c = 0;
    for (int q = 0; q < 4; ++q) {
      unsigned u = (unsigned)ctl[4 + q];
      while (u) { int bp = __ffs(u) - 1; ctl[8 + c] = q * 32 + bp; ++c; u &= u - 1; }
    }
    ctl[1] = c;
  }
  __syncthreads();
  const int nsl = ctl[1];
  const unsigned sw0 = sel[l32 * 4 + 0], sw1 = sel[l32 * 4 + 1], sw2 = sel[l32 * 4 + 2], sw3 = sel[l32 * 4 + 3];
  {
    AttnSrc ss;
    ss.K = (const u16*)(ws + O_KS) + (long)b * T_ * 128 + g * 64; ss.ldk = 128; ss.K2 = nullptr;
    ss.V = (const u16*)(ws + O_VST) + ((long)(b * 2 + g) * 64) * T_; ss.ldv = T_;
    m = -1e30f; l = 0.f; zero_o(O);
    attn_loop<AM_SLC, 64, true, false, false, true>(smem, ss, nsl, 0, ctl + 8, qf, m, l, O, t, slope2, sw0, sw1, sw2, sw3, 0.f, nullptr, tid);
    const float lt = l;
    const float sc1 = lt > 0.f ? g1 / lt : 0.f;
#pragma unroll
    for (int db = 0; db < 2; ++db)
#pragma unroll
      for (int i = 0; i < 16; ++i) osp[8192 + (db * 16 + i) * 256] = O[db][i] * sc1;
  }
  {
    AttnSrc sw;
    sw.K = (const u16*)(ws + O_KW) + (long)b * T_ * 128 + g * 64; sw.ldk = 128; sw.K2 = nullptr;
    sw.V = (const u16*)(ws + O_VWT) + ((long)(b * 2 + g) * 64) * T_; sw.ldv = T_;
    const int lo = (t0 > 511 ? (t0 - 511) : 0) >> 6, hi = (t0 + 31) >> 6;
    m = -1e30f; l = 0.f; zero_o(O);
    attn_loop<AM_WIN, 64, true, false, false, false>(smem, sw, hi - lo + 1, lo, nullptr, qf, m, l, O, t, slope2, 0, 0, 0, 0, 0.f, nullptr, tid);
    const float lt = l;
    const float sc2 = lt > 0.f ? g2 / lt : 0.f;
#pragma unroll
    for (int db = 0; db < 2; ++db)
#pragma unroll
      for (int i = 0; i < 16; ++i) O[db][i] = O[db][i] * sc2 + osp[(db * 16 + i) * 256] + osp[8192 + (db * 16 + i) * 256];
  }
  u16* dst = (u16*)(ws + O_CONCAT) + tok * 1024 + head8 * 64;
#pragma unroll
  for (int db = 0; db < 2; ++db)
#pragma unroll
    for (int a = 0; a < 4; ++a)
      store4bf(dst + db * 32 + 8 * a + 4 * h, O[db][4 * a], O[db][4 * a + 1], O[db][4 * a + 2], O[db][4 * a + 3]);
}

DI void ln_apply_pass(const u16* src, const float* st, u16* dst, int tid, int nb) {
  const int lane = tid & 63;
  for (int row = blockIdx.x * 4 + (tid >> 6); row < M_; row += nb * 4) {
    const float mean = st[2 * row] * (1.f / 1024.f);
    const float rstd = rsqrtf(st[2 * row + 1] * (1.f / 1024.f) - mean * mean + 1e-5f);
    const u16* o = src + (long)row * 1024;
#pragma unroll
    for (int i = 0; i < 2; ++i) {
      const int c = lane * 8 + 512 * i;
      const uint4 v = *(const uint4*)(o + c);
      *(uint4*)(dst + (long)row * 1024 + c) = make_uint4(pack2((bflo(v.x) - mean) * rstd, (bfhi(v.x) - mean) * rstd), pack2((bflo(v.y) - mean) * rstd, (bfhi(v.y) - mean) * rstd),
                                                        pack2((bflo(v.z) - mean) * rstd, (bfhi(v.z) - mean) * rstd), pack2((bflo(v.w) - mean) * rstd, (bfhi(v.w) - mean) * rstd));
    }
  }
}

#ifndef REP
#define REP 0
#endif
#ifndef FAKEV
#define FAKEV 0
#endif
DI void tile_map(int i, int NT, int& mt, int& nt, int mpx = 64) {
  const int xcd = i & 7, j = i >> 3;
  const int ms = j / (8 * NT), r = j - ms * 8 * NT;
  nt = r >> 3;
  mt = xcd * mpx + ms * 8 + (r & 7);
}

template <int PMODE = 0, int FK = 0>
DI void phase4(const Params& P, unsigned char* smem, int tid, int cbase) {
  {
    int* ctr = (int*)(P.ws + O_CTR) + cbase;
    int* ctl = (int*)(smem + CTL_OFF);
    const int xcd = blockIdx.x & 7;
    bool mla_done = false;
    for (;;) {
      __syncthreads();
      if (tid == 0) {
        int it = -1;
        if (!mla_done) { int k = atomicAdd(ctr + xcd, 1); if (k < 512) it = k; }
        if (it < 0) { if (PMODE == 1) it = 8192; else { int j = atomicAdd(ctr + 8, 1); it = (j < 4096) ? 4096 + j : 8192; } }
        ctl[0] = it;
      }
      __syncthreads();
      const int item = ctl[0];
      if (item >= 8192) break;
#ifndef SKIP_MLA
      if (item < 4096) {
        const int qt = 63 - (item & 63), bh = (item >> 6) * 8 + xcd;
        mla_item<FK>(P, smem, bh >> 3, bh & 7, qt, tid);
      }
#endif
      if (item >= 4096) mla_done = true;
#ifndef SKIP_NSA
      if (item >= 4096) {
        const int j = item - 4096;
        const int tt = 255 - (j >> 4), bg = j & 15;
        nsa_item(P, smem, bg >> 1, bg & 1, tt, tid);
      }
#endif
    }
  }
}

#define XB_XCNT(j)  (64 * (j))
#define XB_XSUB(j)  (1024 + 64 * (j))
#define XB_XGEN(j)  (2048 + 64 * (j))
#define XB_TOP      3072
#define XB_TOPGEN   3136
#define XB_WORDS    3200
DI unsigned xb_ld(unsigned* p) { return __hip_atomic_load(p, __ATOMIC_RELAXED, __HIP_MEMORY_SCOPE_AGENT); }
DI unsigned xb_add(unsigned* p, unsigned v) { return __hip_atomic_fetch_add(p, v, __ATOMIC_RELAXED, __HIP_MEMORY_SCOPE_AGENT); }
DI unsigned xb_xcc_id() { return (unsigned)__builtin_amdgcn_s_getreg((3 << 11) | 20) & 0xFu; }
struct XBar { unsigned* bar; unsigned x, nloc, nx; };
DI void gsync(const XBar& b, int tid) {
  asm volatile("s_waitcnt vmcnt(0)" ::: "memory");
  __syncthreads();
  if (tid == 0) {
    unsigned* bar = b.bar;
    __builtin_amdgcn_s_waitcnt(0);
    const unsigned old = xb_add(&bar[XB_XSUB(b.x)], 1u);
    const unsigned gen = old / b.nloc;
    if (old + 1u == (gen + 1u) * b.nloc) {
      __builtin_amdgcn_fence(__ATOMIC_RELEASE, "agent");
      asm volatile("s_waitcnt vmcnt(0)" ::: "memory");
      const unsigned og = xb_add(&bar[XB_TOP], 1u);
      const unsigned tg = og / b.nx;
      if (og + 1u == (tg + 1u) * b.nx) xb_add(&bar[XB_TOPGEN], 1u);
      else while (xb_ld(&bar[XB_TOPGEN]) == tg) __builtin_amdgcn_s_sleep(1);
      __builtin_amdgcn_fence(__ATOMIC_ACQUIRE, "agent");
      xb_add(&bar[XB_XGEN(b.x)], 1u);
      asm volatile("s_waitcnt vmcnt(0)" ::: "memory");
    } else {
      while (xb_ld(&bar[XB_XGEN(b.x)]) == gen) __builtin_amdgcn_s_sleep(1);
      __builtin_amdgcn_fence(__ATOMIC_ACQUIRE, "agent");
      asm volatile("s_waitcnt vmcnt(0)" ::: "memory");
    }
  }
  __syncthreads();
}

__global__ void __launch_bounds__(256, 2) fwd_megakernel(Params P) {
  cg::grid_group grid = cg::this_grid();
  extern __shared__ __attribute__((aligned(16))) unsigned char smem[];
  const int tid = threadIdx.x;
  const int nb = gridDim.x;
  XBar xb; xb.bar = (unsigned*)(P.ws + O_BAR); xb.x = xb_xcc_id(); xb.nloc = 1u; xb.nx = 1u;
  if (tid == 0) (void)xb_add(&xb.bar[XB_XCNT(xb.x)], 1u);

#ifndef SKIP_P0
  phase0(P, smem, tid);
#endif
  if (P.ws == nullptr) grid.sync();
  if (tid == 0) {
    unsigned mine = 0u, cnt = 0u, sum = 0u;
    for (;;) {
      mine = 0u; cnt = 0u; sum = 0u;
#pragma unroll
      for (unsigned j = 0; j < 16; ++j) { const unsigned c = xb_ld(&xb.bar[XB_XCNT(j)]); sum += c; cnt += (c > 0u) ? 1u : 0u; mine = (j == xb.x) ? c : mine; }
      if (sum == gridDim.x) break;
      __builtin_amdgcn_s_sleep(1);
    }
    xb.nloc = mine > 0u ? mine : 1u; xb.nx = cnt > 0u ? cnt : 1u;
  }
  gsync(xb, tid);
#ifndef SKIP_P1
  for (int i = blockIdx.x; i < 512 * 14; i += nb) { int mt, nt; tile_map(i, 14, mt, nt); gemm_tile<PH_IN>(P, smem, mt, nt, 0, tid); }
#if REP == 11
  for (int q = 0; q < 20; ++q) gsync(xb, tid);
#endif
#if REP == 1
  gsync(xb, tid);
  for (int i = blockIdx.x; i < 512 * 14; i += nb) { int mt, nt; tile_map(i, 14, mt, nt); gemm_tile<PH_IN>(P, smem, mt, nt, 0, tid); }
#endif
#endif
  gsync(xb, tid);
#ifndef SKIP_P2
  for (int i = blockIdx.x; i < 256 + 3072 + 4096; i += nb) {
    if (i < 256) gemm_tile<PH_C1>(P, smem, (i >> 1) & 63, i & 1, i >> 7, tid);
    else if (i < 256 + 3072) { int mt, nt; tile_map(i - 256, 6, mt, nt); gemm_tile<PH_UQ>(P, smem, mt, nt, 0, tid); }
    else { int mt, nt; tile_map(i - 256 - 3072, 8, mt, nt); gemm_tile<PH_UKV>(P, smem, mt, nt, 0, tid); }
  }
#endif
#if REP == 2
  gsync(xb, tid);
  for (int i = blockIdx.x; i < 256 + 3072 + 4096; i += nb) {
    if (i < 256) gemm_tile<PH_C1>(P, smem, (i >> 1) & 63, i & 1, i >> 7, tid);
    else if (i < 256 + 3072) { int mt, nt; tile_map(i - 256, 6, mt, nt); gemm_tile<PH_UQ>(P, smem, mt, nt, 0, tid); }
    else { int mt, nt; tile_map(i - 256 - 3072, 8, mt, nt); gemm_tile<PH_UKV>(P, smem, mt, nt, 0, tid); }
  }
#endif
  gsync(xb, tid);
#ifndef SKIP_P3
  for (int i = blockIdx.x; i < 128; i += nb) gemm_tile<PH_C2>(P, smem, i & 63, 0, i >> 6, tid);
#endif
  gsync(xb, tid);
  phase4(P, smem, tid, 0);
#if REP == 4
  gsync(xb, tid);
  phase4<0, 0>(P, smem, tid, 16);
#endif
#if REP == 41
  gsync(xb, tid);
  phase4<1, FAKEV>(P, smem, tid, 16);
#endif
  gsync(xb, tid);
  {
    u16* pb = (u16*)(P.ws + O_PB);
    for (long i = (long)blockIdx.x * 256 + tid; i < (long)M_ * 256 / 8; i += (long)nb * 256) {
      const float4 a = *(const float4*)(P.p + i * 8), b = *(const float4*)(P.p + i * 8 + 4);
      *(uint4*)(pb + i * 8) = make_uint4(pack2(a.x, a.y), pack2(a.z, a.w), pack2(b.x, b.y), pack2(b.z, b.w));
    }
  }
#ifndef SKIP_P5
  for (int i = blockIdx.x; i < 256 * 8; i += nb) { int mt, nt; tile_map(i, 8, mt, nt, 32); gemm_tile<PH_OUT>(P, smem, mt, nt, 0, tid); }
#endif
  gsync(xb, tid);
#ifndef SKIP_P6
  for (int i = blockIdx.x; i < 256 * 44; i += nb) { int mt, nt; tile_map(i, 44, mt, nt, 32); gemm_tile<PH_UP>(P, smem, mt, nt, 0, tid); }
#if REP == 6
  gsync(xb, tid);
  for (int i = blockIdx.x; i < 256 * 44; i += nb) { int mt, nt; tile_map(i, 44, mt, nt, 32); gemm_tile<PH_UP, FAKEV>(P, smem, mt, nt, 0, tid); }
#endif
#endif
  gsync(xb, tid);
#ifndef SKIP_P7
  for (int i = blockIdx.x; i < 256 * 8; i += nb) { int mt, nt; tile_map(i, 8, mt, nt, 32); gemm_tile<PH_DOWN>(P, smem, mt, nt, 0, tid); }
#endif
  gsync(xb, tid);
#ifndef SKIP_P8
  for (int i = blockIdx.x; i < 256 * 8; i += nb) { int mt, nt; tile_map(i, 8, mt, nt, 32); gemm_tile<PH_PLE>(P, smem, mt, nt, 0, tid); }
#endif
  gsync(xb, tid);
  {
    const float* st3 = (const float*)(P.ws + O_STATS) + (long)M_ * 4;
    const int lane = tid & 63;
    for (int row = blockIdx.x * 4 + (tid >> 6); row < M_; row += nb * 4) {
      const float mean = st3[2 * row] * (1.f / 1024.f);
      const float rstd = rsqrtf(st3[2 * row + 1] * (1.f / 1024.f) - mean * mean + 1e-5f);
      float* o = P.out + (long)row * 1024;
      const u16* yb = (const u16*)(P.ws + O_CONCAT) + (long)row * 1024;
#pragma unroll
      for (int i = 0; i < 4; ++i) {
        const int c = lane * 4 + 256 * i;
        const uint2 yq = *(const uint2*)(yb + c);
        float4 v = make_float4(bflo(yq.x), bfhi(yq.x), bflo(yq.y), bfhi(yq.y));
        const float4 gg = *(const float4*)(P.ln3_g + c);
        const float4 bb = *(const float4*)(P.ln3_b + c);
        v.x = (v.x - mean) * rstd * gg.x + bb.x;
        v.y = (v.y - mean) * rstd * gg.y + bb.y;
        v.z = (v.z - mean) * rstd * gg.z + bb.z;
        v.w = (v.w - mean) * rstd * gg.w + bb.w;
        *(float4*)(o + c) = v;
      }
    }
  }
}

extern "C" void kernel_launch(void* const* d_in, const int* in_sizes, int n_in,
                              void* d_out, int out_size, void* d_ws, size_t ws_size,
                              hipStream_t stream) {
  static int grid_blocks = 0;
  if (!grid_blocks) {
    int dev = 0, cus = 0, per_cu = 0;
    (void)hipGetDevice(&dev);
    (void)hipDeviceGetAttribute(&cus, hipDeviceAttributeMultiprocessorCount, dev);
    (void)hipFuncSetAttribute((const void*)fwd_megakernel, hipFuncAttributeMaxDynamicSharedMemorySize, LDS_TOTAL);
    (void)hipOccupancyMaxActiveBlocksPerMultiprocessor(&per_cu, fwd_megakernel, 256, LDS_TOTAL);
    if (per_cu < 1) per_cu = 1;
    if (per_cu > 2) per_cu = 2;
    grid_blocks = cus * per_cu;
    fprintf(stderr, "grid_blocks=%d (cus=%d per_cu=%d) ws_need=%zu ws_size=%zu\n", grid_blocks, cus, per_cu, (size_t)WS_NEED, ws_size);
  }
  if (ws_size < WS_NEED || n_in < 24) { fprintf(stderr, "kernel_launch: workspace too small or bad inputs\n"); return; }
  (void)hipMemsetAsync((unsigned char*)d_ws + O_BAR, 0, 16384, stream);
  Params p{};
  const float** pp = (const float**)&p;
  for (int i = 0; i < 24; ++i) pp[i] = (const float*)d_in[i];
  p.out = (float*)d_out;
  p.ws = (unsigned char*)d_ws;
  void* args[] = {&p};
  hipError_t e = hipLaunchCooperativeKernel((void*)fwd_megakernel, dim3(grid_blocks), dim3(256), args, LDS_TOTAL, stream);
  if (e != hipSuccess) fprintf(stderr, "cooperative launch failed: %s (grid %d)\n", hipGetErrorString(e), grid_blocks);
}
```

```cpp
#include <hip/hip_runtime.h>
#include <hip/hip_cooperative_groups.h>
#include <cstdio>
#include <cstdint>
namespace cg = cooperative_groups;

#define DI __device__ __forceinline__
typedef unsigned short u16;
typedef unsigned long long u64;
typedef __attribute__((ext_vector_type(8))) short bf16x8;
typedef __attribute__((ext_vector_type(4))) short s16x4;
typedef __attribute__((ext_vector_type(4))) float f32x4;
typedef __attribute__((ext_vector_type(16))) float f32x16;
typedef __attribute__((ext_vector_type(2))) __bf16 bf2_t;

constexpr int T_ = 8192;
constexpr int M_ = 65536;
constexpr float ALPHA_ = 1.189207115002721f;
constexpr float LOG2E_ = 1.4426950408889634f;

constexpr size_t AL(size_t x) { return (x + 255) & ~(size_t)255; }
constexpr size_t O_WT_IN   = 0;
constexpr size_t O_WT_UQ   = O_WT_IN   + AL((size_t)1792 * 1024 * 2);
constexpr size_t O_WT_UKV  = O_WT_UQ   + AL((size_t)768 * 256 * 2);
constexpr size_t O_WT_CK1  = O_WT_UKV  + AL((size_t)1024 * 128 * 2);
constexpr size_t O_WT_CV1  = O_WT_CK1  + AL((size_t)256 * 2048 * 2);
constexpr size_t O_WT_CK2  = O_WT_CV1  + AL((size_t)256 * 2048 * 2);
constexpr size_t O_WT_CV2  = O_WT_CK2  + AL((size_t)128 * 256 * 2);
constexpr size_t O_WT_OUT  = O_WT_CV2  + AL((size_t)128 * 256 * 2);
constexpr size_t O_WT_UP   = O_WT_OUT  + AL((size_t)1024 * 1024 * 2);
constexpr size_t O_WT_DOWN = O_WT_UP   + AL((size_t)5632 * 1024 * 2);
constexpr size_t O_WT_GATE = O_WT_DOWN + AL((size_t)1024 * 2816 * 2);
constexpr size_t O_WT_PLE  = O_WT_GATE + AL((size_t)1024 * 1024 * 2);
constexpr size_t O_BIAS1K  = O_WT_PLE  + AL((size_t)1024 * 256 * 2);
constexpr size_t O_BIAS1V  = O_BIAS1K  + AL(256 * 4);
constexpr size_t O_BIAS_UP = O_BIAS1V  + AL(256 * 4);
constexpr size_t O_BIAS_G  = O_BIAS_UP + AL(5632 * 4);
constexpr size_t O_CSUM_UP = O_BIAS_G  + AL(1024 * 4);
constexpr size_t O_CSUM_G  = O_CSUM_UP + AL(5632 * 4);
constexpr size_t O_ROPE_C  = O_CSUM_G  + AL(1024 * 4);
constexpr size_t O_ROPE_S  = O_ROPE_C  + AL((size_t)8192 * 16 * 4);
constexpr size_t O_STATS   = O_ROPE_S  + AL((size_t)8192 * 16 * 4);
constexpr size_t O_SSQ     = O_STATS   + AL((size_t)3 * M_ * 2 * 4);
constexpr size_t O_CTR     = O_SSQ     + AL((size_t)2 * M_ * 4);
constexpr size_t O_BAR     = O_CTR     + 256;
constexpr size_t O_HID     = O_BAR     + 16384;
constexpr size_t O_CMPK    = O_HID     + AL((size_t)2 * 8192 * 256 * 2);
constexpr size_t O_CMPVT   = O_CMPK    + AL((size_t)16 * 512 * 64 * 2);
constexpr size_t O_CONCAT  = O_CMPVT   + AL((size_t)16 * 64 * 512 * 2);
constexpr size_t O_Y2      = O_CONCAT  + AL((size_t)M_ * 1024 * 2);
constexpr size_t O_R1      = O_Y2      + AL((size_t)M_ * 1024 * 4);
constexpr size_t O_QN      = O_R1;
constexpr size_t O_KC      = O_QN   + AL((size_t)M_ * 512 * 2);
constexpr size_t O_VC      = O_KC   + AL((size_t)M_ * 128 * 2);
constexpr size_t O_KS      = O_VC   + AL((size_t)M_ * 128 * 2);
constexpr size_t O_VST     = O_KS   + AL((size_t)M_ * 128 * 2);
constexpr size_t O_KW      = O_VST  + AL((size_t)M_ * 128 * 2);
constexpr size_t O_VWT     = O_KW   + AL((size_t)M_ * 128 * 2);
constexpr size_t O_CQ      = O_VWT  + AL((size_t)M_ * 128 * 2);
constexpr size_t O_CKV     = O_CQ   + AL((size_t)M_ * 256 * 2);
constexpr size_t O_KPE     = O_CKV  + AL((size_t)M_ * 128 * 2);
constexpr size_t O_GATES   = O_KPE  + AL((size_t)M_ * 32 * 2);
constexpr size_t O_QM      = O_GATES + AL((size_t)M_ * 24 * 4);
constexpr size_t O_KN      = O_QM   + AL((size_t)M_ * 768 * 2);
constexpr size_t O_VMT     = O_KN   + AL((size_t)M_ * 512 * 2);
constexpr size_t O_R1_END  = O_VMT  + AL((size_t)M_ * 512 * 2);
constexpr size_t O_HBUF    = O_R1;
constexpr size_t O_PB      = O_R1 + AL((size_t)M_ * 2816 * 2);
static_assert(O_PB + (size_t)M_ * 256 * 2 <= O_R1_END, "PB alias");
static_assert(O_R1_END - O_R1 >= (size_t)M_ * 2816 * 2, "HBUF alias too small");
constexpr size_t O_YB      = O_R1_END;
constexpr size_t WS_NEED   = O_YB + AL((size_t)M_ * 1024 * 2);
static_assert(WS_NEED <= (size_t)1073741824, "workspace budget (4 x largest tensor)");

struct Params {
  const float *x, *p, *w_in, *w_ck1, *w_ck2, *pos_ck, *w_cv1, *w_cv2, *pos_cv, *qn_g, *w_uq, *kvn_g, *w_ukv, *w_out,
      *ln1_g, *ln1_b, *w_up, *w_down, *ln2_g, *ln2_b, *w_pg, *w_ple, *ln3_g, *ln3_b;
  float* out;
  unsigned char* ws;
};

DI unsigned pack2(float a, float b) { bf2_t v; v[0] = (__bf16)a; v[1] = (__bf16)b; return __builtin_bit_cast(unsigned, v); }
DI void store4bf(u16* p, float a, float b, float c, float d) { *(uint2*)p = make_uint2(pack2(a, b), pack2(c, d)); }
DI float bflo(unsigned u) { return __uint_as_float(u << 16); }
DI float bfhi(unsigned u) { return __uint_as_float(u & 0xffff0000u); }
DI float sigmoid_(float x) { return 1.f / (1.f + __expf(-x)); }
DI float gelu_tanh_(float x) {
  float u = 0.7978845608028654f * (x + 0.044715f * x * x * x);
  float e = __expf(2.f * u);
  float th = 1.f - 2.f / (e + 1.f);
  return 0.5f * x * (1.f + th);
}
DI float ex2(float x) { return __builtin_amdgcn_exp2f(x); }
#define MFMA16(a, b, c) __builtin_amdgcn_mfma_f32_16x16x32_bf16((a), (b), (c), 0, 0, 0)
#define MFMA32(a, b, c) __builtin_amdgcn_mfma_f32_32x32x16_bf16((a), (b), (c), 0, 0, 0)

DI int map_in(int n) {
  if (n < 1280) return n;
  if (n < 1536) return 1304 + (n - 1280);
  if (n < 1664) return 1560 + (n - 1536);
  if (n < 1696) return 1688 + (n - 1664);
  if (n < 1720) return 1280 + (n - 1696);
  return -1;
}
DI int map_up(int n) {
  int t = n >> 7, c = n & 127, wc = c >> 6, j = (c >> 4) & 3, i = c & 15;
  int base = 64 * t + wc * 32 + (i >> 2) * 8 + (j & 1) * 4 + (i & 3);
  return (j < 2) ? base : 2816 + base;
}

struct TJob { const float* src; u16* dst; const float* scale; int K, Nsrc, map; };
DI TJob get_tjob(const Params& P, int j) {
  TJob t; t.scale = nullptr; t.map = 0;
  unsigned char* ws = P.ws;
  switch (j) {
    case 0: t.src = P.w_in; t.dst = (u16*)(ws + O_WT_IN); t.K = 1024; t.Nsrc = 1720; t.map = 1; break;
    case 1: t.src = P.w_uq; t.dst = (u16*)(ws + O_WT_UQ); t.K = 256; t.Nsrc = 768; t.scale = P.qn_g; break;
    case 2: t.src = P.w_ukv; t.dst = (u16*)(ws + O_WT_UKV); t.K = 128; t.Nsrc = 1024; t.scale = P.kvn_g; break;
    case 3: t.src = P.w_ck1; t.dst = (u16*)(ws + O_WT_CK1); t.K = 2048; t.Nsrc = 256; break;
    case 4: t.src = P.w_cv1; t.dst = (u16*)(ws + O_WT_CV1); t.K = 2048; t.Nsrc = 256; break;
    case 5: t.src = P.w_ck2; t.dst = (u16*)(ws + O_WT_CK2); t.K = 256; t.Nsrc = 64; break;
    case 6: t.src = P.w_cv2; t.dst = (u16*)(ws + O_WT_CV2); t.K = 256; t.Nsrc = 64; break;
    case 7: t.src = P.w_out; t.dst = (u16*)(ws + O_WT_OUT); t.K = 1024; t.Nsrc = 1024; break;
    case 8: t.src = P.w_up; t.dst = (u16*)(ws + O_WT_UP); t.K = 1024; t.Nsrc = 5632; t.map = 2; t.scale = P.ln1_g; break;
    case 9: t.src = P.w_down; t.dst = (u16*)(ws + O_WT_DOWN); t.K = 2816; t.Nsrc = 1024; break;
    case 10: t.src = P.w_pg; t.dst = (u16*)(ws + O_WT_GATE); t.K = 1024; t.Nsrc = 1024; t.scale = P.ln2_g; break;
    default: t.src = P.w_ple; t.dst = (u16*)(ws + O_WT_PLE); t.K = 256; t.Nsrc = 1024; break;
  }
  return t;
}

DI void phase0(const Params& P, unsigned char* smem, int tid) {
  const int NTL[12] = {448, 48, 32, 128, 128, 4, 4, 256, 1408, 704, 256, 64};
  constexpr int TOT_T = 3480;
  constexpr int TOT_U = TOT_T + 1728;
  float* tl = (float*)smem;
  for (int pass = 0; pass < 2; ++pass) {
  if ((pass ^ (int)(blockIdx.x >> 3)) & 1) {
  for (int u = blockIdx.x; u < TOT_U; u += gridDim.x) {
    __syncthreads();
    if (u < TOT_T) {
      int j = 0, ti = u;
#pragma unroll
      for (int q = 0; q < 12; ++q) { if (j == q && ti >= NTL[q]) { ti -= NTL[q]; j = q + 1; } }
      TJob jb = get_tjob(P, j);
      const int nkt = jb.K >> 6;
      const int k0 = (ti % nkt) * 64, n0 = (ti / nkt) * 64;
#pragma unroll
      for (int i = 0; i < 16; ++i) {
        int kk = i * 4 + (tid >> 6), nn = tid & 63;
        int n = n0 + nn;
        int sn = (jb.map == 1) ? map_in(n) : (jb.map == 2 ? map_up(n) : n);
        float v = 0.f;
        if (sn >= 0) v = jb.src[(long)(k0 + kk) * jb.Nsrc + sn];
        if (jb.scale) v *= jb.scale[k0 + kk];
        tl[kk * 65 + nn] = v;
      }
      __syncthreads();
      {
        int n = tid >> 2, kq = tid & 3;
        unsigned w[8];
#pragma unroll
        for (int e = 0; e < 8; ++e) w[e] = pack2(tl[(kq * 16 + 2 * e) * 65 + n], tl[(kq * 16 + 2 * e + 1) * 65 + n]);
        u16* d = jb.dst + (long)(n0 + n) * jb.K + k0 + kq * 16;
        *(uint4*)d = make_uint4(w[0], w[1], w[2], w[3]);
        *(uint4*)(d + 8) = make_uint4(w[4], w[5], w[6], w[7]);
      }
    } else {
      int bu = u - TOT_T;
      const float* vec; const float* W; float* dst; int K, Nsrc, mp = 0;
      if (bu < 32) { vec = P.pos_ck; W = P.w_ck1; dst = (float*)(P.ws + O_BIAS1K); K = 2048; Nsrc = 256; }
      else if (bu < 64) { bu -= 32; vec = P.pos_cv; W = P.w_cv1; dst = (float*)(P.ws + O_BIAS1V); K = 2048; Nsrc = 256; }
      else if (bu < 768) { bu -= 64; vec = P.ln1_b; W = P.w_up; dst = (float*)(P.ws + O_BIAS_UP); K = 1024; Nsrc = 5632; mp = 2; }
      else if (bu < 896) { bu -= 768; vec = P.ln2_b; W = P.w_pg; dst = (float*)(P.ws + O_BIAS_G); K = 1024; Nsrc = 1024; }
      else if (bu < 1600) { bu -= 896; vec = P.ln1_g; W = P.w_up; dst = (float*)(P.ws + O_CSUM_UP); K = 1024; Nsrc = 5632; mp = 2; }
      else { bu -= 1600; vec = P.ln2_g; W = P.w_pg; dst = (float*)(P.ws + O_CSUM_G); K = 1024; Nsrc = 1024; }
      int c = tid & 7, kg = tid >> 3;
      int n = bu * 8 + c;
      int sn = (mp == 2) ? map_up(n) : n;
      float s = 0.f;
#pragma unroll 8
      for (int k = kg; k < K; k += 32) s += vec[k] * W[(long)k * Nsrc + sn];
      tl[kg * 8 + c] = s;
      __syncthreads();
      if (tid < 8) {
        float a = 0.f;
#pragma unroll
        for (int q = 0; q < 32; ++q) a += tl[q * 8 + tid];
        dst[bu * 8 + tid] = a;
      }
    }
  }
  } else {
    const long gtid0 = (long)blockIdx.x * 256 + tid, gstr0 = (long)gridDim.x * 256;
    u16* xb = (u16*)(P.ws + O_CONCAT);
    for (long i = gtid0; i < (long)M_ * 1024 / 8; i += gstr0) {
      const float4 a = *(const float4*)(P.x + i * 8), b = *(const float4*)(P.x + i * 8 + 4);
      *(uint4*)(xb + i * 8) = make_uint4(pack2(a.x, a.y), pack2(a.z, a.w), pack2(b.x, b.y), pack2(b.z, b.w));
    }
  }
  }
  const long gtid = (long)blockIdx.x * 256 + tid, gstr = (long)gridDim.x * 256;
  float* rc = (float*)(P.ws + O_ROPE_C);
  float* rs = (float*)(P.ws + O_ROPE_S);
  for (long i = gtid; i < 8192 * 16; i += gstr) {
    int pos = (int)(i >> 4), f = (int)(i & 15);
    float inv = powf(10000.0f, -(float)f / 16.0f);
    float ang = (float)pos * inv;
    rc[i] = cosf(ang); rs[i] = sinf(ang);
  }
  float* st = (float*)(P.ws + O_STATS);
  for (long i = gtid; i < (long)3 * M_ * 2; i += gstr) st[i] = 0.f;
  { float* sq = (float*)(P.ws + O_SSQ); for (long i = gtid; i < (long)2 * M_; i += gstr) sq[i] = 0.f; }
  if (gtid < 64) ((int*)(P.ws + O_CTR))[gtid] = 0;
}

constexpr int LDS_BUF = 32768;
constexpr int LDS_RS_OFF = 2 * LDS_BUF;

template <int AMODE, int FAKE = 0>
DI void gemm_mainloop(f32x4 (&acc)[4][4], unsigned char* smem, const void* A, long lda, int m0, int K,
                      const u16* Bt, int n0, const float* stats, bool ns, int tid) {
  const int lane = tid & 63, wave = tid >> 6, wm = wave >> 1, wn = wave & 1;
  const int l16 = lane & 15, lq = lane >> 4;
  const int crow = tid >> 3, cch = tid & 7;
  int gtok0 = 0;
  const int nk = K >> 6;
  const int swz = (cch ^ (crow & 7)) * 8;
  const unsigned boff = ((unsigned)(n0 + crow) * (unsigned)K + (unsigned)cch * 8u) * 2u;
  const unsigned bstrb = 64u * (unsigned)K;
  unsigned aoff = 0u; const unsigned astrb = 64u * (unsigned)lda;
  if constexpr (AMODE == 0) aoff = ((unsigned)(m0 + crow) * (unsigned)lda + (unsigned)cch * 8u) * 2u;
  if constexpr (AMODE == 3) { const int r_ = m0 + crow; const int bg_ = r_ >> 9; gtok0 = (r_ & 511) * 16;
    aoff = ((unsigned)(bg_ >> 1) * (unsigned)T_ * 128u + (unsigned)(bg_ & 1) * 64u + (unsigned)cch * 8u) * 2u; }
  const unsigned gch = (unsigned)(cch ^ (crow & 7)) * 16u;
  const unsigned boffd = ((unsigned)(n0 + crow) * (unsigned)K) * 2u + gch;
  unsigned aoffd = 0u;
  if constexpr (AMODE == 0) aoffd = ((unsigned)(m0 + crow) * (unsigned)lda) * 2u + gch;
  if constexpr (AMODE == 3) { const int r_ = m0 + crow; const int bg_ = r_ >> 9;
    aoffd = ((unsigned)(bg_ >> 1) * (unsigned)T_ * 128u + (unsigned)(bg_ & 1) * 64u) * 2u + gch; }
  const int wbase = __builtin_amdgcn_readfirstlane(wave) * 1024;
#define GP(base_, off_) ((const unsigned*)((const char*)(base_) + (unsigned)(off_)))
#define LP(BUF, off_) ((unsigned*)(smem + (BUF) * LDS_BUF + wbase + (off_)))
#define D_LOAD(BUF, ks) { const unsigned qb_ = boffd + (unsigned)(ks) * 128u; \
    __builtin_amdgcn_global_load_lds(GP(Bt, qb_), LP(BUF, 16384), 16, 0, 0); \
    __builtin_amdgcn_global_load_lds(GP(Bt, qb_ + bstrb), LP(BUF, 16384 + 4096), 16, 0, 0); \
    __builtin_amdgcn_global_load_lds(GP(Bt, qb_ + 2u * bstrb), LP(BUF, 16384 + 8192), 16, 0, 0); \
    __builtin_amdgcn_global_load_lds(GP(Bt, qb_ + 3u * bstrb), LP(BUF, 16384 + 12288), 16, 0, 0); \
    if constexpr (AMODE == 0) { const unsigned qa_ = aoffd + (unsigned)(ks) * 128u; \
      __builtin_amdgcn_global_load_lds(GP(A, qa_), LP(BUF, 0), 16, 0, 0); \
      __builtin_amdgcn_global_load_lds(GP(A, qa_ + astrb), LP(BUF, 4096), 16, 0, 0); \
      __builtin_amdgcn_global_load_lds(GP(A, qa_ + 2u * astrb), LP(BUF, 8192), 16, 0, 0); \
      __builtin_amdgcn_global_load_lds(GP(A, qa_ + 3u * astrb), LP(BUF, 12288), 16, 0, 0); } \
    else { \
      __builtin_amdgcn_global_load_lds(GP(A, aoffd + (unsigned)min(gtok0 + (ks), T_ - 1) * 256u), LP(BUF, 0), 16, 0, 0); \
      __builtin_amdgcn_global_load_lds(GP(A, aoffd + (unsigned)min(gtok0 + 512 + (ks), T_ - 1) * 256u), LP(BUF, 4096), 16, 0, 0); \
      __builtin_amdgcn_global_load_lds(GP(A, aoffd + (unsigned)min(gtok0 + 1024 + (ks), T_ - 1) * 256u), LP(BUF, 8192), 16, 0, 0); \
      __builtin_amdgcn_global_load_lds(GP(A, aoffd + (unsigned)min(gtok0 + 1536 + (ks), T_ - 1) * 256u), LP(BUF, 12288), 16, 0, 0); } }
#define D_SYNC() { asm volatile("s_waitcnt vmcnt(0)" ::: "memory"); asm volatile("s_waitcnt lgkmcnt(0)" ::: "memory"); __builtin_amdgcn_s_barrier(); asm volatile("" ::: "memory"); }
#define G_ROW(mi, fa_) \
      if (ns) { acc[mi][0] = MFMA16(fa_, fb0, acc[mi][0]); acc[mi][1] = MFMA16(fa_, fb1, acc[mi][1]); acc[mi][2] = MFMA16(fa_, fb2, acc[mi][2]); acc[mi][3] = MFMA16(fa_, fb3, acc[mi][3]); } \
      else    { acc[mi][0] = MFMA16(fb0, fa_, acc[mi][0]); acc[mi][1] = MFMA16(fb1, fa_, acc[mi][1]); acc[mi][2] = MFMA16(fb2, fa_, acc[mi][2]); acc[mi][3] = MFMA16(fb3, fa_, acc[mi][3]); }
#define G_HALF(BUF, kk) { \
      const int co = (((kk) * 4 + lq) ^ (l16 & 7)) * 8; \
      const u16* pa = (const u16*)(smem + (BUF) * LDS_BUF) + (wm * 64 + l16) * 64 + co; \
      const u16* pb = (const u16*)(smem + (BUF) * LDS_BUF) + 8192 + (wn * 64 + l16) * 64 + co; \
      const bf16x8 fa0 = *(const bf16x8*)pa, fa1 = *(const bf16x8*)(pa + 16 * 64), fa2 = *(const bf16x8*)(pa + 32 * 64), fa3 = *(const bf16x8*)(pa + 48 * 64); \
      const bf16x8 fb0 = *(const bf16x8*)pb, fb1 = *(const bf16x8*)(pb + 16 * 64), fb2 = *(const bf16x8*)(pb + 32 * 64), fb3 = *(const bf16x8*)(pb + 48 * 64); \
      G_ROW(0, fa0) G_ROW(1, fa1) G_ROW(2, fa2) G_ROW(3, fa3) }
#define R_STEP(CUR, ks) { \
    if ((ks) + 1 < nk && FAKE != 1) D_LOAD((CUR) ^ 1, (ks) + 1) \
    __builtin_amdgcn_sched_barrier(0); \
    if (FAKE != 2) { G_HALF(CUR, 0) G_HALF(CUR, 1) } \
    D_SYNC() }
  __syncthreads();
  D_LOAD(0, 0)
  D_SYNC()
  for (int ks = 0; ks < nk; ks += 2) {
    R_STEP(0, ks)
    if (ks + 1 < nk) R_STEP(1, ks + 1)
  }
#undef GP
#undef LP
#undef D_LOAD
#undef D_SYNC
#undef G_ROW
#undef G_HALF
#undef R_STEP
}

constexpr int LDS_BIG = 24576;
template <int FAKE = 0>
DI void gemm_mainloop_big(f32x4 (&acc)[8][4], unsigned char* smem, const void* A, long lda, int m0, int K,
                          const u16* Bt, int n0, bool ns, int tid) {
  const int lane = tid & 63, wave = tid >> 6, wm = wave >> 1, wn = wave & 1;
  const int l16 = lane & 15, lq = lane >> 4;
  const int nk = K >> 5;
  const int prow = lane >> 2, ppos = lane & 3;
  const unsigned gch = (unsigned)(ppos ^ ((4 - ((lane >> 4) & 3)) & 3)) * 16u;
  const unsigned aoffd = ((unsigned)(m0 + 16 * wave + prow) * (unsigned)lda) * 2u + gch;
  const unsigned boffd = ((unsigned)(n0 + 16 * wave + prow) * (unsigned)K) * 2u + gch;
  const unsigned astrb = 128u * (unsigned)lda, bstrb = 128u * (unsigned)K;
  const int wbase = __builtin_amdgcn_readfirstlane(wave) * 1024;
#define GP(base_, off_) ((const unsigned*)((const char*)(base_) + (unsigned)(off_)))
#define LP(BUF, off_) ((unsigned*)(smem + (BUF) * LDS_BIG + wbase + (off_)))
#define D_LOAD(BUF, ks) { const unsigned ko_ = (unsigned)(ks) * 64u; \
    __builtin_amdgcn_global_load_lds(GP(A, aoffd + ko_), LP(BUF, 0), 16, 0, 0); \
    __builtin_amdgcn_global_load_lds(GP(A, aoffd + ko_ + astrb), LP(BUF, 4096), 16, 0, 0); \
    __builtin_amdgcn_global_load_lds(GP(A, aoffd + ko_ + 2u * astrb), LP(BUF, 8192), 16, 0, 0); \
    __builtin_amdgcn_global_load_lds(GP(A, aoffd + ko_ + 3u * astrb), LP(BUF, 12288), 16, 0, 0); \
    __builtin_amdgcn_global_load_lds(GP(Bt, boffd + ko_), LP(BUF, 16384), 16, 0, 0); \
    __builtin_amdgcn_global_load_lds(GP(Bt, boffd + ko_ + bstrb), LP(BUF, 16384 + 4096), 16, 0, 0); }
#define D_SYNC() { asm volatile("s_waitcnt vmcnt(0)" ::: "memory"); asm volatile("s_waitcnt lgkmcnt(0)" ::: "memory"); __builtin_amdgcn_s_barrier(); asm volatile("" ::: "memory"); }
  const int pp = (lq ^ ((4 - ((l16 >> 2) & 3)) & 3)) * 8;
#define B_ROW(mi) { const bf16x8 fa_ = *(const bf16x8*)(pa + (mi) * 16 * 32); \
      if (ns) { acc[mi][0] = MFMA16(fa_, fb0, acc[mi][0]); acc[mi][1] = MFMA16(fa_, fb1, acc[mi][1]); acc[mi][2] = MFMA16(fa_, fb2, acc[mi][2]); acc[mi][3] = MFMA16(fa_, fb3, acc[mi][3]); } \
      else    { acc[mi][0] = MFMA16(fb0, fa_, acc[mi][0]); acc[mi][1] = MFMA16(fb1, fa_, acc[mi][1]); acc[mi][2] = MFMA16(fb2, fa_, acc[mi][2]); acc[mi][3] = MFMA16(fb3, fa_, acc[mi][3]); } }
#define B_COMPUTE(BUF) { \
      const u16* pa = (const u16*)(smem + (BUF) * LDS_BIG) + (wm * 128 + l16) * 32 + pp; \
      const u16* pb = (const u16*)(smem + (BUF) * LDS_BIG + 16384) + (wn * 64 + l16) * 32 + pp; \
      const bf16x8 fb0 = *(const bf16x8*)pb, fb1 = *(const bf16x8*)(pb + 16 * 32), fb2 = *(const bf16x8*)(pb + 32 * 32), fb3 = *(const bf16x8*)(pb + 48 * 32); \
      B_ROW(0) B_ROW(1) B_ROW(2) B_ROW(3) B_ROW(4) B_ROW(5) B_ROW(6) B_ROW(7) }
#define B_STEP(CUR, ks) { \
    if ((ks) + 1 < nk && FAKE != 1) D_LOAD((CUR) ^ 1, (ks) + 1) \
    __builtin_amdgcn_sched_barrier(0); \
    if (FAKE != 2) B_COMPUTE(CUR) \
    D_SYNC() }
  __syncthreads();
  D_LOAD(0, 0)
  D_SYNC()
  for (int ks = 0; ks < nk; ks += 2) {
    B_STEP(0, ks)
    if (ks + 1 < nk) B_STEP(1, ks + 1)
  }
#undef GP
#undef LP
#undef D_LOAD
#undef D_SYNC
#undef B_ROW
#undef B_COMPUTE
#undef B_STEP
}

template <int MI>
DI void zero_acc(f32x4 (&acc)[MI][4]) {
#pragma unroll
  for (int i = 0; i < MI; ++i)
#pragma unroll
    for (int j = 0; j < 4; ++j) acc[i][j] = f32x4{0.f, 0.f, 0.f, 0.f};
}

DI void stat_push(float* stats, int tok, float s1, float s2, int lq) {
  s1 += __shfl_xor(s1, 16); s2 += __shfl_xor(s2, 16);
  s1 += __shfl_xor(s1, 32); s2 += __shfl_xor(s2, 32);
  if (lq == 0) { atomicAdd(stats + 2 * (long)tok, s1); atomicAdd(stats + 2 * (long)tok + 1, s2); }
}

enum { PH_IN = 1, PH_UQ, PH_UKV, PH_C1, PH_C2, PH_OUT, PH_UP, PH_DOWN, PH_PLE };

template <int PH, int FAKE = 0>
DI void gemm_tile(const Params& P, unsigned char* smem, int mt, int nt, int which, int tid_in) {
  int tid = tid_in;
  asm volatile("" : "+v"(tid));
  unsigned char* ws = P.ws;
  const int lane = tid & 63, wave = tid >> 6, wm = wave >> 1, wn = wave & 1;
  const int l16 = lane & 15, lq = lane >> 4;
  constexpr int MI = (PH == PH_OUT || PH == PH_UP || PH == PH_DOWN || PH == PH_PLE) ? 8 : 4;
  constexpr int WR = MI * 16;
  const int m0 = mt * (2 * WR), n0 = nt * 128;
  f32x4 acc[MI][4];
  zero_acc<MI>(acc);
  float* rsq = (float*)(smem + LDS_RS_OFF);

  if constexpr (PH == PH_IN) {
    const bool ns = (nt == 7 || nt == 9);
    gemm_mainloop<0>(acc, smem, (const u16*)(ws + O_CONCAT), 1024, m0, 1024, (const u16*)(ws + O_WT_IN), n0, nullptr, ns, tid);
    const float QSC = 0.125f * LOG2E_;
#pragma unroll
    for (int mi = 0; mi < MI; ++mi) {
      if (!ns) {
        const int tok = m0 + wm * WR + mi * 16 + l16;
        if (nt < 4) {
#pragma unroll
          for (int nj = 0; nj < 4; ++nj) {
            int col = n0 + wn * 64 + nj * 16 + lq * 4;
            f32x4 a = acc[mi][nj];
            store4bf((u16*)(ws + O_QN) + (long)tok * 512 + col, a[0] * QSC, a[1] * QSC, a[2] * QSC, a[3] * QSC);
          }
        } else if (nt == 4 || nt == 5 || nt == 6 || nt == 8 || nt == 12) {
          u16* dst = (u16*)(ws + (nt == 4 ? O_KC : nt == 5 ? O_VC : nt == 6 ? O_KS : nt == 8 ? O_KW : O_CKV));
          float ss = 0.f;
#pragma unroll
          for (int nj = 0; nj < 4; ++nj) {
            int col = wn * 64 + nj * 16 + lq * 4;
            f32x4 a = acc[mi][nj];
            ss += a[0] * a[0] + a[1] * a[1] + a[2] * a[2] + a[3] * a[3];
            store4bf(dst + (long)tok * 128 + col, a[0], a[1], a[2], a[3]);
          }
          if (nt == 12) {
            ss += __shfl_xor(ss, 16); ss += __shfl_xor(ss, 32);
            if (lq == 0) atomicAdd((float*)(ws + O_SSQ) + M_ + tok, ss);
          }
        } else if (nt == 10 || nt == 11) {
          float ss = 0.f;
#pragma unroll
          for (int nj = 0; nj < 4; ++nj) {
            int col = (nt - 10) * 128 + wn * 64 + nj * 16 + lq * 4;
            f32x4 a = acc[mi][nj];
            ss += a[0] * a[0] + a[1] * a[1] + a[2] * a[2] + a[3] * a[3];
            store4bf((u16*)(ws + O_CQ) + (long)tok * 256 + col, a[0], a[1], a[2], a[3]);
          }
          ss += __shfl_xor(ss, 16); ss += __shfl_xor(ss, 32);
          if (lq == 0) atomicAdd((float*)(ws + O_SSQ) + tok, ss);
        } else {
          if (wn == 0) {
            const int pos = tok & (T_ - 1);
            const float4 cs = *(const float4*)((const float*)(ws + O_ROPE_C) + pos * 16 + lq * 4);
            const float4 sn = *(const float4*)((const float*)(ws + O_ROPE_S) + pos * 16 + lq * 4);
            f32x4 x1 = acc[mi][0], x2 = acc[mi][1];
            u16* kp = (u16*)(ws + O_KPE) + (long)tok * 32;
            store4bf(kp + lq * 4, x1[0] * cs.x - x2[0] * sn.x, x1[1] * cs.y - x2[1] * sn.y, x1[2] * cs.z - x2[2] * sn.z, x1[3] * cs.w - x2[3] * sn.w);
            store4bf(kp + 16 + lq * 4, x2[0] * cs.x + x1[0] * sn.x, x2[1] * cs.y + x1[1] * sn.y, x2[2] * cs.z + x1[2] * sn.z, x2[3] * cs.w + x1[3] * sn.w);
            float* gp = (float*)(ws + O_GATES) + (long)tok * 24;
            f32x4 g0 = acc[mi][2], g1 = acc[mi][3];
            *(float4*)(gp + lq * 4) = make_float4(sigmoid_(g0[0]), sigmoid_(g0[1]), sigmoid_(g0[2]), sigmoid_(g0[3]));
            if (lq < 2) *(float4*)(gp + 16 + lq * 4) = make_float4(sigmoid_(g1[0]), sigmoid_(g1[1]), sigmoid_(g1[2]), sigmoid_(g1[3]));
          }
        }
      } else {
        const int tok4 = m0 + wm * WR + mi * 16 + lq * 4;
        const int b = tok4 >> 13, t = tok4 & (T_ - 1);
        u16* dstb = (u16*)(ws + (nt == 7 ? O_VST : O_VWT));
#pragma unroll
        for (int nj = 0; nj < 4; ++nj) {
          int c = wn * 64 + nj * 16 + l16, g = c >> 6, d = c & 63;
          f32x4 a = acc[mi][nj];
          store4bf(dstb + ((long)((b * 2 + g) * 64 + d)) * T_ + t, a[0], a[1], a[2], a[3]);
        }
      }
    }
  }

  if constexpr (PH == PH_UQ || PH == PH_UKV) {
    constexpr int K = (PH == PH_UQ) ? 256 : 128;
    const u16* A = (const u16*)(ws + (PH == PH_UQ ? O_CQ : O_CKV));
    __syncthreads();
    if (tid < 128) {
      const float ss = ((const float*)(ws + O_SSQ))[(PH == PH_UQ ? 0 : M_) + m0 + tid];
      rsq[tid] = rsqrtf(ss * (1.f / K) + 1e-6f);
    }
    if constexpr (PH == PH_UQ) {
      gemm_mainloop<0>(acc, smem, A, 256, m0, 256, (const u16*)(ws + O_WT_UQ), n0, nullptr, false, tid);
      const float SC = 0.10206207261596577f * LOG2E_;
#pragma unroll
      for (int mi = 0; mi < MI; ++mi) {
        const int tok = m0 + wm * WR + mi * 16 + l16;
        const float rs = rsq[wm * WR + mi * 16 + l16] * SC;
        const int pos = tok & (T_ - 1);
        const int ct0 = nt * 8 + wn * 4;
#pragma unroll
        for (int njp = 0; njp < 4; njp += 2) {
          f32x4 a = acc[mi][njp], b2 = acc[mi][njp + 1];
          if (((ct0 + njp) % 6) == 4) {
            const float4 cs = *(const float4*)((const float*)(ws + O_ROPE_C) + pos * 16 + lq * 4);
            const float4 sn = *(const float4*)((const float*)(ws + O_ROPE_S) + pos * 16 + lq * 4);
            f32x4 o1, o2;
            o1[0] = a[0] * cs.x - b2[0] * sn.x; o2[0] = b2[0] * cs.x + a[0] * sn.x;
            o1[1] = a[1] * cs.y - b2[1] * sn.y; o2[1] = b2[1] * cs.y + a[1] * sn.y;
            o1[2] = a[2] * cs.z - b2[2] * sn.z; o2[2] = b2[2] * cs.z + a[2] * sn.z;
            o1[3] = a[3] * cs.w - b2[3] * sn.w; o2[3] = b2[3] * cs.w + a[3] * sn.w;
            a = o1; b2 = o2;
          }
          u16* dst = (u16*)(ws + O_QM) + (long)tok * 768 + n0 + wn * 64 + njp * 16 + lq * 4;
          store4bf(dst, a[0] * rs, a[1] * rs, a[2] * rs, a[3] * rs);
          store4bf(dst + 16, b2[0] * rs, b2[1] * rs, b2[2] * rs, b2[3] * rs);
        }
      }
    } else {
      const bool ns = (wn == 1);
      gemm_mainloop<0>(acc, smem, A, 128, m0, 128, (const u16*)(ws + O_WT_UKV), n0, nullptr, ns, tid);
#pragma unroll
      for (int mi = 0; mi < MI; ++mi) {
        if (!ns) {
          const int tok = m0 + wm * WR + mi * 16 + l16;
          const float rs = rsq[wm * WR + mi * 16 + l16];
#pragma unroll
          for (int nj = 0; nj < 4; ++nj) {
            f32x4 a = acc[mi][nj];
            store4bf((u16*)(ws + O_KN) + (long)tok * 512 + nt * 64 + nj * 16 + lq * 4, a[0] * rs, a[1] * rs, a[2] * rs, a[3] * rs);
          }
        } else {
          const int lr = wm * WR + mi * 16 + lq * 4;
          const int tok4 = m0 + lr;
          const int b = tok4 >> 13, t = tok4 & (T_ - 1);
          const float r0 = rsq[lr], r1 = rsq[lr + 1], r2 = rsq[lr + 2], r3 = rsq[lr + 3];
#pragma unroll
          for (int nj = 0; nj < 4; ++nj) {
            int d = nj * 16 + l16;
            f32x4 a = acc[mi][nj];
            store4bf((u16*)(ws + O_VMT) + ((long)((b * 8 + nt) * 64 + d)) * T_ + t, a[0] * r0, a[1] * r1, a[2] * r2, a[3] * r3);
          }
        }
      }
    }
  }

  if constexpr (PH == PH_C1) {
    const u16* A = (const u16*)(ws + (which ? O_VC : O_KC));
    const u16* Bt = (const u16*)(ws + (which ? O_WT_CV1 : O_WT_CK1));
    const float* bias = (const float*)(ws + (which ? O_BIAS1V : O_BIAS1K));
    gemm_mainloop<3>(acc, smem, A, 128, m0, 2048, Bt, n0, nullptr, false, tid);
    u16* hid = (u16*)(ws + O_HID) + (long)which * 8192 * 256;
#pragma unroll
    for (int mi = 0; mi < MI; ++mi) {
      const int row = m0 + wm * WR + mi * 16 + l16;
#pragma unroll
      for (int nj = 0; nj < 4; ++nj) {
        int col = n0 + wn * 64 + nj * 16 + lq * 4;
        const float4 bb = *(const float4*)(bias + col);
        f32x4 a = acc[mi][nj];
        store4bf(hid + (long)row * 256 + col, gelu_tanh_(a[0] + bb.x), gelu_tanh_(a[1] + bb.y), gelu_tanh_(a[2] + bb.z), gelu_tanh_(a[3] + bb.w));
      }
    }
  }

  if constexpr (PH == PH_C2) {
    const u16* A = (const u16*)(ws + O_HID) + (long)which * 8192 * 256;
    const u16* Bt = (const u16*)(ws + (which ? O_WT_CV2 : O_WT_CK2));
    const bool ns = (which == 1);
    gemm_mainloop<0>(acc, smem, A, 256, m0, 256, Bt, 0, nullptr, ns, tid);
    if (wn == 0) {
#pragma unroll
      for (int mi = 0; mi < MI; ++mi) {
        if (!ns) {
          const int row = m0 + wm * WR + mi * 16 + l16;
#pragma unroll
          for (int nj = 0; nj < 4; ++nj) {
            f32x4 a = acc[mi][nj];
            store4bf((u16*)(ws + O_CMPK) + (long)row * 64 + nj * 16 + lq * 4, a[0], a[1], a[2], a[3]);
          }
        } else {
          const int r4 = m0 + wm * WR + mi * 16 + lq * 4;
          const int bg = r4 >> 9, c = r4 & 511;
#pragma unroll
          for (int nj = 0; nj < 4; ++nj) {
            int d = nj * 16 + l16;
            f32x4 a = acc[mi][nj];
            store4bf((u16*)(ws + O_CMPVT) + ((long)(bg * 64 + d)) * 512 + c, a[0], a[1], a[2], a[3]);
          }
        }
      }
    }
  }

  if constexpr (PH == PH_OUT) {
    gemm_mainloop_big<0>(acc, smem, (const u16*)(ws + O_CONCAT), 1024, m0, 1024, (const u16*)(ws + O_WT_OUT), n0, false, tid);
    float* stats = (float*)(ws + O_STATS);
#pragma unroll
    for (int mi = 0; mi < MI; ++mi) {
      const int tok = m0 + wm * WR + mi * 16 + l16;
      float s1 = 0.f, s2 = 0.f;
#pragma unroll
      for (int nj = 0; nj < 4; ++nj) {
        int col = n0 + wn * 64 + nj * 16 + lq * 4;
        const float4 xv = *(const float4*)(P.x + (long)tok * 1024 + col);
        f32x4 a = acc[mi][nj];
        float4 y = make_float4(ALPHA_ * xv.x + a[0], ALPHA_ * xv.y + a[1], ALPHA_ * xv.z + a[2], ALPHA_ * xv.w + a[3]);
        store4bf((u16*)(ws + O_YB) + (long)tok * 1024 + col, y.x, y.y, y.z, y.w);
        s1 += y.x + y.y + y.z + y.w;
        s2 += y.x * y.x + y.y * y.y + y.z * y.z + y.w * y.w;
      }
      stat_push(stats, tok, s1, s2, lq);
    }
  }

  if constexpr (PH == PH_UP) {
    gemm_mainloop_big<FAKE>(acc, smem, (const u16*)(ws + O_YB), 1024, m0, 1024, (const u16*)(ws + O_WT_UP), n0, false, tid);
    if (FAKE != 0 && acc[0][0][0] + acc[3][3][3] + acc[1][2][1] != 123456.75f) return;
    const float* bias = (const float*)(ws + O_BIAS_UP);
    const float* csum = (const float*)(ws + O_CSUM_UP);
    const float* st1 = (const float*)(ws + O_STATS);
    const int cb0 = n0 + wn * 64 + lq * 4;
    const float4 bgv[2] = {*(const float4*)(bias + cb0), *(const float4*)(bias + cb0 + 16)};
    const float4 buv[2] = {*(const float4*)(bias + cb0 + 32), *(const float4*)(bias + cb0 + 48)};
    const float4 cgv[2] = {*(const float4*)(csum + cb0), *(const float4*)(csum + cb0 + 16)};
    const float4 cuv[2] = {*(const float4*)(csum + cb0 + 32), *(const float4*)(csum + cb0 + 48)};
#pragma unroll
    for (int mi = 0; mi < MI; ++mi) {
      const int tok = m0 + wm * WR + mi * 16 + l16;
      const float mean = st1[2 * tok] * (1.f / 1024.f);
      const float rstd = rsqrtf(st1[2 * tok + 1] * (1.f / 1024.f) - mean * mean + 1e-5f);
      unsigned hw[4];
#pragma unroll
      for (int nj = 0; nj < 2; ++nj) {
        const float4 bg = bgv[nj], bu = buv[nj], cg = cgv[nj], cu = cuv[nj];
        f32x4 g = acc[mi][nj], u = acc[mi][nj + 2];
        float h0, h1, h2, h3, v;
        v = rstd * (g[0] - mean * cg.x) + bg.x; h0 = v * sigmoid_(v) * (rstd * (u[0] - mean * cu.x) + bu.x);
        v = rstd * (g[1] - mean * cg.y) + bg.y; h1 = v * sigmoid_(v) * (rstd * (u[1] - mean * cu.y) + bu.y);
        v = rstd * (g[2] - mean * cg.z) + bg.z; h2 = v * sigmoid_(v) * (rstd * (u[2] - mean * cu.z) + bu.z);
        v = rstd * (g[3] - mean * cg.w) + bg.w; h3 = v * sigmoid_(v) * (rstd * (u[3] - mean * cu.w) + bu.w);
        hw[2 * nj] = pack2(h0, h1); hw[2 * nj + 1] = pack2(h2, h3);
      }
      *(uint4*)((u16*)(ws + O_HBUF) + (long)tok * 2816 + nt * 64 + wn * 32 + lq * 8) = make_uint4(hw[0], hw[1], hw[2], hw[3]);
    }
  }

  if constexpr (PH == PH_DOWN) {
    gemm_mainloop_big<0>(acc, smem, (const u16*)(ws + O_HBUF), 2816, m0, 2816, (const u16*)(ws + O_WT_DOWN), n0, false, tid);
    const float* st1 = (const float*)(ws + O_STATS);
    float* st2 = (float*)(ws + O_STATS) + (long)M_ * 2;
    u16* yb = (u16*)(ws + O_YB);
#pragma unroll
    for (int mi = 0; mi < MI; ++mi) {
      const int tok = m0 + wm * WR + mi * 16 + l16;
      const float mean = st1[2 * tok] * (1.f / 1024.f);
      const float rstd = rsqrtf(st1[2 * tok + 1] * (1.f / 1024.f) - mean * mean + 1e-5f);
      float s1 = 0.f, s2 = 0.f;
#pragma unroll
      for (int nj = 0; nj < 4; ++nj) {
        int col = n0 + wn * 64 + nj * 16 + lq * 4;
        const uint2 yq = *(const uint2*)(yb + (long)tok * 1024 + col);
        const float4 yv = make_float4(bflo(yq.x), bfhi(yq.x), bflo(yq.y), bfhi(yq.y));
        const float4 gg = *(const float4*)(P.ln1_g + col);
        const float4 bb = *(const float4*)(P.ln1_b + col);
        f32x4 a = acc[mi][nj];
        float4 y;
        y.x = ALPHA_ * ((yv.x - mean) * rstd * gg.x + bb.x) + a[0];
        y.y = ALPHA_ * ((yv.y - mean) * rstd * gg.y + bb.y) + a[1];
        y.z = ALPHA_ * ((yv.z - mean) * rstd * gg.z + bb.z) + a[2];
        y.w = ALPHA_ * ((yv.w - mean) * rstd * gg.w + bb.w) + a[3];
        store4bf(yb + (long)tok * 1024 + col, y.x, y.y, y.z, y.w);
        s1 += y.x + y.y + y.z + y.w;
        s2 += y.x * y.x + y.y * y.y + y.z * y.z + y.w * y.w;
      }
      stat_push(st2, tok, s1, s2, lq);
    }
  }

  if constexpr (PH == PH_PLE) {
    const float* st2 = (const float*)(ws + O_STATS) + (long)M_ * 2;
    float* st3 = (float*)(ws + O_STATS) + (long)M_ * 4;
    u16* yb = (u16*)(ws + O_YB);
    gemm_mainloop_big<0>(acc, smem, (const u16*)(ws + O_YB), 1024, m0, 1024, (const u16*)(ws + O_WT_GATE), n0, false, tid);
    const float* bias = (const float*)(ws + O_BIAS_G);
    uint4* gsp4 = (uint4*)(ws + O_HBUF) + (long)(mt * 8 + nt) * 16 * 256;
    const int cg0 = n0 + wn * 64 + lq * 4;
    const float4 gbv[4] = {*(const float4*)(bias + cg0), *(const float4*)(bias + cg0 + 16), *(const float4*)(bias + cg0 + 32), *(const float4*)(bias + cg0 + 48)};
    const float* csg = (const float*)(ws + O_CSUM_G);
    const float4 gcv[4] = {*(const float4*)(csg + cg0), *(const float4*)(csg + cg0 + 16), *(const float4*)(csg + cg0 + 32), *(const float4*)(csg + cg0 + 48)};
#pragma unroll
    for (int mi = 0; mi < MI; ++mi) {
      const int tok = m0 + wm * WR + mi * 16 + l16;
      const float mean_g = st2[2 * tok] * (1.f / 1024.f);
      const float rstd_g = rsqrtf(st2[2 * tok + 1] * (1.f / 1024.f) - mean_g * mean_g + 1e-5f);
      unsigned gw[8];
#pragma unroll
      for (int nj = 0; nj < 4; ++nj) {
        const float4 bb = gbv[nj], cs = gcv[nj];
        f32x4 a = acc[mi][nj];
        gw[2 * nj] = pack2(sigmoid_(rstd_g * (a[0] - mean_g * cs.x) + bb.x), sigmoid_(rstd_g * (a[1] - mean_g * cs.y) + bb.y));
        gw[2 * nj + 1] = pack2(sigmoid_(rstd_g * (a[2] - mean_g * cs.z) + bb.z), sigmoid_(rstd_g * (a[3] - mean_g * cs.w) + bb.w));
      }
      gsp4[(mi * 2 + 0) * 256 + tid] = make_uint4(gw[0], gw[1], gw[2], gw[3]);
      gsp4[(mi * 2 + 1) * 256 + tid] = make_uint4(gw[4], gw[5], gw[6], gw[7]);
    }
    zero_acc<MI>(acc);
    gemm_mainloop_big<0>(acc, smem, (const u16*)(ws + O_PB), 256, m0, 256, (const u16*)(ws + O_WT_PLE), n0, false, tid);
#pragma unroll
    for (int mi = 0; mi < MI; ++mi) {
      const int tok = m0 + wm * WR + mi * 16 + l16;
      const float mean = st2[2 * tok] * (1.f / 1024.f);
      const float rstd = rsqrtf(st2[2 * tok + 1] * (1.f / 1024.f) - mean * mean + 1e-5f);
      float s1 = 0.f, s2 = 0.f;
      const uint4 gqa = gsp4[(mi * 2 + 0) * 256 + tid], gqb = gsp4[(mi * 2 + 1) * 256 + tid];
#pragma unroll
      for (int nj = 0; nj < 4; ++nj) {
        int col = n0 + wn * 64 + nj * 16 + lq * 4;
        const uint2 yq = *(const uint2*)(yb + (long)tok * 1024 + col);
        const float4 yv = make_float4(bflo(yq.x), bfhi(yq.x), bflo(yq.y), bfhi(yq.y));
        const float4 gg = *(const float4*)(P.ln2_g + col);
        const float4 bb = *(const float4*)(P.ln2_b + col);
        f32x4 a = acc[mi][nj];
        const unsigned g01 = (nj == 0) ? gqa.x : (nj == 1) ? gqa.z : (nj == 2) ? gqb.x : gqb.z;
        const unsigned g23 = (nj == 0) ? gqa.y : (nj == 1) ? gqa.w : (nj == 2) ? gqb.y : gqb.w;
        float4 y;
        y.x = ALPHA_ * ((yv.x - mean) * rstd * gg.x + bb.x) + bflo(g01) * a[0];
        y.y = ALPHA_ * ((yv.y - mean) * rstd * gg.y + bb.y) + bfhi(g01) * a[1];
        y.z = ALPHA_ * ((yv.z - mean) * rstd * gg.z + bb.z) + bflo(g23) * a[2];
        y.w = ALPHA_ * ((yv.w - mean) * rstd * gg.w + bb.w) + bfhi(g23) * a[3];
        store4bf((u16*)(ws + O_CONCAT) + (long)tok * 1024 + col, y.x, y.y, y.z, y.w);
        s1 += y.x + y.y + y.z + y.w;
        s2 += y.x * y.x + y.y * y.y + y.z * y.z + y.w * y.w;
      }
      stat_push(st3, tok, s1, s2, lq);
    }
  }
}

constexpr int LDS_TOTAL = 2 * LDS_BUF + 512;
constexpr int CTL_OFF = 53248;
constexpr int SEL_OFF = CTL_OFF + 1024;
constexpr int IMP_OFF = 35840;
static_assert(IMP_OFF + 32 * 130 * 4 <= CTL_OFF, "lds");
static_assert(SEL_OFF + 512 <= LDS_TOTAL, "lds");

struct AttnSrc { const u16* K; long ldk; const u16* K2; const u16* V; long ldv; };
enum { AM_MLA = 0, AM_WIN = 1, AM_SLC = 2, AM_CMP = 3 };

template <int MODE, int DQ, bool DO_PV, bool FIXED_M, bool DO_IMP, bool USE_LIST, int FK = 0>
DI void attn_loop(unsigned char* smem, const AttnSrc src, int ntiles, int tile_lo, const int* tlist,
                  const bf16x8 (&qf)[DQ / 16], float& m, float& l, f32x16 (&O)[2], int t, float slope2,
                  unsigned sw0, unsigned sw1, unsigned sw2, unsigned sw3, float inv_l, unsigned* imp, int tid_in) {
  int tid = tid_in;
  asm volatile("" : "+v"(tid));
  constexpr int KST = DQ + 8;
  constexpr int KCH = DQ / 8;
  constexpr int NKL = KCH * 64 / 256;
  constexpr int KBYTES = 64 * KST * 2;
  constexpr int VST = 68;
  constexpr int VBYTES = 64 * VST * 2;
  const int lane = tid & 63, l32 = lane & 31, h = lane >> 5;
  u16* sK0 = (u16*)smem;
  u16* sV0 = (u16*)(smem + 2 * KBYTES);
  uint4 rk0, rk1, rk2, rv0, rv1;
  const int kr0 = tid / KCH, kc0 = tid % KCH;
  const int kr1 = (tid + 256) / KCH, kc1 = (tid + 256) % KCH;
  const int kr2 = (tid + 512) / KCH, kc2 = (tid + 512) % KCH;
  const int vr0 = tid >> 3, vc0 = tid & 7;
#define A_KLD(dst_, row_, ch_, tile_) { \
    if constexpr (MODE == AM_MLA) { \
      if ((ch_) < 8) dst_ = *(const uint4*)(src.K + ((long)(tile_) * 64 + (row_)) * src.ldk + (ch_) * 8); \
      else dst_ = *(const uint4*)(src.K2 + ((long)(tile_) * 64 + (row_)) * 32 + ((ch_) - 8) * 8); \
    } else dst_ = *(const uint4*)(src.K + ((long)(tile_) * 64 + (row_)) * src.ldk + (ch_) * 8); }
#define A_GLOAD(tile_) { \
    A_KLD(rk0, kr0, kc0, tile_) A_KLD(rk1, kr1, kc1, tile_) \
    if constexpr (NKL == 3) A_KLD(rk2, kr2, kc2, tile_) \
    if constexpr (DO_PV) { \
      rv0 = *(const uint4*)(src.V + (long)vr0 * src.ldv + (long)(tile_) * 64 + vc0 * 8); \
      rv1 = *(const uint4*)(src.V + (long)(vr0 + 32) * src.ldv + (long)(tile_) * 64 + vc0 * 8); } }
#define A_LSTORE(buf_) { \
    u16* sK_ = sK0 + (buf_) * (KBYTES / 2); u16* sV_ = sV0 + (buf_) * (VBYTES / 2); \
    *(uint4*)(sK_ + kr0 * KST + kc0 * 8) = rk0; *(uint4*)(sK_ + kr1 * KST + kc1 * 8) = rk1; \
    if constexpr (NKL == 3) *(uint4*)(sK_ + kr2 * KST + kc2 * 8) = rk2; \
    if constexpr (DO_PV) { \
      *(uint2*)(sV_ + vr0 * VST + vc0 * 8) = make_uint2(rv0.x, rv0.y); *(uint2*)(sV_ + vr0 * VST + vc0 * 8 + 4) = make_uint2(rv0.z, rv0.w); \
      *(uint2*)(sV_ + (vr0 + 32) * VST + vc0 * 8) = make_uint2(rv1.x, rv1.y); *(uint2*)(sV_ + (vr0 + 32) * VST + vc0 * 8 + 4) = make_uint2(rv1.z, rv1.w); } }
  __syncthreads();
  if (ntiles > 0) { const int tf = USE_LIST ? tlist[0] : tile_lo; A_GLOAD(tf) A_LSTORE(0) }
  __syncthreads();
  for (int it = 0; it < ntiles; ++it) {
    const int tile = USE_LIST ? tlist[it] : tile_lo + it;
    if (it + 1 < ntiles && FK != 1) { const int tn = USE_LIST ? tlist[it + 1] : tile_lo + it + 1; A_GLOAD(tn) }
    __builtin_amdgcn_sched_barrier(0);
    const u16* sK = sK0 + (it & 1) * (KBYTES / 2);
    const u16* sV = sV0 + (it & 1) * (VBYTES / 2);
    f32x16 S[2];
#pragma unroll
    for (int kb = 0; kb < 2; ++kb) {
#pragma unroll
      for (int i = 0; i < 16; ++i) S[kb][i] = 0.f;
#pragma unroll
      for (int s = 0; s < DQ / 16; ++s) {
        bf16x8 kf = *(const bf16x8*)(sK + (kb * 32 + l32) * KST + s * 16 + h * 8);
        S[kb] = MFMA32(kf, qf[s], S[kb]);
      }
    }
    float c0 = 0.f;
    {
      constexpr int MUL = (MODE == AM_CMP) ? 16 : 1;
      int d0;
      if constexpr (MODE == AM_CMP) d0 = t - 31 - 16 * (tile * 64 + 4 * h);
      else d0 = t - tile * 64 - 4 * h;
      bool need = true;
      if constexpr (MODE == AM_MLA) need = (tile * 64 + 63 > t - l32);
      bool selbit = true;
      if constexpr (MODE == AM_SLC) {
        const int w = tile >> 5;
        const unsigned swd = (w == 0) ? sw0 : (w == 1) ? sw1 : (w == 2) ? sw2 : sw3;
        selbit = (swd >> (tile & 31)) & 1u;
      }
      bool full = false;
      if constexpr (MODE != AM_MLA) {
        const int tw = t - l32;
        if constexpr (MODE == AM_CMP) full = ((tile * 64 + 63) * 16 + 31 <= tw);
        if constexpr (MODE == AM_WIN) full = (tile * 64 + 63 <= tw) && (tw + 31 - tile * 64 < 512);
        if constexpr (MODE == AM_SLC) full = (tile * 64 + 63 <= tw) && __all(selbit);
      }
      const float fd0 = (float)d0;
      if constexpr (MODE != AM_MLA) {
#pragma unroll
        for (int kb = 0; kb < 2; ++kb)
#pragma unroll
          for (int i = 0; i < 16; ++i) {
            const float ci = (float)(MUL * ((i & 3) + 8 * (i >> 2) + 32 * kb));
            S[kb][i] = fmaf(slope2, ci, S[kb][i]);
          }
      }
      c0 = (MODE != AM_MLA) ? -slope2 * fd0 : 0.f;
      if (need && !full) {
#pragma unroll
        for (int kb = 0; kb < 2; ++kb)
#pragma unroll
          for (int i = 0; i < 16; ++i) {
            const float ci = (float)(MUL * ((i & 3) + 8 * (i >> 2) + 32 * kb));
            const float dist = fd0 - ci;
            bool valid = dist >= 0.f;
            if constexpr (MODE == AM_WIN) valid = valid && (dist < 512.f);
            if constexpr (MODE == AM_SLC) valid = valid && selbit;
            S[kb][i] = valid ? S[kb][i] : -INFINITY;
          }
      }
    }
    if constexpr (FK != 2) {
    if constexpr (!FIXED_M) {
      float tmax = -INFINITY;
#pragma unroll
      for (int kb = 0; kb < 2; ++kb)
#pragma unroll
        for (int i = 0; i < 16; ++i) tmax = fmaxf(tmax, S[kb][i]);
      tmax += c0;
      tmax = fmaxf(tmax, __shfl_xor(tmax, 32));
      const bool need = tmax > m + 8.f;
      if (__any(need)) {
        const float mnew = need ? tmax : m;
        const float alpha = ex2(m - mnew);
        m = mnew;
        l *= alpha;
        if constexpr (DO_PV) {
#pragma unroll
          for (int db = 0; db < 2; ++db)
#pragma unroll
            for (int i = 0; i < 16; ++i) O[db][i] *= alpha;
        }
      }
    }
    const float mx = m - c0;
    {
      float ps = 0.f;
#pragma unroll
      for (int kb = 0; kb < 2; ++kb)
#pragma unroll
        for (int i = 0; i < 16; ++i) { float p = ex2(S[kb][i] - mx); S[kb][i] = p; ps += p; }
      l += ps;
    }
    }
    if constexpr (DO_IMP) {
#pragma unroll
      for (int kb = 0; kb < 2; ++kb)
#pragma unroll
        for (int a = 0; a < 4; ++a) {
          const float p0 = S[kb][4 * a] * inv_l, p1 = S[kb][4 * a + 1] * inv_l, p2 = S[kb][4 * a + 2] * inv_l, p3 = S[kb][4 * a + 3] * inv_l;
          const float mainv = 2.f * (p0 + p1 + p2) + p3;
          const int n = tile * 16 + kb * 8 + 2 * a + h;
          atomicAdd(imp + l32 * 130 + n, (unsigned)(mainv * 268435456.f));
          atomicAdd(imp + l32 * 130 + n + 1, (unsigned)(p3 * 268435456.f));
        }
    }
    if (it + 1 < ntiles) { A_LSTORE((it + 1) & 1) }
    if constexpr (DO_PV) {
#pragma unroll
      for (int sp = 0; sp < 4; ++sp) {
        const int kb = sp >> 1, hf = sp & 1;
        unsigned w0 = pack2(S[kb][8 * hf + 0], S[kb][8 * hf + 1]);
        unsigned w1 = pack2(S[kb][8 * hf + 2], S[kb][8 * hf + 3]);
        unsigned w2 = pack2(S[kb][8 * hf + 4], S[kb][8 * hf + 5]);
        unsigned w3 = pack2(S[kb][8 * hf + 6], S[kb][8 * hf + 7]);
        uint4 pw = make_uint4(w0, w1, w2, w3);
        bf16x8 pf = __builtin_bit_cast(bf16x8, pw);
#pragma unroll
        for (int db = 0; db < 2; ++db) {
          const u16* vp = sV + (db * 32 + l32) * VST + 16 * sp + 4 * h;
          s16x4 lo = *(const s16x4*)vp;
          s16x4 hi = *(const s16x4*)(vp + 8);
          bf16x8 vf = __builtin_shufflevector(lo, hi, 0, 1, 2, 3, 4, 5, 6, 7);
          O[db] = MFMA32(vf, pf, O[db]);
        }
      }
    }
    __syncthreads();
  }
  l += __shfl_xor(l, 32);
#undef A_KLD
#undef A_GLOAD
#undef A_LSTORE
}

DI void zero_o(f32x16 (&O)[2]) {
#pragma unroll
  for (int db = 0; db < 2; ++db)
#pragma unroll
    for (int i = 0; i < 16; ++i) O[db][i] = 0.f;
}

template <int FK = 0>
DI void mla_item(const Params& P, unsigned char* smem, int b, int hh, int qt, int tid_in) {
  int tid = tid_in;
  asm volatile("" : "+v"(tid));
  unsigned char* ws = P.ws;
  const int lane = tid & 63, w = tid >> 6, l32 = lane & 31, h = lane >> 5;
  const int t = qt * 128 + w * 32 + l32;
  const long tok = (long)b * T_ + t;
  bf16x8 qf[6];
#pragma unroll
  for (int s = 0; s < 6; ++s) qf[s] = *(const bf16x8*)((const u16*)(ws + O_QM) + tok * 768 + hh * 96 + s * 16 + h * 8);
  float m = -1e30f, l = 0.f;
  f32x16 O[2];
  zero_o(O);
  AttnSrc src;
  src.K = (const u16*)(ws + O_KN) + (long)b * T_ * 512 + hh * 64; src.ldk = 512;
  src.K2 = (const u16*)(ws + O_KPE) + (long)b * T_ * 32;
  src.V = (const u16*)(ws + O_VMT) + ((long)(b * 8 + hh) * 64) * T_; src.ldv = T_;
  attn_loop<AM_MLA, 96, true, false, false, false, FK>(smem, src, 2 * qt + 2, 0, nullptr, qf, m, l, O, t, 0.f, 0, 0, 0, 0, 0.f, nullptr, tid);
  if (FK != 0 && O[0][0] + O[1][5] + l != 123456.75f) return;
  const float lt = l;
  const float inv = lt > 0.f ? 1.f / lt : 0.f;
  u16* dst = (u16*)(ws + O_CONCAT) + tok * 1024 + 512 + hh * 64;
#pragma unroll
  for (int db = 0; db < 2; ++db)
#pragma unroll
    for (int a = 0; a < 4; ++a)
      store4bf(dst + db * 32 + 8 * a + 4 * h, O[db][4 * a] * inv, O[db][4 * a + 1] * inv, O[db][4 * a + 2] * inv, O[db][4 * a + 3] * inv);
}

DI u64 mk_key(int n, unsigned v, int cur) {
  if (n > cur) return 0ull;
  if (n == 0 || n == cur || n == cur - 1) v = 0xFFFFFFFFu;
  return ((u64)v << 8) | (u64)(128 - n);
}

DI void nsa_item(const Params& P, unsigned char* smem, int b, int g, int tt, int tid_in) {
  int tid = tid_in;
  asm volatile("" : "+v"(tid));
  unsigned char* ws = P.ws;
  const int lane = tid & 63, w = tid >> 6, l32 = lane & 31, h = lane >> 5;
  const int t0 = tt * 32;
  const int t = t0 + l32;
  const long tok = (long)b * T_ + t;
  const int head8 = g * 4 + w;
  int* ctl = (int*)(smem + CTL_OFF);
  unsigned* sel = (unsigned*)(smem + SEL_OFF);
  unsigned* imp = (unsigned*)(smem + IMP_OFF);
  bf16x8 qf[4];
#pragma unroll
  for (int s = 0; s < 4; ++s) qf[s] = *(const bf16x8*)((const u16*)(ws + O_QN) + tok * 512 + head8 * 64 + s * 16 + h * 8);
  const float* gp = (const float*)(ws + O_GATES) + tok * 24 + head8 * 3;
  const float g0 = gp[0], g1 = gp[1], g2 = gp[2];
  const float slope2 = LOG2E_ * exp2f(-(float)(head8 + 1));
  __syncthreads();
  for (int i = tid; i < 32 * 130; i += 256) imp[i] = 0u;
  if (tid < 4) ctl[4 + tid] = 0;
  f32x16 O[2];
  float m = -1e30f, l = 0.f;
  float* osp = (float*)(ws + O_Y2) + (long)blockIdx.x * 16384 + tid;
  AttnSrc sc;
  sc.K = (const u16*)(ws + O_CMPK) + ((long)(b * 2 + g) * 512) * 64; sc.ldk = 64; sc.K2 = nullptr;
  sc.V = (const u16*)(ws + O_CMPVT) + ((long)(b * 2 + g) * 64) * 512; sc.ldv = 512;
  const int ntc = (t0 >> 10) + 1;
  attn_loop<AM_CMP, 64, false, false, false, false>(smem, sc, ntc, 0, nullptr, qf, m, l, O, t, slope2, 0, 0, 0, 0, 0.f, nullptr, tid);
  {
    const float lt = l;
    const float inv_l = lt > 0.f ? 1.f / lt : 0.f;
    zero_o(O);
    float l2 = 0.f;
    attn_loop<AM_CMP, 64, true, true, true, false>(smem, sc, ntc, 0, nullptr, qf, m, l2, O, t, slope2, 0, 0, 0, 0, inv_l, imp, tid);
    const float sc0 = g0 * inv_l;
#pragma unroll
    for (int db = 0; db < 2; ++db)
#pragma unroll
      for (int i = 0; i < 16; ++i) osp[(db * 16 + i) * 256] = O[db][i] * sc0;
  }
  for (int tk = 0; tk < 8; ++tk) {
    const int token = w * 8 + tk;
    const int cur = (t0 + token) >> 6;
    const u64 k0 = mk_key(lane, imp[token * 130 + lane], cur);
    const u64 k1 = mk_key(lane + 64, imp[token * 130 + lane + 64], cur);
    u64 thr = 0ull;
    for (int bit = 39; bit >= 0; --bit) {
      const u64 cand = thr | (1ull << bit);
      const int c = __popcll(__ballot(k0 >= cand)) + __popcll(__ballot(k1 >= cand));
      if (c >= 16) thr = cand;
    }
    const u64 m0 = __ballot(k0 >= thr && k0 > 0ull);
    const u64 m1 = __ballot(k1 >= thr && k1 > 0ull);
    if (lane == 0) {
      sel[token * 4 + 0] = (unsigned)m0; sel[token * 4 + 1] = (unsigned)(m0 >> 32);
      sel[token * 4 + 2] = (unsigned)m1; sel[token * 4 + 3] = (unsigned)(m1 >> 32);
      atomicOr((unsigned*)&ctl[4], (unsigned)m0); atomicOr((unsigned*)&ctl[5], (unsigned)(m0 >> 32));
      atomicOr((unsigned*)&ctl[6], (unsigned)m1); atomicOr((unsigned*)&ctl[7], (unsigned)(m1 >> 32));
    }
  }
  __syncthreads();
  if (tid == 0) {
    int c = 0;
    for (int q = 0; q < 4; ++q) {
      unsigned u = (unsigned)ctl[4 + q];
      while (u) { int bp = __ffs(u) - 1; ctl[8 + c] = q * 32 + bp; ++c; u &= u - 1; }
    }
    ctl[1] = c;
  }
  __syncthreads();
  const int nsl = ctl[1];
  const unsigned sw0 = sel[l32 * 4 + 0], sw1 = sel[l32 * 4 + 1], sw2 = sel[l32 * 4 + 2], sw3 = sel[l32 * 4 + 3];
  {
    AttnSrc ss;
    ss.K = (const u16*)(ws + O_KS) + (long)b * T_ * 128 + g * 64; ss.ldk = 128; ss.K2 = nullptr;
    ss.V = (const u16*)(ws + O_VST) + ((long)(b * 2 + g) * 64) * T_; ss.ldv = T_;
    m = -1e30f; l = 0.f; zero_o(O);
    attn_loop<AM_SLC, 64, true, false, false, true>(smem, ss, nsl, 0, ctl + 8, qf, m, l, O, t, slope2, sw0, sw1, sw2, sw3, 0.f, nullptr, tid);
    const float lt = l;
    const float sc1 = lt > 0.f ? g1 / lt : 0.f;
#pragma unroll
    for (int db = 0; db < 2; ++db)
#pragma unroll
      for (int i = 0; i < 16; ++i) osp[8192 + (db * 16 + i) * 256] = O[db][i] * sc1;
  }
  {
    AttnSrc sw;
    sw.K = (const u16*)(ws + O_KW) + (long)b * T_ * 128 + g * 64; sw.ldk = 128; sw.K2 = nullptr;
    sw.V = (const u16*)(ws + O_VWT) + ((long)(b * 2 + g) * 64) * T_; sw.ldv = T_;
    const int lo = (t0 > 511 ? (t0 - 511) : 0) >> 6, hi = (t0 + 31) >> 6;
    m = -1e30f; l = 0.f; zero_o(O);
    attn_loop<AM_WIN, 64, true, false, false, false>(smem, sw, hi - lo + 1, lo, nullptr, qf, m, l, O, t, slope2, 0, 0, 0, 0, 0.f, nullptr, tid);
    const float lt = l;
    const float sc2 = lt > 0.f ? g2 / lt : 0.f;
#pragma unroll
    for (int db = 0; db < 2; ++db)
#pragma unroll
      for (int i = 0; i < 16; ++i) O[db][i] = O[db][i] * sc2 + osp[(db * 16 + i) * 256] + osp[8192 + (db * 16 + i) * 256];
  }
  u16* dst = (u16*)(ws + O_CONCAT) + tok * 1024 + head8 * 64;
#pragma unroll
  for (int db = 0; db < 2; ++db)
#pragma unroll
    for (int a = 0; a < 4; ++a)
      store4bf(dst + db * 32 + 8 * a + 4 * h, O[db][4 * a], O[db][4 * a + 1], O[db][4 * a + 2], O[db][4 * a + 3]);
}

DI void ln_apply_pass(const u16* src, const float* st, u16* dst, int tid, int nb) {
  const int lane = tid & 63;
  for (int row = blockIdx.x * 4 + (tid >> 6); row < M_; row += nb * 4) {
    const float mean = st[2 * row] * (1.f / 1024.f);
    const float rstd = rsqrtf(st[2 * row + 1] * (1.f / 1024.f) - mean * mean + 1e-5f);
    const u16* o = src + (long)row * 1024;
#pragma unroll
    for (int i = 0; i < 2; ++i) {
      const int c = lane * 8 + 512 * i;
      const uint4 v = *(const uint4*)(o + c);
      *(uint4*)(dst + (long)row * 1024 + c) = make_uint4(pack2((bflo(v.x) - mean) * rstd, (bfhi(v.x) - mean) * rstd), pack2((bflo(v.y) - mean) * rstd, (bfhi(v.y) - mean) * rstd),
                                                        pack2((bflo(v.z) - mean) * rstd, (bfhi(v.z) - mean) * rstd), pack2((bflo(v.w) - mean) * rstd, (bfhi(v.w) - mean) * rstd));
    }
  }
}

#ifndef REP
#define REP 0
#endif
#ifndef FAKEV
#define FAKEV 0
#endif
DI void tile_map(int i, int NT, int& mt, int& nt, int mpx = 64) {
  const int xcd = i & 7, j = i >> 3;
  const int ms = j / (8 * NT), r = j - ms * 8 * NT;
  nt = r >> 3;
  mt = xcd * mpx + ms * 8 + (r & 7);
}

template <int PMODE = 0, int FK = 0>
DI void phase4(const Params& P, unsigned char* smem, int tid, int cbase) {
  {
    int* ctr = (int*)(P.ws + O_CTR) + cbase;
    int* ctl = (int*)(smem + CTL_OFF);
    const int xcd = blockIdx.x & 7;
    bool mla_done = false;
    for (;;) {
      __syncthreads();
      if (tid == 0) {
        int it = -1;
        if (!mla_done) { int k = atomicAdd(ctr + xcd, 1); if (k < 512) it = k; }
        if (it < 0) { if (PMODE == 1) it = 8192; else { int j = atomicAdd(ctr + 8, 1); it = (j < 4096) ? 4096 + j : 8192; } }
        ctl[0] = it;
      }
      __syncthreads();
      const int item = ctl[0];
      if (item >= 8192) break;
#ifndef SKIP_MLA
      if (item < 4096) {
        const int qt = 63 - (item & 63), bh = (item >> 6) * 8 + xcd;
        mla_item<FK>(P, smem, bh >> 3, bh & 7, qt, tid);
      }
#endif
      if (item >= 4096) mla_done = true;
#ifndef SKIP_NSA
      if (item >= 4096) {
        const int j = item - 4096;
        const int tt = 255 - (j >> 4), bg = j & 15;
        nsa_item(P, smem, bg >> 1, bg & 1, tt, tid);
      }
#endif
    }
  }
}

#define XB_XCNT(j)  (64 * (j))
#define XB_XSUB(j)  (1024 + 64 * (j))
#define XB_XGEN(j)  (2048 + 64 * (j))
#define XB_TOP      3072
#define XB_TOPGEN   3136
#define XB_WORDS    3200
DI unsigned xb_ld(unsigned* p) { return __hip_atomic_load(p, __ATOMIC_RELAXED, __HIP_MEMORY_SCOPE_AGENT); }
DI unsigned xb_add(unsigned* p, unsigned v) { return __hip_atomic_fetch_add(p, v, __ATOMIC_RELAXED, __HIP_MEMORY_SCOPE_AGENT); }
DI unsigned xb_xcc_id() { return (unsigned)__builtin_amdgcn_s_getreg((3 << 11) | 20) & 0xFu; }
struct XBar { unsigned* bar; unsigned x, nloc, nx; };
DI void gsync(const XBar& b, int tid) {
  asm volatile("s_waitcnt vmcnt(0)" ::: "memory");
  __syncthreads();
  if (tid == 0) {
    unsigned* bar = b.bar;
    __builtin_amdgcn_s_waitcnt(0);
    const unsigned old = xb_add(&bar[XB_XSUB(b.x)], 1u);
    const unsigned gen = old / b.nloc;
    if (old + 1u == (gen + 1u) * b.nloc) {
      __builtin_amdgcn_fence(__ATOMIC_RELEASE, "agent");
      asm volatile("s_waitcnt vmcnt(0)" ::: "memory");
      const unsigned og = xb_add(&bar[XB_TOP], 1u);
      const unsigned tg = og / b.nx;
      if (og + 1u == (tg + 1u) * b.nx) xb_add(&bar[XB_TOPGEN], 1u);
      else while (xb_ld(&bar[XB_TOPGEN]) == tg) __builtin_amdgcn_s_sleep(1);
      __builtin_amdgcn_fence(__ATOMIC_ACQUIRE, "agent");
      xb_add(&bar[XB_XGEN(b.x)], 1u);
      asm volatile("s_waitcnt vmcnt(0)" ::: "memory");
    } else {
      while (xb_ld(&bar[XB_XGEN(b.x)]) == gen) __builtin_amdgcn_s_sleep(1);
      __builtin_amdgcn_fence(__ATOMIC_ACQUIRE, "agent");
      asm volatile("s_waitcnt vmcnt(0)" ::: "memory");
    }
  }
  __syncthreads();
}

__global__ void __launch_bounds__(256, 2) fwd_megakernel(Params P) {
  cg::grid_group grid = cg::this_grid();
  extern __shared__ __attribute__((aligned(16))) unsigned char smem[];
  const int tid = threadIdx.x;
  const int nb = gridDim.x;
  XBar xb; xb.bar = (unsigned*)(P.ws + O_BAR); xb.x = xb_xcc_id(); xb.nloc = 1u; xb.nx = 1u;
  if (tid == 0) (void)xb_add(&xb.bar[XB_XCNT(xb.x)], 1u);

#ifndef SKIP_P0
  phase0(P, smem, tid);
#endif
  if (P.ws == nullptr) grid.sync();
  if (tid == 0) {
    unsigned mine = 0u, cnt = 0u, sum = 0u;
    for (;;) {
      mine = 0u; cnt = 0u; sum = 0u;
#pragma unroll
      for (unsigned j = 0; j < 16; ++j) { const unsigned c = xb_ld(&xb.bar[XB_XCNT(j)]); sum += c; cnt += (c > 0u) ? 1u : 0u; mine = (j == xb.x) ? c : mine; }
      if (sum == gridDim.x) break;
      __builtin_amdgcn_s_sleep(1);
    }
    xb.nloc = mine > 0u ? mine : 1u; xb.nx = cnt > 0u ? cnt : 1u;
  }
  gsync(xb, tid);
#ifndef SKIP_P1
  for (int i = blockIdx.x; i < 512 * 14; i += nb) { int mt, nt; tile_map(i, 14, mt, nt); gemm_tile<PH_IN>(P, smem, mt, nt, 0, tid); }
#if REP == 11
  for (int q = 0; q < 20; ++q) gsync(xb, tid);
#endif
#if REP == 1
  gsync(xb, tid);
  for (int i = blockIdx.x; i < 512 * 14; i += nb) { int mt, nt; tile_map(i, 14, mt, nt); gemm_tile<PH_IN>(P, smem, mt, nt, 0, tid); }
#endif
#endif
  gsync(xb, tid);
#ifndef SKIP_P2
  for (int i = blockIdx.x; i < 256 + 3072 + 4096; i += nb) {
    if (i < 256) gemm_tile<PH_C1>(P, smem, (i >> 1) & 63, i & 1, i >> 7, tid);
    else if (i < 256 + 3072) { int mt, nt; tile_map(i - 256, 6, mt, nt); gemm_tile<PH_UQ>(P, smem, mt, nt, 0, tid); }
    else { int mt, nt; tile_map(i - 256 - 3072, 8, mt, nt); gemm_tile<PH_UKV>(P, smem, mt, nt, 0, tid); }
  }
#endif
#if REP == 2
  gsync(xb, tid);
  for (int i = blockIdx.x; i < 256 + 3072 + 4096; i += nb) {
    if (i < 256) gemm_tile<PH_C1>(P, smem, (i >> 1) & 63, i & 1, i >> 7, tid);
    else if (i < 256 + 3072) { int mt, nt; tile_map(i - 256, 6, mt, nt); gemm_tile<PH_UQ>(P, smem, mt, nt, 0, tid); }
    else { int mt, nt; tile_map(i - 256 - 3072, 8, mt, nt); gemm_tile<PH_UKV>(P, smem, mt, nt, 0, tid); }
  }
#endif
  gsync(xb, tid);
#ifndef SKIP_P3
  for (int i = blockIdx.x; i < 128; i += nb) gemm_tile<PH_C2>(P, smem, i & 63, 0, i >> 6, tid);
#endif
  gsync(xb, tid);
  phase4(P, smem, tid, 0);
#if REP == 4
  gsync(xb, tid);
  phase4<0, 0>(P, smem, tid, 16);
#endif
#if REP == 41
  gsync(xb, tid);
  phase4<1, FAKEV>(P, smem, tid, 16);
#endif
  gsync(xb, tid);
  {
    u16* pb = (u16*)(P.ws + O_PB);
    for (long i = (long)blockIdx.x * 256 + tid; i < (long)M_ * 256 / 8; i += (long)nb * 256) {
      const float4 a = *(const float4*)(P.p + i * 8), b = *(const float4*)(P.p + i * 8 + 4);
      *(uint4*)(pb + i * 8) = make_uint4(pack2(a.x, a.y), pack2(a.z, a.w), pack2(b.x, b.y), pack2(b.z, b.w));
    }
  }
#ifndef SKIP_P5
  for (int i = blockIdx.x; i < 256 * 8; i += nb) { int mt, nt; tile_map(i, 8, mt, nt, 32); gemm_tile<PH_OUT>(P, smem, mt, nt, 0, tid); }
#endif
  gsync(xb, tid);
#ifndef SKIP_P6
  for (int i = blockIdx.x; i < 256 * 44; i += nb) { int mt, nt; tile_map(i, 44, mt, nt, 32); gemm_tile<PH_UP>(P, smem, mt, nt, 0, tid); }
#if REP == 6
  gsync(xb, tid);
  for (int i = blockIdx.x; i < 256 * 44; i += nb) { int mt, nt; tile_map(i, 44, mt, nt, 32); gemm_tile<PH_UP, FAKEV>(P, smem, mt, nt, 0, tid); }
#endif
#endif
  gsync(xb, tid);
#ifndef SKIP_P7
  for (int i = blockIdx.x; i < 256 * 8; i += nb) { int mt, nt; tile_map(i, 8, mt, nt, 32); gemm_tile<PH_DOWN>(P, smem, mt, nt, 0, tid); }
#endif
  gsync(xb, tid);
#ifndef SKIP_P8
  for (int i = blockIdx.x; i < 256 * 8; i += nb) { int mt, nt; tile_map(i, 8, mt, nt, 32); gemm_tile<PH_PLE>(P, smem, mt, nt, 0, tid); }
#endif
  gsync(xb, tid);
  {
    const float* st3 = (const float*)(P.ws + O_STATS) + (long)M_ * 4;
    const int lane = tid & 63;
    for (int row = blockIdx.x * 4 + (tid >> 6); row < M_; row += nb * 4) {
      const float mean = st3[2 * row] * (1.f / 1024.f);
      const float rstd = rsqrtf(st3[2 * row + 1] * (1.f / 1024.f) - mean * mean + 1e-5f);
      float* o = P.out + (long)row * 1024;
      const u16* yb = (const u16*)(P.ws + O_CONCAT) + (long)row * 1024;
#pragma unroll
      for (int i = 0; i < 4; ++i) {
        const int c = lane * 4 + 256 * i;
        const uint2 yq = *(const uint2*)(yb + c);
        float4 v = make_float4(bflo(yq.x), bfhi(yq.x), bflo(yq.y), bfhi(yq.y));
        const float4 gg = *(const float4*)(P.ln3_g + c);
        const float4 bb = *(const float4*)(P.ln3_b + c);
        v.x = (v.x - mean) * rstd * gg.x + bb.x;
        v.y = (v.y - mean) * rstd * gg.y + bb.y;
        v.z = (v.z - mean) * rstd * gg.z + bb.z;
        v.w = (v.w - mean) * rstd * gg.w + bb.w;
        *(float4*)(o + c) = v;
      }
    }
  }
}

extern "C" void kernel_launch(void* const* d_in, const int* in_sizes, int n_in,
                              void* d_out, int out_size, void* d_ws, size_t ws_size,
                              hipStream_t stream) {
  static int grid_blocks = 0;
  if (!grid_blocks) {
    int dev = 0, cus = 0, per_cu = 0;
    (void)hipGetDevice(&dev);
    (void)hipDeviceGetAttribute(&cus, hipDeviceAttributeMultiprocessorCount, dev);
    (void)hipFuncSetAttribute((const void*)fwd_megakernel, hipFuncAttributeMaxDynamicSharedMemorySize, LDS_TOTAL);
    (void)hipOccupancyMaxActiveBlocksPerMultiprocessor(&per_cu, fwd_megakernel, 256, LDS_TOTAL);
    if (per_cu < 1) per_cu = 1;
    if (per_cu > 2) per_cu = 2;
    grid_blocks = cus * per_cu;
    fprintf(stderr, "grid_blocks=%d (cus=%d per_cu=%d) ws_need=%zu ws_size=%zu\n", grid_blocks, cus, per_cu, (size_t)WS_NEED, ws_size);
  }
  if (ws_size < WS_NEED || n_in < 24) { fprintf(stderr, "kernel_launch: workspace too small or bad inputs\n"); return; }
  (void)hipMemsetAsync((unsigned char*)d_ws + O_BAR, 0, 16384, stream);
  Params p{};
  const float** pp = (const float**)&p;
  for (int i = 0; i < 24; ++i) pp[i] = (const float*)d_in[i];
  p.out = (float*)d_out;
  p.ws = (unsigned char*)d_ws;
  void* args[] = {&p};
  hipError_t e = hipLaunchCooperativeKernel((void*)fwd_megakernel, dim3(grid_blocks), dim3(256), args, LDS_TOTAL, stream);
  if (e != hipSuccess) fprintf(stderr, "cooperative launch failed: %s (grid %d)\n", hipGetErrorString(e), grid_blocks);
}
```

```cpp
#include <hip/hip_runtime.h>
#include <hip/hip_cooperative_groups.h>
#include <cstdio>
#include <cstdint>
namespace cg = cooperative_groups;

#define DI __device__ __forceinline__
typedef unsigned short u16;
typedef unsigned long long u64;
typedef __attribute__((ext_vector_type(8))) short bf16x8;
typedef __attribute__((ext_vector_type(4))) short s16x4;
typedef __attribute__((ext_vector_type(4))) float f32x4;
typedef __attribute__((ext_vector_type(16))) float f32x16;
typedef __attribute__((ext_vector_type(2))) __bf16 bf2_t;

constexpr int T_ = 8192;
constexpr int M_ = 65536;
constexpr float ALPHA_ = 1.189207115002721f;
constexpr float LOG2E_ = 1.4426950408889634f;

constexpr size_t AL(size_t x) { return (x + 255) & ~(size_t)255; }
constexpr size_t O_WT_IN   = 0;
constexpr size_t O_WT_UQ   = O_WT_IN   + AL((size_t)1792 * 1024 * 2);
constexpr size_t O_WT_UKV  = O_WT_UQ   + AL((size_t)768 * 256 * 2);
constexpr size_t O_WT_CK1  = O_WT_UKV  + AL((size_t)1024 * 128 * 2);
constexpr size_t O_WT_CV1  = O_WT_CK1  + AL((size_t)256 * 2048 * 2);
constexpr size_t O_WT_CK2  = O_WT_CV1  + AL((size_t)256 * 2048 * 2);
constexpr size_t O_WT_CV2  = O_WT_CK2  + AL((size_t)128 * 256 * 2);
constexpr size_t O_WT_OUT  = O_WT_CV2  + AL((size_t)128 * 256 * 2);
constexpr size_t O_WT_UP   = O_WT_OUT  + AL((size_t)1024 * 1024 * 2);
constexpr size_t O_WT_DOWN = O_WT_UP   + AL((size_t)5632 * 1024 * 2);
constexpr size_t O_WT_GATE = O_WT_DOWN + AL((size_t)1024 * 2816 * 2);
constexpr size_t O_WT_PLE  = O_WT_GATE + AL((size_t)1024 * 1024 * 2);
constexpr size_t O_BIAS1K  = O_WT_PLE  + AL((size_t)1024 * 256 * 2);
constexpr size_t O_BIAS1V  = O_BIAS1K  + AL(256 * 4);
constexpr size_t O_BIAS_UP = O_BIAS1V  + AL(256 * 4);
constexpr size_t O_BIAS_G  = O_BIAS_UP + AL(5632 * 4);
constexpr size_t O_CSUM_UP = O_BIAS_G  + AL(1024 * 4);
constexpr size_t O_CSUM_G  = O_CSUM_UP + AL(5632 * 4);
constexpr size_t O_ROPE_C  = O_CSUM_G  + AL(1024 * 4);
constexpr size_t O_ROPE_S  = O_ROPE_C  + AL((size_t)8192 * 16 * 4);
constexpr size_t O_STATS   = O_ROPE_S  + AL((size_t)8192 * 16 * 4);
constexpr size_t O_SSQ     = O_STATS   + AL((size_t)3 * M_ * 2 * 4);
constexpr size_t O_CTR     = O_SSQ     + AL((size_t)2 * M_ * 4);
constexpr size_t O_BAR     = O_CTR     + 256;
constexpr size_t O_HID     = O_BAR     + 16384;
constexpr size_t O_CMPK    = O_HID     + AL((size_t)2 * 8192 * 256 * 2);
constexpr size_t O_CMPVT   = O_CMPK    + AL((size_t)16 * 512 * 64 * 2);
constexpr size_t O_CONCAT  = O_CMPVT   + AL((size_t)16 * 64 * 512 * 2);
constexpr size_t O_Y2      = O_CONCAT  + AL((size_t)M_ * 1024 * 2);
constexpr size_t O_R1      = O_Y2      + AL((size_t)M_ * 1024 * 4);
constexpr size_t O_QN      = O_R1;
constexpr size_t O_KC      = O_QN   + AL((size_t)M_ * 512 * 2);
constexpr size_t O_VC      = O_KC   + AL((size_t)M_ * 128 * 2);
constexpr size_t O_KS      = O_VC   + AL((size_t)M_ * 128 * 2);
constexpr size_t O_VST     = O_KS   + AL((size_t)M_ * 128 * 2);
constexpr size_t O_KW      = O_VST  + AL((size_t)M_ * 128 * 2);
constexpr size_t O_VWT     = O_KW   + AL((size_t)M_ * 128 * 2);
constexpr size_t O_CQ      = O_VWT  + AL((size_t)M_ * 128 * 2);
constexpr size_t O_CKV     = O_CQ   + AL((size_t)M_ * 256 * 2);
constexpr size_t O_KPE     = O_CKV  + AL((size_t)M_ * 128 * 2);
constexpr size_t O_GATES   = O_KPE  + AL((size_t)M_ * 32 * 2);
constexpr size_t O_QM      = O_GATES + AL((size_t)M_ * 24 * 4);
constexpr size_t O_KN      = O_QM   + AL((size_t)M_ * 768 * 2);
constexpr size_t O_VMT     = O_KN   + AL((size_t)M_ * 512 * 2);
constexpr size_t O_R1_END  = O_VMT  + AL((size_t)M_ * 512 * 2);
constexpr size_t O_HBUF    = O_R1;
constexpr size_t O_PB      = O_R1 + AL((size_t)M_ * 2816 * 2);
static_assert(O_PB + (size_t)M_ * 256 * 2 <= O_R1_END, "PB alias");
static_assert(O_R1_END - O_R1 >= (size_t)M_ * 2816 * 2, "HBUF alias too small");
constexpr size_t O_YB      = O_R1_END;
constexpr size_t WS_NEED   = O_YB + AL((size_t)M_ * 1024 * 2);
static_assert(WS_NEED <= (size_t)1073741824, "workspace budget (4 x largest tensor)");

struct Params {
  const float *x, *p, *w_in, *w_ck1, *w_ck2, *pos_ck, *w_cv1, *w_cv2, *pos_cv, *qn_g, *w_uq, *kvn_g, *w_ukv, *w_out,
      *ln1_g, *ln1_b, *w_up, *w_down, *ln2_g, *ln2_b, *w_pg, *w_ple, *ln3_g, *ln3_b;
  float* out;
  unsigned char* ws;
};

DI unsigned pack2(float a, float b) { bf2_t v; v[0] = (__bf16)a; v[1] = (__bf16)b; return __builtin_bit_cast(unsigned, v); }
DI void store4bf(u16* p, float a, float b, float c, float d) { *(uint2*)p = make_uint2(pack2(a, b), pack2(c, d)); }
DI float bflo(unsigned u) { return __uint_as_float(u << 16); }
DI float bfhi(unsigned u) { return __uint_as_float(u & 0xffff0000u); }
DI float sigmoid_(float x) { return 1.f / (1.f + __expf(-x)); }
DI float gelu_tanh_(float x) {
  float u = 0.7978845608028654f * (x + 0.044715f * x * x * x);
  float e = __expf(2.f * u);
  float th = 1.f - 2.f / (e + 1.f);
  return 0.5f * x * (1.f + th);
}
DI float ex2(float x) { return __builtin_amdgcn_exp2f(x); }
#define MFMA16(a, b, c) __builtin_amdgcn_mfma_f32_16x16x32_bf16((a), (b), (c), 0, 0, 0)
#define MFMA32(a, b, c) __builtin_amdgcn_mfma_f32_32x32x16_bf16((a), (b), (c), 0, 0, 0)

DI int map_in(int n) {
  if (n < 1280) return n;
  if (n < 1536) return 1304 + (n - 1280);
  if (n < 1664) return 1560 + (n - 1536);
  if (n < 1696) return 1688 + (n - 1664);
  if (n < 1720) return 1280 + (n - 1696);
  return -1;
}
DI int map_up(int n) {
  int t = n >> 7, c = n & 127, wc = c >> 6, j = (c >> 4) & 3, i = c & 15;
  int base = 64 * t + wc * 32 + (i >> 2) * 8 + (j & 1) * 4 + (i & 3);
  return (j < 2) ? base : 2816 + base;
}

struct TJob { const float* src; u16* dst; const float* scale; int K, Nsrc, map; };
DI TJob get_tjob(const Params& P, int j) {
  TJob t; t.scale = nullptr; t.map = 0;
  unsigned char* ws = P.ws;
  switch (j) {
    case 0: t.src = P.w_in; t.dst = (u16*)(ws + O_WT_IN); t.K = 1024; t.Nsrc = 1720; t.map = 1; break;
    case 1: t.src = P.w_uq; t.dst = (u16*)(ws + O_WT_UQ); t.K = 256; t.Nsrc = 768; t.scale = P.qn_g; break;
    case 2: t.src = P.w_ukv; t.dst = (u16*)(ws + O_WT_UKV); t.K = 128; t.Nsrc = 1024; t.scale = P.kvn_g; break;
    case 3: t.src = P.w_ck1; t.dst = (u16*)(ws + O_WT_CK1); t.K = 2048; t.Nsrc = 256; break;
    case 4: t.src = P.w_cv1; t.dst = (u16*)(ws + O_WT_CV1); t.K = 2048; t.Nsrc = 256; break;
    case 5: t.src = P.w_ck2; t.dst = (u16*)(ws + O_WT_CK2); t.K = 256; t.Nsrc = 64; break;
    case 6: t.src = P.w_cv2; t.dst = (u16*)(ws + O_WT_CV2); t.K = 256; t.Nsrc = 64; break;
    case 7: t.src = P.w_out; t.dst = (u16*)(ws + O_WT_OUT); t.K = 1024; t.Nsrc = 1024; break;
    case 8: t.src = P.w_up; t.dst = (u16*)(ws + O_WT_UP); t.K = 1024; t.Nsrc = 5632; t.map = 2; t.scale = P.ln1_g; break;
    case 9: t.src = P.w_down; t.dst = (u16*)(ws + O_WT_DOWN); t.K = 2816; t.Nsrc = 1024; break;
    case 10: t.src = P.w_pg; t.dst = (u16*)(ws + O_WT_GATE); t.K = 1024; t.Nsrc = 1024; t.scale = P.ln2_g; break;
    default: t.src = P.w_ple; t.dst = (u16*)(ws + O_WT_PLE); t.K = 256; t.Nsrc = 1024; break;
  }
  return t;
}

DI void phase0(const Params& P, unsigned char* smem, int tid) {
  const int NTL[12] = {448, 48, 32, 128, 128, 4, 4, 256, 1408, 704, 256, 64};
  constexpr int TOT_T = 3480;
  constexpr int TOT_U = TOT_T + 896;
  float* tl = (float*)smem;
  for (int pass = 0; pass < 2; ++pass) {
  if ((pass ^ (int)(blockIdx.x >> 3)) & 1) {
  for (int u = blockIdx.x; u < TOT_U; u += gridDim.x) {
    __syncthreads();
    if (u < TOT_T) {
      int j = 0, ti = u;
#pragma unroll
      for (int q = 0; q < 12; ++q) { if (j == q && ti >= NTL[q]) { ti -= NTL[q]; j = q + 1; } }
      TJob jb = get_tjob(P, j);
      const int nkt = jb.K >> 6;
      const int k0 = (ti % nkt) * 64, n0 = (ti / nkt) * 64;
#pragma unroll
      for (int i = 0; i < 16; ++i) {
        int kk = i * 4 + (tid >> 6), nn = tid & 63;
        int n = n0 + nn;
        int sn = (jb.map == 1) ? map_in(n) : (jb.map == 2 ? map_up(n) : n);
        float v = 0.f;
        if (sn >= 0) v = jb.src[(long)(k0 + kk) * jb.Nsrc + sn];
        if (jb.scale) v *= jb.scale[k0 + kk];
        tl[kk * 65 + nn] = v;
      }
      __syncthreads();
      {
        int n = tid >> 2, kq = tid & 3;
        unsigned w[8];
#pragma unroll
        for (int e = 0; e < 8; ++e) w[e] = pack2(tl[(kq * 16 + 2 * e) * 65 + n], tl[(kq * 16 + 2 * e + 1) * 65 + n]);
        u16* d = jb.dst + (long)(n0 + n) * jb.K + k0 + kq * 16;
        *(uint4*)d = make_uint4(w[0], w[1], w[2], w[3]);
        *(uint4*)(d + 8) = make_uint4(w[4], w[5], w[6], w[7]);
      }
    } else {
      int bu = u - TOT_T;
      const float* vec; const float* vec2 = nullptr; const float* W; float* dst; float* dst2 = nullptr; int K, Nsrc, mp = 0;
      if (bu < 32) { vec = P.pos_ck; W = P.w_ck1; dst = (float*)(P.ws + O_BIAS1K); K = 2048; Nsrc = 256; }
      else if (bu < 64) { bu -= 32; vec = P.pos_cv; W = P.w_cv1; dst = (float*)(P.ws + O_BIAS1V); K = 2048; Nsrc = 256; }
      else if (bu < 768) { bu -= 64; vec = P.ln1_b; vec2 = P.ln1_g; W = P.w_up; dst = (float*)(P.ws + O_BIAS_UP); dst2 = (float*)(P.ws + O_CSUM_UP); K = 1024; Nsrc = 5632; mp = 2; }
      else { bu -= 768; vec = P.ln2_b; vec2 = P.ln2_g; W = P.w_pg; dst = (float*)(P.ws + O_BIAS_G); dst2 = (float*)(P.ws + O_CSUM_G); K = 1024; Nsrc = 1024; }
      int c = tid & 7, kg = tid >> 3;
      int n = bu * 8 + c;
      int sn = (mp == 2) ? map_up(n) : n;
      float sa = 0.f, sb = 0.f;
      if (vec2) {
#pragma unroll 8
        for (int k = kg; k < K; k += 32) { const float w = W[(long)k * Nsrc + sn]; sa += vec[k] * w; sb += vec2[k] * w; }
      } else {
#pragma unroll 8
        for (int k = kg; k < K; k += 32) sa += vec[k] * W[(long)k * Nsrc + sn];
      }
      tl[kg * 8 + c] = sa; tl[256 + kg * 8 + c] = sb;
      __syncthreads();
      if (tid < 8) {
        float a0 = 0.f, a1 = 0.f;
#pragma unroll
        for (int q = 0; q < 32; ++q) { a0 += tl[q * 8 + tid]; a1 += tl[256 + q * 8 + tid]; }
        dst[bu * 8 + tid] = a0;
        if (dst2) dst2[bu * 8 + tid] = a1;
      }
    }
  }
  } else {
    const long gtid0 = (long)blockIdx.x * 256 + tid, gstr0 = (long)gridDim.x * 256;
    u16* xb = (u16*)(P.ws + O_CONCAT);
    for (long i = gtid0; i < (long)M_ * 1024 / 8; i += gstr0) {
      const float4 a = *(const float4*)(P.x + i * 8), b = *(const float4*)(P.x + i * 8 + 4);
      *(uint4*)(xb + i * 8) = make_uint4(pack2(a.x, a.y), pack2(a.z, a.w), pack2(b.x, b.y), pack2(b.z, b.w));
    }
  }
  }
  const long gtid = (long)blockIdx.x * 256 + tid, gstr = (long)gridDim.x * 256;
  float* rc = (float*)(P.ws + O_ROPE_C);
  float* rs = (float*)(P.ws + O_ROPE_S);
  for (long i = gtid; i < 8192 * 16; i += gstr) {
    int pos = (int)(i >> 4), f = (int)(i & 15);
    float inv = powf(10000.0f, -(float)f / 16.0f);
    float ang = (float)pos * inv;
    rc[i] = cosf(ang); rs[i] = sinf(ang);
  }
  float* st = (float*)(P.ws + O_STATS);
  for (long i = gtid; i < (long)3 * M_ * 2; i += gstr) st[i] = 0.f;
  { float* sq = (float*)(P.ws + O_SSQ); for (long i = gtid; i < (long)2 * M_; i += gstr) sq[i] = 0.f; }
  if (gtid < 64) ((int*)(P.ws + O_CTR))[gtid] = 0;
}

constexpr int LDS_BUF = 32768;
constexpr int LDS_RS_OFF = 2 * LDS_BUF;

template <int AMODE, int FAKE = 0>
DI void gemm_mainloop(f32x4 (&acc)[4][4], unsigned char* smem, const void* A, long lda, int m0, int K,
                      const u16* Bt, int n0, const float* stats, bool ns, int tid) {
  const int lane = tid & 63, wave = tid >> 6, wm = wave >> 1, wn = wave & 1;
  const int l16 = lane & 15, lq = lane >> 4;
  const int crow = tid >> 3, cch = tid & 7;
  int gtok0 = 0;
  const int nk = K >> 6;
  const int swz = (cch ^ (crow & 7)) * 8;
  const unsigned boff = ((unsigned)(n0 + crow) * (unsigned)K + (unsigned)cch * 8u) * 2u;
  const unsigned bstrb = 64u * (unsigned)K;
  unsigned aoff = 0u; const unsigned astrb = 64u * (unsigned)lda;
  if constexpr (AMODE == 0) aoff = ((unsigned)(m0 + crow) * (unsigned)lda + (unsigned)cch * 8u) * 2u;
  if constexpr (AMODE == 3) { const int r_ = m0 + crow; const int bg_ = r_ >> 9; gtok0 = (r_ & 511) * 16;
    aoff = ((unsigned)(bg_ >> 1) * (unsigned)T_ * 128u + (unsigned)(bg_ & 1) * 64u + (unsigned)cch * 8u) * 2u; }
  const unsigned gch = (unsigned)(cch ^ (crow & 7)) * 16u;
  const unsigned boffd = ((unsigned)(n0 + crow) * (unsigned)K) * 2u + gch;
  unsigned aoffd = 0u;
  if constexpr (AMODE == 0) aoffd = ((unsigned)(m0 + crow) * (unsigned)lda) * 2u + gch;
  if constexpr (AMODE == 3) { const int r_ = m0 + crow; const int bg_ = r_ >> 9;
    aoffd = ((unsigned)(bg_ >> 1) * (unsigned)T_ * 128u + (unsigned)(bg_ & 1) * 64u) * 2u + gch; }
  const int wbase = __builtin_amdgcn_readfirstlane(wave) * 1024;
#define GP(base_, off_) ((const unsigned*)((const char*)(base_) + (unsigned)(off_)))
#define LP(BUF, off_) ((unsigned*)(smem + (BUF) * LDS_BUF + wbase + (off_)))
#define D_LOAD(BUF, ks) { const unsigned qb_ = boffd + (unsigned)(ks) * 128u; \
    __builtin_amdgcn_global_load_lds(GP(Bt, qb_), LP(BUF, 16384), 16, 0, 0); \
    __builtin_amdgcn_global_load_lds(GP(Bt, qb_ + bstrb), LP(BUF, 16384 + 4096), 16, 0, 0); \
    __builtin_amdgcn_global_load_lds(GP(Bt, qb_ + 2u * bstrb), LP(BUF, 16384 + 8192), 16, 0, 0); \
    __builtin_amdgcn_global_load_lds(GP(Bt, qb_ + 3u * bstrb), LP(BUF, 16384 + 12288), 16, 0, 0); \
    if constexpr (AMODE == 0) { const unsigned qa_ = aoffd + (unsigned)(ks) * 128u; \
      __builtin_amdgcn_global_load_lds(GP(A, qa_), LP(BUF, 0), 16, 0, 0); \
      __builtin_amdgcn_global_load_lds(GP(A, qa_ + astrb), LP(BUF, 4096), 16, 0, 0); \
      __builtin_amdgcn_global_load_lds(GP(A, qa_ + 2u * astrb), LP(BUF, 8192), 16, 0, 0); \
      __builtin_amdgcn_global_load_lds(GP(A, qa_ + 3u * astrb), LP(BUF, 12288), 16, 0, 0); } \
    else { \
      __builtin_amdgcn_global_load_lds(GP(A, aoffd + (unsigned)min(gtok0 + (ks), T_ - 1) * 256u), LP(BUF, 0), 16, 0, 0); \
      __builtin_amdgcn_global_load_lds(GP(A, aoffd + (unsigned)min(gtok0 + 512 + (ks), T_ - 1) * 256u), LP(BUF, 4096), 16, 0, 0); \
      __builtin_amdgcn_global_load_lds(GP(A, aoffd + (unsigned)min(gtok0 + 1024 + (ks), T_ - 1) * 256u), LP(BUF, 8192), 16, 0, 0); \
      __builtin_amdgcn_global_load_lds(GP(A, aoffd + (unsigned)min(gtok0 + 1536 + (ks), T_ - 1) * 256u), LP(BUF, 12288), 16, 0, 0); } }
#define D_SYNC() { asm volatile("s_waitcnt vmcnt(0)" ::: "memory"); asm volatile("s_waitcnt lgkmcnt(0)" ::: "memory"); __builtin_amdgcn_s_barrier(); asm volatile("" ::: "memory"); }
#define G_ROW(mi, fa_) \
      if (ns) { acc[mi][0] = MFMA16(fa_, fb0, acc[mi][0]); acc[mi][1] = MFMA16(fa_, fb1, acc[mi][1]); acc[mi][2] = MFMA16(fa_, fb2, acc[mi][2]); acc[mi][3] = MFMA16(fa_, fb3, acc[mi][3]); } \
      else    { acc[mi][0] = MFMA16(fb0, fa_, acc[mi][0]); acc[mi][1] = MFMA16(fb1, fa_, acc[mi][1]); acc[mi][2] = MFMA16(fb2, fa_, acc[mi][2]); acc[mi][3] = MFMA16(fb3, fa_, acc[mi][3]); }
#define G_HALF(BUF, kk) { \
      const int co = (((kk) * 4 + lq) ^ (l16 & 7)) * 8; \
      const u16* pa = (const u16*)(smem + (BUF) * LDS_BUF) + (wm * 64 + l16) * 64 + co; \
      const u16* pb = (const u16*)(smem + (BUF) * LDS_BUF) + 8192 + (wn * 64 + l16) * 64 + co; \
      const bf16x8 fa0 = *(const bf16x8*)pa, fa1 = *(const bf16x8*)(pa + 16 * 64), fa2 = *(const bf16x8*)(pa + 32 * 64), fa3 = *(const bf16x8*)(pa + 48 * 64); \
      const bf16x8 fb0 = *(const bf16x8*)pb, fb1 = *(const bf16x8*)(pb + 16 * 64), fb2 = *(const bf16x8*)(pb + 32 * 64), fb3 = *(const bf16x8*)(pb + 48 * 64); \
      G_ROW(0, fa0) G_ROW(1, fa1) G_ROW(2, fa2) G_ROW(3, fa3) }
#define R_STEP(CUR, ks) { \
    if ((ks) + 1 < nk && FAKE != 1) D_LOAD((CUR) ^ 1, (ks) + 1) \
    __builtin_amdgcn_sched_barrier(0); \
    if (FAKE != 2) { G_HALF(CUR, 0) G_HALF(CUR, 1) } \
    D_SYNC() }
  __syncthreads();
  D_LOAD(0, 0)
  D_SYNC()
  for (int ks = 0; ks < nk; ks += 2) {
    R_STEP(0, ks)
    if (ks + 1 < nk) R_STEP(1, ks + 1)
  }
#undef GP
#undef LP
#undef D_LOAD
#undef D_SYNC
#undef G_ROW
#undef G_HALF
#undef R_STEP
}

constexpr int LDS_BIG = 24576;
template <int FAKE = 0>
DI void gemm_mainloop_big(f32x4 (&acc)[8][4], unsigned char* smem, const void* A, long lda, int m0, int K,
                          const u16* Bt, int n0, bool ns, int tid) {
  const int lane = tid & 63, wave = tid >> 6, wm = wave >> 1, wn = wave & 1;
  const int l16 = lane & 15, lq = lane >> 4;
  const int nk = K >> 5;
  const int prow = lane >> 2, ppos = lane & 3;
  const unsigned gch = (unsigned)(ppos ^ ((4 - ((lane >> 4) & 3)) & 3)) * 16u;
  const unsigned aoffd = ((unsigned)(m0 + 16 * wave + prow) * (unsigned)lda) * 2u + gch;
  const unsigned boffd = ((unsigned)(n0 + 16 * wave + prow) * (unsigned)K) * 2u + gch;
  const unsigned astrb = 128u * (unsigned)lda, bstrb = 128u * (unsigned)K;
  const int wbase = __builtin_amdgcn_readfirstlane(wave) * 1024;
#define GP(base_, off_) ((const unsigned*)((const char*)(base_) + (unsigned)(off_)))
#define LP(BUF, off_) ((unsigned*)(smem + (BUF) * LDS_BIG + wbase + (off_)))
#define D_LOAD(BUF, ks) { const unsigned ko_ = (unsigned)(ks) * 64u; \
    __builtin_amdgcn_global_load_lds(GP(A, aoffd + ko_), LP(BUF, 0), 16, 0, 0); \
    __builtin_amdgcn_global_load_lds(GP(A, aoffd + ko_ + astrb), LP(BUF, 4096), 16, 0, 0); \
    __builtin_amdgcn_global_load_lds(GP(A, aoffd + ko_ + 2u * astrb), LP(BUF, 8192), 16, 0, 0); \
    __builtin_amdgcn_global_load_lds(GP(A, aoffd + ko_ + 3u * astrb), LP(BUF, 12288), 16, 0, 0); \
    __builtin_amdgcn_global_load_lds(GP(Bt, boffd + ko_), LP(BUF, 16384), 16, 0, 0); \
    __builtin_amdgcn_global_load_lds(GP(Bt, boffd + ko_ + bstrb), LP(BUF, 16384 + 4096), 16, 0, 0); }
#define D_SYNC() { asm volatile("s_waitcnt vmcnt(0)" ::: "memory"); asm volatile("s_waitcnt lgkmcnt(0)" ::: "memory"); __builtin_amdgcn_s_barrier(); asm volatile("" ::: "memory"); }
  const int pp = (lq ^ ((4 - ((l16 >> 2) & 3)) & 3)) * 8;
#define B_ROW(mi) { const bf16x8 fa_ = *(const bf16x8*)(pa + (mi) * 16 * 32); \
      if (ns) { acc[mi][0] = MFMA16(fa_, fb0, acc[mi][0]); acc[mi][1] = MFMA16(fa_, fb1, acc[mi][1]); acc[mi][2] = MFMA16(fa_, fb2, acc[mi][2]); acc[mi][3] = MFMA16(fa_, fb3, acc[mi][3]); } \
      else    { acc[mi][0] = MFMA16(fb0, fa_, acc[mi][0]); acc[mi][1] = MFMA16(fb1, fa_, acc[mi][1]); acc[mi][2] = MFMA16(fb2, fa_, acc[mi][2]); acc[mi][3] = MFMA16(fb3, fa_, acc[mi][3]); } }
#define B_COMPUTE(BUF) { \
      const u16* pa = (const u16*)(smem + (BUF) * LDS_BIG) + (wm * 128 + l16) * 32 + pp; \
      const u16* pb = (const u16*)(smem + (BUF) * LDS_BIG + 16384) + (wn * 64 + l16) * 32 + pp; \
      const bf16x8 fb0 = *(const bf16x8*)pb, fb1 = *(const bf16x8*)(pb + 16 * 32), fb2 = *(const bf16x8*)(pb + 32 * 32), fb3 = *(const bf16x8*)(pb + 48 * 32); \
      B_ROW(0) B_ROW(1) B_ROW(2) B_ROW(3) B_ROW(4) B_ROW(5) B_ROW(6) B_ROW(7) }
#define B_STEP(CUR, ks) { \
    if ((ks) + 1 < nk && FAKE != 1) D_LOAD((CUR) ^ 1, (ks) + 1) \
    __builtin_amdgcn_sched_barrier(0); \
    if (FAKE != 2) B_COMPUTE(CUR) \
    D_SYNC() }
  __syncthreads();
  D_LOAD(0, 0)
  D_SYNC()
  for (int ks = 0; ks < nk; ks += 2) {
    B_STEP(0, ks)
    if (ks + 1 < nk) B_STEP(1, ks + 1)
  }
#undef GP
#undef LP
#undef D_LOAD
#undef D_SYNC
#undef B_ROW
#undef B_COMPUTE
#undef B_STEP
}

template <int MI>
DI void zero_acc(f32x4 (&acc)[MI][4]) {
#pragma unroll
  for (int i = 0; i < MI; ++i)
#pragma unroll
    for (int j = 0; j < 4; ++j) acc[i][j] = f32x4{0.f, 0.f, 0.f, 0.f};
}

DI void stat_push(float* stats, int tok, float s1, float s2, int lq) {
  s1 += __shfl_xor(s1, 16); s2 += __shfl_xor(s2, 16);
  s1 += __shfl_xor(s1, 32); s2 += __shfl_xor(s2, 32);
  if (lq == 0) { atomicAdd(stats + 2 * (long)tok, s1); atomicAdd(stats + 2 * (long)tok + 1, s2); }
}

enum { PH_IN = 1, PH_UQ, PH_UKV, PH_C1, PH_C2, PH_OUT, PH_UP, PH_DOWN, PH_PLE };

template <int PH, int FAKE = 0>
DI void gemm_tile(const Params& P, unsigned char* smem, int mt, int nt, int which, int tid_in) {
  int tid = tid_in;
  asm volatile("" : "+v"(tid));
  unsigned char* ws = P.ws;
  const int lane = tid & 63, wave = tid >> 6, wm = wave >> 1, wn = wave & 1;
  const int l16 = lane & 15, lq = lane >> 4;
  constexpr int MI = (PH == PH_OUT || PH == PH_UP || PH == PH_DOWN || PH == PH_PLE) ? 8 : 4;
  constexpr int WR = MI * 16;
  const int m0 = mt * (2 * WR), n0 = nt * 128;
  f32x4 acc[MI][4];
  zero_acc<MI>(acc);
  float* rsq = (float*)(smem + LDS_RS_OFF);

  if constexpr (PH == PH_IN) {
    const bool ns = (nt == 7 || nt == 9);
    gemm_mainloop<0>(acc, smem, (const u16*)(ws + O_CONCAT), 1024, m0, 1024, (const u16*)(ws + O_WT_IN), n0, nullptr, ns, tid);
    const float QSC = 0.125f * LOG2E_;
#pragma unroll
    for (int mi = 0; mi < MI; ++mi) {
      if (!ns) {
        const int tok = m0 + wm * WR + mi * 16 + l16;
        if (nt < 4) {
#pragma unroll
          for (int nj = 0; nj < 4; ++nj) {
            int col = n0 + wn * 64 + nj * 16 + lq * 4;
            f32x4 a = acc[mi][nj];
            store4bf((u16*)(ws + O_QN) + (long)tok * 512 + col, a[0] * QSC, a[1] * QSC, a[2] * QSC, a[3] * QSC);
          }
        } else if (nt == 4 || nt == 5 || nt == 6 || nt == 8 || nt == 12) {
          u16* dst = (u16*)(ws + (nt == 4 ? O_KC : nt == 5 ? O_VC : nt == 6 ? O_KS : nt == 8 ? O_KW : O_CKV));
          float ss = 0.f;
#pragma unroll
          for (int nj = 0; nj < 4; ++nj) {
            int col = wn * 64 + nj * 16 + lq * 4;
            f32x4 a = acc[mi][nj];
            ss += a[0] * a[0] + a[1] * a[1] + a[2] * a[2] + a[3] * a[3];
            store4bf(dst + (long)tok * 128 + col, a[0], a[1], a[2], a[3]);
          }
          if (nt == 12) {
            ss += __shfl_xor(ss, 16); ss += __shfl_xor(ss, 32);
            if (lq == 0) atomicAdd((float*)(ws + O_SSQ) + M_ + tok, ss);
          }
        } else if (nt == 10 || nt == 11) {
          float ss = 0.f;
#pragma unroll
          for (int nj = 0; nj < 4; ++nj) {
            int col = (nt - 10) * 128 + wn * 64 + nj * 16 + lq * 4;
            f32x4 a = acc[mi][nj];
            ss += a[0] * a[0] + a[1] * a[1] + a[2] * a[2] + a[3] * a[3];
            store4bf((u16*)(ws + O_CQ) + (long)tok * 256 + col, a[0], a[1], a[2], a[3]);
          }
          ss += __shfl_xor(ss, 16); ss += __shfl_xor(ss, 32);
          if (lq == 0) atomicAdd((float*)(ws + O_SSQ) + tok, ss);
        } else {
          if (wn == 0) {
            const int pos = tok & (T_ - 1);
            const float4 cs = *(const float4*)((const float*)(ws + O_ROPE_C) + pos * 16 + lq * 4);
            const float4 sn = *(const float4*)((const float*)(ws + O_ROPE_S) + pos * 16 + lq * 4);
            f32x4 x1 = acc[mi][0], x2 = acc[mi][1];
            u16* kp = (u16*)(ws + O_KPE) + (long)tok * 32;
            store4bf(kp + lq * 4, x1[0] * cs.x - x2[0] * sn.x, x1[1] * cs.y - x2[1] * sn.y, x1[2] * cs.z - x2[2] * sn.z, x1[3] * cs.w - x2[3] * sn.w);
            store4bf(kp + 16 + lq * 4, x2[0] * cs.x + x1[0] * sn.x, x2[1] * cs.y + x1[1] * sn.y, x2[2] * cs.z + x1[2] * sn.z, x2[3] * cs.w + x1[3] * sn.w);
            float* gp = (float*)(ws + O_GATES) + (long)tok * 24;
            f32x4 g0 = acc[mi][2], g1 = acc[mi][3];
            *(float4*)(gp + lq * 4) = make_float4(sigmoid_(g0[0]), sigmoid_(g0[1]), sigmoid_(g0[2]), sigmoid_(g0[3]));
            if (lq < 2) *(float4*)(gp + 16 + lq * 4) = make_float4(sigmoid_(g1[0]), sigmoid_(g1[1]), sigmoid_(g1[2]), sigmoid_(g1[3]));
          }
        }
      } else {
        const int tok4 = m0 + wm * WR + mi * 16 + lq * 4;
        const int b = tok4 >> 13, t = tok4 & (T_ - 1);
        u16* dstb = (u16*)(ws + (nt == 7 ? O_VST : O_VWT));
#pragma unroll
        for (int nj = 0; nj < 4; ++nj) {
          int c = wn * 64 + nj * 16 + l16, g = c >> 6, d = c & 63;
          f32x4 a = acc[mi][nj];
          store4bf(dstb + ((long)((b * 2 + g) * 64 + d)) * T_ + t, a[0], a[1], a[2], a[3]);
        }
      }
    }
  }

  if constexpr (PH == PH_UQ || PH == PH_UKV) {
    constexpr int K = (PH == PH_UQ) ? 256 : 128;
    const u16* A = (const u16*)(ws + (PH == PH_UQ ? O_CQ : O_CKV));
    __syncthreads();
    if (tid < 128) {
      const float ss = ((const float*)(ws + O_SSQ))[(PH == PH_UQ ? 0 : M_) + m0 + tid];
      rsq[tid] = rsqrtf(ss * (1.f / K) + 1e-6f);
    }
    if constexpr (PH == PH_UQ) {
      gemm_mainloop<0>(acc, smem, A, 256, m0, 256, (const u16*)(ws + O_WT_UQ), n0, nullptr, false, tid);
      const float SC = 0.10206207261596577f * LOG2E_;
#pragma unroll
      for (int mi = 0; mi < MI; ++mi) {
        const int tok = m0 + wm * WR + mi * 16 + l16;
        const float rs = rsq[wm * WR + mi * 16 + l16] * SC;
        const int pos = tok & (T_ - 1);
        const int ct0 = nt * 8 + wn * 4;
#pragma unroll
        for (int njp = 0; njp < 4; njp += 2) {
          f32x4 a = acc[mi][njp], b2 = acc[mi][njp + 1];
          if (((ct0 + njp) % 6) == 4) {
            const float4 cs = *(const float4*)((const float*)(ws + O_ROPE_C) + pos * 16 + lq * 4);
            const float4 sn = *(const float4*)((const float*)(ws + O_ROPE_S) + pos * 16 + lq * 4);
            f32x4 o1, o2;
            o1[0] = a[0] * cs.x - b2[0] * sn.x; o2[0] = b2[0] * cs.x + a[0] * sn.x;
            o1[1] = a[1] * cs.y - b2[1] * sn.y; o2[1] = b2[1] * cs.y + a[1] * sn.y;
            o1[2] = a[2] * cs.z - b2[2] * sn.z; o2[2] = b2[2] * cs.z + a[2] * sn.z;
            o1[3] = a[3] * cs.w - b2[3] * sn.w; o2[3] = b2[3] * cs.w + a[3] * sn.w;
            a = o1; b2 = o2;
          }
          u16* dst = (u16*)(ws + O_QM) + (long)tok * 768 + n0 + wn * 64 + njp * 16 + lq * 4;
          store4bf(dst, a[0] * rs, a[1] * rs, a[2] * rs, a[3] * rs);
          store4bf(dst + 16, b2[0] * rs, b2[1] * rs, b2[2] * rs, b2[3] * rs);
        }
      }
    } else {
      const bool ns = (wn == 1);
      gemm_mainloop<0>(acc, smem, A, 128, m0, 128, (const u16*)(ws + O_WT_UKV), n0, nullptr, ns, tid);
#pragma unroll
      for (int mi = 0; mi < MI; ++mi) {
        if (!ns) {
          const int tok = m0 + wm * WR + mi * 16 + l16;
          const float rs = rsq[wm * WR + mi * 16 + l16];
#pragma unroll
          for (int nj = 0; nj < 4; ++nj) {
            f32x4 a = acc[mi][nj];
            store4bf((u16*)(ws + O_KN) + (long)tok * 512 + nt * 64 + nj * 16 + lq * 4, a[0] * rs, a[1] * rs, a[2] * rs, a[3] * rs);
          }
        } else {
          const int lr = wm * WR + mi * 16 + lq * 4;
          const int tok4 = m0 + lr;
          const int b = tok4 >> 13, t = tok4 & (T_ - 1);
          const float r0 = rsq[lr], r1 = rsq[lr + 1], r2 = rsq[lr + 2], r3 = rsq[lr + 3];
#pragma unroll
          for (int nj = 0; nj < 4; ++nj) {
            int d = nj * 16 + l16;
            f32x4 a = acc[mi][nj];
            store4bf((u16*)(ws + O_VMT) + ((long)((b * 8 + nt) * 64 + d)) * T_ + t, a[0] * r0, a[1] * r1, a[2] * r2, a[3] * r3);
          }
        }
      }
    }
  }

  if constexpr (PH == PH_C1) {
    const u16* A = (const u16*)(ws + (which ? O_VC : O_KC));
    const u16* Bt = (const u16*)(ws + (which ? O_WT_CV1 : O_WT_CK1));
    const float* bias = (const float*)(ws + (which ? O_BIAS1V : O_BIAS1K));
    gemm_mainloop<3>(acc, smem, A, 128, m0, 2048, Bt, n0, nullptr, false, tid);
    u16* hid = (u16*)(ws + O_HID) + (long)which * 8192 * 256;
#pragma unroll
    for (int mi = 0; mi < MI; ++mi) {
      const int row = m0 + wm * WR + mi * 16 + l16;
#pragma unroll
      for (int nj = 0; nj < 4; ++nj) {
        int col = n0 + wn * 64 + nj * 16 + lq * 4;
        const float4 bb = *(const float4*)(bias + col);
        f32x4 a = acc[mi][nj];
        store4bf(hid + (long)row * 256 + col, gelu_tanh_(a[0] + bb.x), gelu_tanh_(a[1] + bb.y), gelu_tanh_(a[2] + bb.z), gelu_tanh_(a[3] + bb.w));
      }
    }
  }

  if constexpr (PH == PH_C2) {
    const u16* A = (const u16*)(ws + O_HID) + (long)which * 8192 * 256;
    const u16* Bt = (const u16*)(ws + (which ? O_WT_CV2 : O_WT_CK2));
    const bool ns = (which == 1);
    gemm_mainloop<0>(acc, smem, A, 256, m0, 256, Bt, 0, nullptr, ns, tid);
    if (wn == 0) {
#pragma unroll
      for (int mi = 0; mi < MI; ++mi) {
        if (!ns) {
          const int row = m0 + wm * WR + mi * 16 + l16;
#pragma unroll
          for (int nj = 0; nj < 4; ++nj) {
            f32x4 a = acc[mi][nj];
            store4bf((u16*)(ws + O_CMPK) + (long)row * 64 + nj * 16 + lq * 4, a[0], a[1], a[2], a[3]);
          }
        } else {
          const int r4 = m0 + wm * WR + mi * 16 + lq * 4;
          const int bg = r4 >> 9, c = r4 & 511;
#pragma unroll
          for (int nj = 0; nj < 4; ++nj) {
            int d = nj * 16 + l16;
            f32x4 a = acc[mi][nj];
            store4bf((u16*)(ws + O_CMPVT) + ((long)(bg * 64 + d)) * 512 + c, a[0], a[1], a[2], a[3]);
          }
        }
      }
    }
  }

  if constexpr (PH == PH_OUT) {
    gemm_mainloop_big<0>(acc, smem, (const u16*)(ws + O_CONCAT), 1024, m0, 1024, (const u16*)(ws + O_WT_OUT), n0, false, tid);
    float* stats = (float*)(ws + O_STATS);
#pragma unroll
    for (int mi = 0; mi < MI; ++mi) {
      const int tok = m0 + wm * WR + mi * 16 + l16;
      float s1 = 0.f, s2 = 0.f;
#pragma unroll
      for (int nj = 0; nj < 4; ++nj) {
        int col = n0 + wn * 64 + nj * 16 + lq * 4;
        const float4 xv = *(const float4*)(P.x + (long)tok * 1024 + col);
        f32x4 a = acc[mi][nj];
        float4 y = make_float4(ALPHA_ * xv.x + a[0], ALPHA_ * xv.y + a[1], ALPHA_ * xv.z + a[2], ALPHA_ * xv.w + a[3]);
        store4bf((u16*)(ws + O_YB) + (long)tok * 1024 + col, y.x, y.y, y.z, y.w);
        s1 += y.x + y.y + y.z + y.w;
        s2 += y.x * y.x + y.y * y.y + y.z * y.z + y.w * y.w;
      }
      stat_push(stats, tok, s1, s2, lq);
    }
  }

  if constexpr (PH == PH_UP) {
    gemm_mainloop_big<FAKE>(acc, smem, (const u16*)(ws + O_YB), 1024, m0, 1024, (const u16*)(ws + O_WT_UP), n0, false, tid);
    if (FAKE != 0 && acc[0][0][0] + acc[3][3][3] + acc[1][2][1] != 123456.75f) return;
    const float* bias = (const float*)(ws + O_BIAS_UP);
    const float* csum = (const float*)(ws + O_CSUM_UP);
    const float* st1 = (const float*)(ws + O_STATS);
    const int cb0 = n0 + wn * 64 + lq * 4;
    const float4 bgv[2] = {*(const float4*)(bias + cb0), *(const float4*)(bias + cb0 + 16)};
    const float4 buv[2] = {*(const float4*)(bias + cb0 + 32), *(const float4*)(bias + cb0 + 48)};
    const float4 cgv[2] = {*(const float4*)(csum + cb0), *(const float4*)(csum + cb0 + 16)};
    const float4 cuv[2] = {*(const float4*)(csum + cb0 + 32), *(const float4*)(csum + cb0 + 48)};
#pragma unroll
    for (int mi = 0; mi < MI; ++mi) {
      const int tok = m0 + wm * WR + mi * 16 + l16;
      const float mean = st1[2 * tok] * (1.f / 1024.f);
      const float rstd = rsqrtf(st1[2 * tok + 1] * (1.f / 1024.f) - mean * mean + 1e-5f);
      unsigned hw[4];
#pragma unroll
      for (int nj = 0; nj < 2; ++nj) {
        const float4 bg = bgv[nj], bu = buv[nj], cg = cgv[nj], cu = cuv[nj];
        f32x4 g = acc[mi][nj], u = acc[mi][nj + 2];
        float h0, h1, h2, h3, v;
        v = rstd * (g[0] - mean * cg.x) + bg.x; h0 = v * sigmoid_(v) * (rstd * (u[0] - mean * cu.x) + bu.x);
        v = rstd * (g[1] - mean * cg.y) + bg.y; h1 = v * sigmoid_(v) * (rstd * (u[1] - mean * cu.y) + bu.y);
        v = rstd * (g[2] - mean * cg.z) + bg.z; h2 = v * sigmoid_(v) * (rstd * (u[2] - mean * cu.z) + bu.z);
        v = rstd * (g[3] - mean * cg.w) + bg.w; h3 = v * sigmoid_(v) * (rstd * (u[3] - mean * cu.w) + bu.w);
        hw[2 * nj] = pack2(h0, h1); hw[2 * nj + 1] = pack2(h2, h3);
      }
      *(uint4*)((u16*)(ws + O_HBUF) + (long)tok * 2816 + nt * 64 + wn * 32 + lq * 8) = make_uint4(hw[0], hw[1], hw[2], hw[3]);
    }
  }

  if constexpr (PH == PH_DOWN) {
    gemm_mainloop_big<0>(acc, smem, (const u16*)(ws + O_HBUF), 2816, m0, 2816, (const u16*)(ws + O_WT_DOWN), n0, false, tid);
    const float* st1 = (const float*)(ws + O_STATS);
    float* st2 = (float*)(ws + O_STATS) + (long)M_ * 2;
    u16* yb = (u16*)(ws + O_YB);
#pragma unroll
    for (int mi = 0; mi < MI; ++mi) {
      const int tok = m0 + wm * WR + mi * 16 + l16;
      const float mean = st1[2 * tok] * (1.f / 1024.f);
      const float rstd = rsqrtf(st1[2 * tok + 1] * (1.f / 1024.f) - mean * mean + 1e-5f);
      float s1 = 0.f, s2 = 0.f;
#pragma unroll
      for (int nj = 0; nj < 4; ++nj) {
        int col = n0 + wn * 64 + nj * 16 + lq * 4;
        const uint2 yq = *(const uint2*)(yb + (long)tok * 1024 + col);
        const float4 yv = make_float4(bflo(yq.x), bfhi(yq.x), bflo(yq.y), bfhi(yq.y));
        const float4 gg = *(const float4*)(P.ln1_g + col);
        const float4 bb = *(const float4*)(P.ln1_b + col);
        f32x4 a = acc[mi][nj];
        float4 y;
        y.x = ALPHA_ * ((yv.x - mean) * rstd * gg.x + bb.x) + a[0];
        y.y = ALPHA_ * ((yv.y - mean) * rstd * gg.y + bb.y) + a[1];
        y.z = ALPHA_ * ((yv.z - mean) * rstd * gg.z + bb.z) + a[2];
        y.w = ALPHA_ * ((yv.w - mean) * rstd * gg.w + bb.w) + a[3];
        store4bf(yb + (long)tok * 1024 + col, y.x, y.y, y.z, y.w);
        s1 += y.x + y.y + y.z + y.w;
        s2 += y.x * y.x + y.y * y.y + y.z * y.z + y.w * y.w;
      }
      stat_push(st2, tok, s1, s2, lq);
    }
  }

  if constexpr (PH == PH_PLE) {
    const float* st2 = (const float*)(ws + O_STATS) + (long)M_ * 2;
    float* st3 = (float*)(ws + O_STATS) + (long)M_ * 4;
    u16* yb = (u16*)(ws + O_YB);
    gemm_mainloop_big<0>(acc, smem, (const u16*)(ws + O_YB), 1024, m0, 1024, (const u16*)(ws + O_WT_GATE), n0, false, tid);
    const float* bias = (const float*)(ws + O_BIAS_G);
    uint4* gsp4 = (uint4*)(ws + O_HBUF) + (long)(mt * 8 + nt) * 16 * 256;
    const int cg0 = n0 + wn * 64 + lq * 4;
    const float4 gbv[4] = {*(const float4*)(bias + cg0), *(const float4*)(bias + cg0 + 16), *(const float4*)(bias + cg0 + 32), *(const float4*)(bias + cg0 + 48)};
    const float* csg = (const float*)(ws + O_CSUM_G);
    const float4 gcv[4] = {*(const float4*)(csg + cg0), *(const float4*)(csg + cg0 + 16), *(const float4*)(csg + cg0 + 32), *(const float4*)(csg + cg0 + 48)};
#pragma unroll
    for (int mi = 0; mi < MI; ++mi) {
      const int tok = m0 + wm * WR + mi * 16 + l16;
      const float mean_g = st2[2 * tok] * (1.f / 1024.f);
      const float rstd_g = rsqrtf(st2[2 * tok + 1] * (1.f / 1024.f) - mean_g * mean_g + 1e-5f);
      unsigned gw[8];
#pragma unroll
      for (int nj = 0; nj < 4; ++nj) {
        const float4 bb = gbv[nj], cs = gcv[nj];
        f32x4 a = acc[mi][nj];
        gw[2 * nj] = pack2(sigmoid_(rstd_g * (a[0] - mean_g * cs.x) + bb.x), sigmoid_(rstd_g * (a[1] - mean_g * cs.y) + bb.y));
        gw[2 * nj + 1] = pack2(sigmoid_(rstd_g * (a[2] - mean_g * cs.z) + bb.z), sigmoid_(rstd_g * (a[3] - mean_g * cs.w) + bb.w));
      }
      gsp4[(mi * 2 + 0) * 256 + tid] = make_uint4(gw[0], gw[1], gw[2], gw[3]);
      gsp4[(mi * 2 + 1) * 256 + tid] = make_uint4(gw[4], gw[5], gw[6], gw[7]);
    }
    zero_acc<MI>(acc);
    gemm_mainloop_big<0>(acc, smem, (const u16*)(ws + O_PB), 256, m0, 256, (const u16*)(ws + O_WT_PLE), n0, false, tid);
#pragma unroll
    for (int mi = 0; mi < MI; ++mi) {
      const int tok = m0 + wm * WR + mi * 16 + l16;
      const float mean = st2[2 * tok] * (1.f / 1024.f);
      const float rstd = rsqrtf(st2[2 * tok + 1] * (1.f / 1024.f) - mean * mean + 1e-5f);
      float s1 = 0.f, s2 = 0.f;
      const uint4 gqa = gsp4[(mi * 2 + 0) * 256 + tid], gqb = gsp4[(mi * 2 + 1) * 256 + tid];
#pragma unroll
      for (int nj = 0; nj < 4; ++nj) {
        int col = n0 + wn * 64 + nj * 16 + lq * 4;
        const uint2 yq = *(const uint2*)(yb + (long)tok * 1024 + col);
        const float4 yv = make_float4(bflo(yq.x), bfhi(yq.x), bflo(yq.y), bfhi(yq.y));
        const float4 gg = *(const float4*)(P.ln2_g + col);
        const float4 bb = *(const float4*)(P.ln2_b + col);
        f32x4 a = acc[mi][nj];
        const unsigned g01 = (nj == 0) ? gqa.x : (nj == 1) ? gqa.z : (nj == 2) ? gqb.x : gqb.z;
        const unsigned g23 = (nj == 0) ? gqa.y : (nj == 1) ? gqa.w : (nj == 2) ? gqb.y : gqb.w;
        float4 y;
        y.x = ALPHA_ * ((yv.x - mean) * rstd * gg.x + bb.x) + bflo(g01) * a[0];
        y.y = ALPHA_ * ((yv.y - mean) * rstd * gg.y + bb.y) + bfhi(g01) * a[1];
        y.z = ALPHA_ * ((yv.z - mean) * rstd * gg.z + bb.z) + bflo(g23) * a[2];
        y.w = ALPHA_ * ((yv.w - mean) * rstd * gg.w + bb.w) + bfhi(g23) * a[3];
        store4bf((u16*)(ws + O_CONCAT) + (long)tok * 1024 + col, y.x, y.y, y.z, y.w);
        s1 += y.x + y.y + y.z + y.w;
        s2 += y.x * y.x + y.y * y.y + y.z * y.z + y.w * y.w;
      }
      stat_push(st3, tok, s1, s2, lq);
    }
  }
}

constexpr int LDS_TOTAL = 2 * LDS_BUF + 512;
constexpr int CTL_OFF = 53248;
constexpr int SEL_OFF = CTL_OFF + 1024;
constexpr int IMP_OFF = 35840;
static_assert(IMP_OFF + 32 * 130 * 4 <= CTL_OFF, "lds");
static_assert(SEL_OFF + 512 <= LDS_TOTAL, "lds");

struct AttnSrc { const u16* K; long ldk; const u16* K2; const u16* V; long ldv; };
enum { AM_MLA = 0, AM_WIN = 1, AM_SLC = 2, AM_CMP = 3 };

template <int MODE, int DQ, bool DO_PV, bool FIXED_M, bool DO_IMP, bool USE_LIST, int FK = 0>
DI void attn_loop(unsigned char* smem, const AttnSrc src, int ntiles, int tile_lo, const int* tlist,
                  const bf16x8 (&qf)[DQ / 16], float& m, float& l, f32x16 (&O)[2], int t, float slope2,
                  unsigned sw0, unsigned sw1, unsigned sw2, unsigned sw3, float inv_l, unsigned* imp, int tid_in) {
  int tid = tid_in;
  asm volatile("" : "+v"(tid));
  constexpr int KST = DQ + 8;
  constexpr int KCH = DQ / 8;
  constexpr int NKL = KCH * 64 / 256;
  constexpr int KBYTES = 64 * KST * 2;
  constexpr int VST = 68;
  constexpr int VBYTES = 64 * VST * 2;
  const int lane = tid & 63, l32 = lane & 31, h = lane >> 5;
  u16* sK0 = (u16*)smem;
  u16* sV0 = (u16*)(smem + 2 * KBYTES);
  uint4 rk0, rk1, rk2, rv0, rv1;
  const int kr0 = tid / KCH, kc0 = tid % KCH;
  const int kr1 = (tid + 256) / KCH, kc1 = (tid + 256) % KCH;
  const int kr2 = (tid + 512) / KCH, kc2 = (tid + 512) % KCH;
  const int vr0 = tid >> 3, vc0 = tid & 7;
#define A_KLD(dst_, row_, ch_, tile_) { \
    if constexpr (MODE == AM_MLA) { \
      if ((ch_) < 8) dst_ = *(const uint4*)(src.K + ((long)(tile_) * 64 + (row_)) * src.ldk + (ch_) * 8); \
      else dst_ = *(const uint4*)(src.K2 + ((long)(tile_) * 64 + (row_)) * 32 + ((ch_) - 8) * 8); \
    } else dst_ = *(const uint4*)(src.K + ((long)(tile_) * 64 + (row_)) * src.ldk + (ch_) * 8); }
#define A_GLOAD(tile_) { \
    A_KLD(rk0, kr0, kc0, tile_) A_KLD(rk1, kr1, kc1, tile_) \
    if constexpr (NKL == 3) A_KLD(rk2, kr2, kc2, tile_) \
    if constexpr (DO_PV) { \
      rv0 = *(const uint4*)(src.V + (long)vr0 * src.ldv + (long)(tile_) * 64 + vc0 * 8); \
      rv1 = *(const uint4*)(src.V + (long)(vr0 + 32) * src.ldv + (long)(tile_) * 64 + vc0 * 8); } }
#define A_LSTORE(buf_) { \
    u16* sK_ = sK0 + (buf_) * (KBYTES / 2); u16* sV_ = sV0 + (buf_) * (VBYTES / 2); \
    *(uint4*)(sK_ + kr0 * KST + kc0 * 8) = rk0; *(uint4*)(sK_ + kr1 * KST + kc1 * 8) = rk1; \
    if constexpr (NKL == 3) *(uint4*)(sK_ + kr2 * KST + kc2 * 8) = rk2; \
    if constexpr (DO_PV) { \
      *(uint2*)(sV_ + vr0 * VST + vc0 * 8) = make_uint2(rv0.x, rv0.y); *(uint2*)(sV_ + vr0 * VST + vc0 * 8 + 4) = make_uint2(rv0.z, rv0.w); \
      *(uint2*)(sV_ + (vr0 + 32) * VST + vc0 * 8) = make_uint2(rv1.x, rv1.y); *(uint2*)(sV_ + (vr0 + 32) * VST + vc0 * 8 + 4) = make_uint2(rv1.z, rv1.w); } }
  __syncthreads();
  if (ntiles > 0) { const int tf = USE_LIST ? tlist[0] : tile_lo; A_GLOAD(tf) A_LSTORE(0) }
  __syncthreads();
  for (int it = 0; it < ntiles; ++it) {
    const int tile = USE_LIST ? tlist[it] : tile_lo + it;
    if (it + 1 < ntiles && FK != 1) { const int tn = USE_LIST ? tlist[it + 1] : tile_lo + it + 1; A_GLOAD(tn) }
    __builtin_amdgcn_sched_barrier(0);
    const u16* sK = sK0 + (it & 1) * (KBYTES / 2);
    const u16* sV = sV0 + (it & 1) * (VBYTES / 2);
    f32x16 S[2];
#pragma unroll
    for (int kb = 0; kb < 2; ++kb) {
#pragma unroll
      for (int i = 0; i < 16; ++i) S[kb][i] = 0.f;
#pragma unroll
      for (int s = 0; s < DQ / 16; ++s) {
        bf16x8 kf = *(const bf16x8*)(sK + (kb * 32 + l32) * KST + s * 16 + h * 8);
        S[kb] = MFMA32(kf, qf[s], S[kb]);
      }
    }
    float c0 = 0.f;
    {
      constexpr int MUL = (MODE == AM_CMP) ? 16 : 1;
      int d0;
      if constexpr (MODE == AM_CMP) d0 = t - 31 - 16 * (tile * 64 + 4 * h);
      else d0 = t - tile * 64 - 4 * h;
      bool need = true;
      if constexpr (MODE == AM_MLA) need = (tile * 64 + 63 > t - l32);
      bool selbit = true;
      if constexpr (MODE == AM_SLC) {
        const int w = tile >> 5;
        const unsigned swd = (w == 0) ? sw0 : (w == 1) ? sw1 : (w == 2) ? sw2 : sw3;
        selbit = (swd >> (tile & 31)) & 1u;
      }
      bool full = false;
      if constexpr (MODE != AM_MLA) {
        const int tw = t - l32;
        if constexpr (MODE == AM_CMP) full = ((tile * 64 + 63) * 16 + 31 <= tw);
        if constexpr (MODE == AM_WIN) full = (tile * 64 + 63 <= tw) && (tw + 31 - tile * 64 < 512);
        if constexpr (MODE == AM_SLC) full = (tile * 64 + 63 <= tw) && __all(selbit);
      }
      const float fd0 = (float)d0;
      if constexpr (MODE != AM_MLA) {
#pragma unroll
        for (int kb = 0; kb < 2; ++kb)
#pragma unroll
          for (int i = 0; i < 16; ++i) {
            const float ci = (float)(MUL * ((i & 3) + 8 * (i >> 2) + 32 * kb));
            S[kb][i] = fmaf(slope2, ci, S[kb][i]);
          }
      }
      c0 = (MODE != AM_MLA) ? -slope2 * fd0 : 0.f;
      if (need && !full) {
#pragma unroll
        for (int kb = 0; kb < 2; ++kb)
#pragma unroll
          for (int i = 0; i < 16; ++i) {
            const float ci = (float)(MUL * ((i & 3) + 8 * (i >> 2) + 32 * kb));
            const float dist = fd0 - ci;
            bool valid = dist >= 0.f;
            if constexpr (MODE == AM_WIN) valid = valid && (dist < 512.f);
            if constexpr (MODE == AM_SLC) valid = valid && selbit;
            S[kb][i] = valid ? S[kb][i] : -INFINITY;
          }
      }
    }
    if constexpr (FK != 2) {
    if constexpr (!FIXED_M) {
      float tmax = -INFINITY;
#pragma unroll
      for (int kb = 0; kb < 2; ++kb)
#pragma unroll
        for (int i = 0; i < 16; ++i) tmax = fmaxf(tmax, S[kb][i]);
      tmax += c0;
      tmax = fmaxf(tmax, __shfl_xor(tmax, 32));
      const bool need = tmax > m + 8.f;
      if (__any(need)) {
        const float mnew = need ? tmax : m;
        const float alpha = ex2(m - mnew);
        m = mnew;
        l *= alpha;
        if constexpr (DO_PV) {
#pragma unroll
          for (int db = 0; db < 2; ++db)
#pragma unroll
            for (int i = 0; i < 16; ++i) O[db][i] *= alpha;
        }
      }
    }
    const float mx = m - c0;
    {
      float ps = 0.f;
#pragma unroll
      for (int kb = 0; kb < 2; ++kb)
#pragma unroll
        for (int i = 0; i < 16; ++i) { float p = ex2(S[kb][i] - mx); S[kb][i] = p; ps += p; }
      l += ps;
    }
    }
    if constexpr (DO_IMP) {
#pragma unroll
      for (int kb = 0; kb < 2; ++kb)
#pragma unroll
        for (int a = 0; a < 4; ++a) {
          const float p0 = S[kb][4 * a] * inv_l, p1 = S[kb][4 * a + 1] * inv_l, p2 = S[kb][4 * a + 2] * inv_l, p3 = S[kb][4 * a + 3] * inv_l;
          const float mainv = 2.f * (p0 + p1 + p2) + p3;
          const int n = tile * 16 + kb * 8 + 2 * a + h;
          atomicAdd(imp + l32 * 130 + n, (unsigned)(mainv * 268435456.f));
          atomicAdd(imp + l32 * 130 + n + 1, (unsigned)(p3 * 268435456.f));
        }
    }
    if (it + 1 < ntiles) { A_LSTORE((it + 1) & 1) }
    if constexpr (DO_PV) {
#pragma unroll
      for (int sp = 0; sp < 4; ++sp) {
        const int kb = sp >> 1, hf = sp & 1;
        unsigned w0 = pack2(S[kb][8 * hf + 0], S[kb][8 * hf + 1]);
        unsigned w1 = pack2(S[kb][8 * hf + 2], S[kb][8 * hf + 3]);
        unsigned w2 = pack2(S[kb][8 * hf + 4], S[kb][8 * hf + 5]);
        unsigned w3 = pack2(S[kb][8 * hf + 6], S[kb][8 * hf + 7]);
        uint4 pw = make_uint4(w0, w1, w2, w3);
        bf16x8 pf = __builtin_bit_cast(bf16x8, pw);
#pragma unroll
        for (int db = 0; db < 2; ++db) {
          const u16* vp = sV + (db * 32 + l32) * VST + 16 * sp + 4 * h;
          s16x4 lo = *(const s16x4*)vp;
          s16x4 hi = *(const s16x4*)(vp + 8);
          bf16x8 vf = __builtin_shufflevector(lo, hi, 0, 1, 2, 3, 4, 5, 6, 7);
          O[db] = MFMA32(vf, pf, O[db]);
        }
      }
    }
    __syncthreads();
  }
  l += __shfl_xor(l, 32);
#undef A_KLD
#undef A_GLOAD
#undef A_LSTORE
}

DI void zero_o(f32x16 (&O)[2]) {
#pragma unroll
  for (int db = 0; db < 2; ++db)
#pragma unroll
    for (int i = 0; i < 16; ++i) O[db][i] = 0.f;
}

template <int FK = 0>
DI void mla_item(const Params& P, unsigned char* smem, int b, int hh, int qt, int tid_in) {
  int tid = tid_in;
  asm volatile("" : "+v"(tid));
  unsigned char* ws = P.ws;
  const int lane = tid & 63, w = tid >> 6, l32 = lane & 31, h = lane >> 5;
  const int t = qt * 128 + w * 32 + l32;
  const long tok = (long)b * T_ + t;
  bf16x8 qf[6];
#pragma unroll
  for (int s = 0; s < 6; ++s) qf[s] = *(const bf16x8*)((const u16*)(ws + O_QM) + tok * 768 + hh * 96 + s * 16 + h * 8);
  float m = -1e30f, l = 0.f;
  f32x16 O[2];
  zero_o(O);
  AttnSrc src;
  src.K = (const u16*)(ws + O_KN) + (long)b * T_ * 512 + hh * 64; src.ldk = 512;
  src.K2 = (const u16*)(ws + O_KPE) + (long)b * T_ * 32;
  src.V = (const u16*)(ws + O_VMT) + ((long)(b * 8 + hh) * 64) * T_; src.ldv = T_;
  attn_loop<AM_MLA, 96, true, false, false, false, FK>(smem, src, 2 * qt + 2, 0, nullptr, qf, m, l, O, t, 0.f, 0, 0, 0, 0, 0.f, nullptr, tid);
  if (FK != 0 && O[0][0] + O[1][5] + l != 123456.75f) return;
  const float lt = l;
  const float inv = lt > 0.f ? 1.f / lt : 0.f;
  u16* dst = (u16*)(ws + O_CONCAT) + tok * 1024 + 512 + hh * 64;
#pragma unroll
  for (int db = 0; db < 2; ++db)
#pragma unroll
    for (int a = 0; a < 4; ++a)
      store4bf(dst + db * 32 + 8 * a + 4 * h, O[db][4 * a] * inv, O[db][4 * a + 1] * inv, O[db][4 * a + 2] * inv, O[db][4 * a + 3] * inv);
}

DI u64 mk_key(int n, unsigned v, int cur) {
  if (n > cur) return 0ull;
  if (n == 0 || n == cur || n == cur - 1) v = 0xFFFFFFFFu;
  return ((u64)v << 8) | (u64)(128 - n);
}

DI void nsa_item(const Params& P, unsigned char* smem, int b, int g, int tt, int tid_in) {
  int tid = tid_in;
  asm volatile("" : "+v"(tid));
  unsigned char* ws = P.ws;
  const int lane = tid & 63, w = tid >> 6, l32 = lane & 31, h = lane >> 5;
  const int t0 = tt * 32;
  const int t = t0 + l32;
  const long tok = (long)b * T_ + t;
  const int head8 = g * 4 + w;
  int* ctl = (int*)(smem + CTL_OFF);
  unsigned* sel = (unsigned*)(smem + SEL_OFF);
  unsigned* imp = (unsigned*)(smem + IMP_OFF);
  bf16x8 qf[4];
#pragma unroll
  for (int s = 0; s < 4; ++s) qf[s] = *(const bf16x8*)((const u16*)(ws + O_QN) + tok * 512 + head8 * 64 + s * 16 + h * 8);
  const float* gp = (const float*)(ws + O_GATES) + tok * 24 + head8 * 3;
  const float g0 = gp[0], g1 = gp[1], g2 = gp[2];
  const float slope2 = LOG2E_ * exp2f(-(float)(head8 + 1));
  __syncthreads();
  for (int i = tid; i < 32 * 130; i += 256) imp[i] = 0u;
  if (tid < 4) ctl[4 + tid] = 0;
  f32x16 O[2];
  float m = -1e30f, l = 0.f;
  float* osp = (float*)(ws + O_Y2) + (long)blockIdx.x * 16384 + tid;
  AttnSrc sc;
  sc.K = (const u16*)(ws + O_CMPK) + ((long)(b * 2 + g) * 512) * 64; sc.ldk = 64; sc.K2 = nullptr;
  sc.V = (const u16*)(ws + O_CMPVT) + ((long)(b * 2 + g) * 64) * 512; sc.ldv = 512;
  const int ntc = (t0 >> 10) + 1;
  attn_loop<AM_CMP, 64, false, false, false, false>(smem, sc, ntc, 0, nullptr, qf, m, l, O, t, slope2, 0, 0, 0, 0, 0.f, nullptr, tid);
  {
    const float lt = l;
    const float inv_l = lt > 0.f ? 1.f / lt : 0.f;
    zero_o(O);
    float l2 = 0.f;
    attn_loop<AM_CMP, 64, true, true, true, false>(smem, sc, ntc, 0, nullptr, qf, m, l2, O, t, slope2, 0, 0, 0, 0, inv_l, imp, tid);
    const float sc0 = g0 * inv_l;
#pragma unroll
    for (int db = 0; db < 2; ++db)
#pragma unroll
      for (int i = 0; i < 16; ++i) osp[(db * 16 + i) * 256] = O[db][i] * sc0;
  }
  for (int tk = 0; tk < 8; ++tk) {
    const int token = w * 8 + tk;
    const int cur = (t0 + token) >> 6;
    const u64 k0 = mk_key(lane, imp[token * 130 + lane], cur);
    const u64 k1 = mk_key(lane + 64, imp[token * 130 + lane + 64], cur);
    u64 thr = 0ull;
    for (int bit = 39; bit >= 0; --bit) {
      const u64 cand = thr | (1ull << bit);
      const int c = __popcll(__ballot(k0 >= cand)) + __popcll(__ballot(k1 >= cand));
      if (c >= 16) thr = cand;
    }
    const u64 m0 = __ballot(k0 >= thr && k0 > 0ull);
    const u64 m1 = __ballot(k1 >= thr && k1 > 0ull);
    if (lane == 0) {
      sel[token * 4 + 0] = (unsigned)m0; sel[token * 4 + 1] = (unsigned)(m0 >> 32);
      sel[token * 4 + 2] = (unsigned)m1; sel[token * 4 + 3] = (unsigned)(m1 >> 32);
      atomicOr((unsigned*)&ctl[4], (unsigned)m0); atomicOr((unsigned*)&ctl[5], (unsigned)(m0 >> 32));
      atomicOr((unsigned*)&ctl[6], (unsigned)m1); atomicOr((unsigned*)&ctl[7], (unsigned)(m1 >> 32));
    }
  }
  __syncthreads();
  if (tid == 0) {
    int c = 0;
    for (int q = 0; q < 4; ++q) {
      unsigned u = (unsigned)ctl[4 + q];
      while (u) { int bp = __ffs(u) - 1; ctl[8 + c] = q * 32 + bp; ++c; u &= u - 1; }
    }
    ctl[1] = c;
  }
  __syncthreads();
  const int nsl = ctl[1];
  const unsigned sw0 = sel[l32 * 4 + 0], sw1 = sel[l32 * 4 + 1], sw2 = sel[l32 * 4 + 2], sw3 = sel[l32 * 4 + 3];
  {
    AttnSrc ss;
    ss.K = (const u16*)(ws + O_KS) + (long)b * T_ * 128 + g * 64; ss.ldk = 128; ss.K2 = nullptr;
    ss.V = (const u16*)(ws + O_VST) + ((long)(b * 2 + g) * 64) * T_; ss.ldv = T_;
    m = -1e30f; l = 0.f; zero_o(O);
    attn_loop<AM_SLC, 64, true, false, false, true>(smem, ss, nsl, 0, ctl + 8, qf, m, l, O, t, slope2, sw0, sw1, sw2, sw3, 0.f, nullptr, tid);
    const float lt = l;
    const float sc1 = lt > 0.f ? g1 / lt : 0.f;
#pragma unroll
    for (int db = 0; db < 2; ++db)
#pragma unroll
      for (int i = 0; i < 16; ++i) osp[8192 + (db * 16 + i) * 256] = O[db][i] * sc1;
  }
  {
    AttnSrc sw;
    sw.K = (const u16*)(ws + O_KW) + (long)b * T_ * 128 + g * 64; sw.ldk = 128; sw.K2 = nullptr;
    sw.V = (const u16*)(ws + O_VWT) + ((long)(b * 2 + g) * 64) * T_; sw.ldv = T_;
    const int lo = (t0 > 511 ? (t0 - 511) : 0) >> 6, hi = (t0 + 31) >> 6;
    m = -1e30f; l = 0.f; zero_o(O);
    attn_loop<AM_WIN, 64, true, false, false, false>(smem, sw, hi - lo + 1, lo, nullptr, qf, m, l, O, t, slope2, 0, 0, 0, 0, 0.f, nullptr, tid);
    const float lt = l;
    const float sc2 = lt > 0.f ? g2 / lt : 0.f;
#pragma unroll
    for (int db = 0; db < 2; ++db)
#pragma unroll
      for (int i = 0; i < 16; ++i) O[db][i] = O[db][i] * sc2 + osp[(db * 16 + i) * 256] + osp[8192 + (db * 16 + i) * 256];
  }
  u16* dst = (u16*)(ws + O_CONCAT) + tok * 1024 + head8 * 64;
#pragma unroll
  for (int db = 0; db < 2; ++db)
#pragma unroll
    for (int a = 0; a < 4; ++a)
      store4bf(dst + db * 32 + 8 * a + 4 * h, O[db][4 * a], O[db][4 * a + 1], O[db][4 * a + 2], O[db][4 * a + 3]);
}

DI void ln_apply_pass(const u16* src, const float* st, u16* dst, int tid, int nb) {
  const int lane = tid & 63;
  for (int row = blockIdx.x * 4 + (tid >> 6); row < M_; row += nb * 4) {
    const float mean = st[2 * row] * (1.f / 1024.f);
    const float rstd = rsqrtf(st[2 * row + 1] * (1.f / 1024.f) - mean * mean + 1e-5f);
    const u16* o = src + (long)row * 1024;
#pragma unroll
    for (int i = 0; i < 2; ++i) {
      const int c = lane * 8 + 512 * i;
      const uint4 v = *(const uint4*)(o + c);
      *(uint4*)(dst + (long)row * 1024 + c) = make_uint4(pack2((bflo(v.x) - mean) * rstd, (bfhi(v.x) - mean) * rstd), pack2((bflo(v.y) - mean) * rstd, (bfhi(v.y) - mean) * rstd),
                                                        pack2((bflo(v.z) - mean) * rstd, (bfhi(v.z) - mean) * rstd), pack2((bflo(v.w) - mean) * rstd, (bfhi(v.w) - mean) * rstd));
    }
  }
}

#ifndef REP
#define REP 0
#endif
#ifndef FAKEV
#define FAKEV 0
#endif
DI void tile_map(int i, int NT, int& mt, int& nt, int mpx = 64) {
  const int xcd = i & 7, j = i >> 3;
  const int ms = j / (8 * NT), r = j - ms * 8 * NT;
  nt = r >> 3;
  mt = xcd * mpx + ms * 8 + (r & 7);
}

template <int PMODE = 0, int FK = 0>
DI void phase4(const Params& P, unsigned char* smem, int tid, int cbase) {
  {
    int* ctr = (int*)(P.ws + O_CTR) + cbase;
    int* ctl = (int*)(smem + CTL_OFF);
    const int xcd = blockIdx.x & 7;
    bool mla_done = false;
    for (;;) {
      __syncthreads();
      if (tid == 0) {
        int it = -1;
        if (!mla_done) { int k = atomicAdd(ctr + xcd, 1); if (k < 512) it = k; }
        if (it < 0) { if (PMODE == 1) it = 8192; else { int j = atomicAdd(ctr + 8, 1); it = (j < 4096) ? 4096 + j : 8192; } }
        ctl[0] = it;
      }
      __syncthreads();
      const int item = ctl[0];
      if (item >= 8192) break;
#ifndef SKIP_MLA
      if (item < 4096) {
        const int qt = 63 - (item & 63), bh = (item >> 6) * 8 + xcd;
        mla_item<FK>(P, smem, bh >> 3, bh & 7, qt, tid);
      }
#endif
      if (item >= 4096) mla_done = true;
#ifndef SKIP_NSA
      if (item >= 4096) {
        const int j = item - 4096;
        const int tt = 255 - (j >> 4), bg = j & 15;
        nsa_item(P, smem, bg >> 1, bg & 1, tt, tid);
      }
#endif
    }
  }
}

#define XB_XCNT(j)  (64 * (j))
#define XB_XSUB(j)  (1024 + 64 * (j))
#define XB_XGEN(j)  (2048 + 64 * (j))
#define XB_TOP      3072
#define XB_TOPGEN   3136
#define XB_WORDS    3200
DI unsigned xb_ld(unsigned* p) { return __hip_atomic_load(p, __ATOMIC_RELAXED, __HIP_MEMORY_SCOPE_AGENT); }
DI unsigned xb_add(unsigned* p, unsigned v) { return __hip_atomic_fetch_add(p, v, __ATOMIC_RELAXED, __HIP_MEMORY_SCOPE_AGENT); }
DI unsigned xb_xcc_id() { return (unsigned)__builtin_amdgcn_s_getreg((3 << 11) | 20) & 0xFu; }
struct XBar { unsigned* bar; unsigned x, nloc, nx; };
DI void gsync(const XBar& b, int tid) {
  asm volatile("s_waitcnt vmcnt(0)" ::: "memory");
  __syncthreads();
  if (tid == 0) {
    unsigned* bar = b.bar;
    __builtin_amdgcn_s_waitcnt(0);
    const unsigned old = xb_add(&bar[XB_XSUB(b.x)], 1u);
    const unsigned gen = old / b.nloc;
    if (old + 1u == (gen + 1u) * b.nloc) {
      __builtin_amdgcn_fence(__ATOMIC_RELEASE, "agent");
      asm volatile("s_waitcnt vmcnt(0)" ::: "memory");
      const unsigned og = xb_add(&bar[XB_TOP], 1u);
      const unsigned tg = og / b.nx;
      if (og + 1u == (tg + 1u) * b.nx) xb_add(&bar[XB_TOPGEN], 1u);
      else while (xb_ld(&bar[XB_TOPGEN]) == tg) __builtin_amdgcn_s_sleep(1);
      __builtin_amdgcn_fence(__ATOMIC_ACQUIRE, "agent");
      xb_add(&bar[XB_XGEN(b.x)], 1u);
      asm volatile("s_waitcnt vmcnt(0)" ::: "memory");
    } else {
      while (xb_ld(&bar[XB_XGEN(b.x)]) == gen) __builtin_amdgcn_s_sleep(1);
      __builtin_amdgcn_fence(__ATOMIC_ACQUIRE, "agent");
      asm volatile("s_waitcnt vmcnt(0)" ::: "memory");
    }
  }
  __syncthreads();
}

__global__ void __launch_bounds__(256, 2) fwd_megakernel(Params P) {
  cg::grid_group grid = cg::this_grid();
  extern __shared__ __attribute__((aligned(16))) unsigned char smem[];
  const int tid = threadIdx.x;
  const int nb = gridDim.x;
  XBar xb; xb.bar = (unsigned*)(P.ws + O_BAR); xb.x = xb_xcc_id(); xb.nloc = 1u; xb.nx = 1u;
  if (tid == 0) (void)xb_add(&xb.bar[XB_XCNT(xb.x)], 1u);

#ifndef SKIP_P0
  phase0(P, smem, tid);
#endif
  if (P.ws == nullptr) grid.sync();
  if (tid == 0) {
    unsigned mine = 0u, cnt = 0u, sum = 0u;
    for (;;) {
      mine = 0u; cnt = 0u; sum = 0u;
#pragma unroll
      for (unsigned j = 0; j < 16; ++j) { const unsigned c = xb_ld(&xb.bar[XB_XCNT(j)]); sum += c; cnt += (c > 0u) ? 1u : 0u; mine = (j == xb.x) ? c : mine; }
      if (sum == gridDim.x) break;
      __builtin_amdgcn_s_sleep(1);
    }
    xb.nloc = mine > 0u ? mine : 1u; xb.nx = cnt > 0u ? cnt : 1u;
  }
  gsync(xb, tid);
#ifndef SKIP_P1
  for (int i = blockIdx.x; i < 512 * 14; i += nb) { int mt, nt; tile_map(i, 14, mt, nt); gemm_tile<PH_IN>(P, smem, mt, nt, 0, tid); }
#if REP == 11
  for (int q = 0; q < 20; ++q) gsync(xb, tid);
#endif
#if REP == 1
  gsync(xb, tid);
  for (int i = blockIdx.x; i < 512 * 14; i += nb) { int mt, nt; tile_map(i, 14, mt, nt); gemm_tile<PH_IN>(P, smem, mt, nt, 0, tid); }
#endif
#endif
  gsync(xb, tid);
#ifndef SKIP_P2
  for (int i = blockIdx.x; i < 256 + 3072 + 4096; i += nb) {
    if (i < 256) gemm_tile<PH_C1>(P, smem, (i >> 1) & 63, i & 1, i >> 7, tid);
    else if (i < 256 + 3072) { int mt, nt; tile_map(i - 256, 6, mt, nt); gemm_tile<PH_UQ>(P, smem, mt, nt, 0, tid); }
    else { int mt, nt; tile_map(i - 256 - 3072, 8, mt, nt); gemm_tile<PH_UKV>(P, smem, mt, nt, 0, tid); }
  }
#endif
#if REP == 2
  gsync(xb, tid);
  for (int i = blockIdx.x; i < 256 + 3072 + 4096; i += nb) {
    if (i < 256) gemm_tile<PH_C1>(P, smem, (i >> 1) & 63, i & 1, i >> 7, tid);
    else if (i < 256 + 3072) { int mt, nt; tile_map(i - 256, 6, mt, nt); gemm_tile<PH_UQ>(P, smem, mt, nt, 0, tid); }
    else { int mt, nt; tile_map(i - 256 - 3072, 8, mt, nt); gemm_tile<PH_UKV>(P, smem, mt, nt, 0, tid); }
  }
#endif
  gsync(xb, tid);
#ifndef SKIP_P3
  for (int i = blockIdx.x; i < 128; i += nb) gemm_tile<PH_C2>(P, smem, i & 63, 0, i >> 6, tid);
#endif
  gsync(xb, tid);
  phase4(P, smem, tid, 0);
#if REP == 4
  gsync(xb, tid);
  phase4<0, 0>(P, smem, tid, 16);
#endif
#if REP == 41
  gsync(xb, tid);
  phase4<1, FAKEV>(P, smem, tid, 16);
#endif
  gsync(xb, tid);
  {
    u16* pb = (u16*)(P.ws + O_PB);
    for (long i = (long)blockIdx.x * 256 + tid; i < (long)M_ * 256 / 8; i += (long)nb * 256) {
      const float4 a = *(const float4*)(P.p + i * 8), b = *(const float4*)(P.p + i * 8 + 4);
      *(uint4*)(pb + i * 8) = make_uint4(pack2(a.x, a.y), pack2(a.z, a.w), pack2(b.x, b.y), pack2(b.z, b.w));
    }
  }
#ifndef SKIP_P5
  for (int i = blockIdx.x; i < 256 * 8; i += nb) { int mt, nt; tile_map(i, 8, mt, nt, 32); gemm_tile<PH_OUT>(P, smem, mt, nt, 0, tid); }
#endif
  gsync(xb, tid);
#ifndef SKIP_P6
  for (int i = blockIdx.x; i < 256 * 44; i += nb) { int mt, nt; tile_map(i, 44, mt, nt, 32); gemm_tile<PH_UP>(P, smem, mt, nt, 0, tid); }
#if REP == 6
  gsync(xb, tid);
  for (int i = blockIdx.x; i < 256 * 44; i += nb) { int mt, nt; tile_map(i, 44, mt, nt, 32); gemm_tile<PH_UP, FAKEV>(P, smem, mt, nt, 0, tid); }
#endif
#endif
  gsync(xb, tid);
#ifndef SKIP_P7
  for (int i = blockIdx.x; i < 256 * 8; i += nb) { int mt, nt; tile_map(i, 8, mt, nt, 32); gemm_tile<PH_DOWN>(P, smem, mt, nt, 0, tid); }
#endif
  gsync(xb, tid);
#ifndef SKIP_P8
  for (int i = blockIdx.x; i < 256 * 8; i += nb) { int mt, nt; tile_map(i, 8, mt, nt, 32); gemm_tile<PH_PLE>(P, smem, mt, nt, 0, tid); }
#endif
  gsync(xb, tid);
  {
    const float* st3 = (const float*)(P.ws + O_STATS) + (long)M_ * 4;
    const int lane = tid & 63;
    for (int row = blockIdx.x * 4 + (tid >> 6); row < M_; row += nb * 4) {
      const float mean = st3[2 * row] * (1.f / 1024.f);
      const float rstd = rsqrtf(st3[2 * row + 1] * (1.f / 1024.f) - mean * mean + 1e-5f);
      float* o = P.out + (long)row * 1024;
      const u16* yb = (const u16*)(P.ws + O_CONCAT) + (long)row * 1024;
#pragma unroll
      for (int i = 0; i < 4; ++i) {
        const int c = lane * 4 + 256 * i;
        const uint2 yq = *(const uint2*)(yb + c);
        float4 v = make_float4(bflo(yq.x), bfhi(yq.x), bflo(yq.y), bfhi(yq.y));
        const float4 gg = *(const float4*)(P.ln3_g + c);
        const float4 bb = *(const float4*)(P.ln3_b + c);
        v.x = (v.x - mean) * rstd * gg.x + bb.x;
        v.y = (v.y - mean) * rstd * gg.y + bb.y;
        v.z = (v.z - mean) * rstd * gg.z + bb.z;
        v.w = (v.w - mean) * rstd * gg.w + bb.w;
        *(float4*)(o + c) = v;
      }
    }
  }
}

extern "C" void kernel_launch(void* const* d_in, const int* in_sizes, int n_in,
                              void* d_out, int out_size, void* d_ws, size_t ws_size,
                              hipStream_t stream) {
  static int grid_blocks = 0;
  if (!grid_blocks) {
    int dev = 0, cus = 0, per_cu = 0;
    (void)hipGetDevice(&dev);
    (void)hipDeviceGetAttribute(&cus, hipDeviceAttributeMultiprocessorCount, dev);
    (void)hipFuncSetAttribute((const void*)fwd_megakernel, hipFuncAttributeMaxDynamicSharedMemorySize, LDS_TOTAL);
    (void)hipOccupancyMaxActiveBlocksPerMultiprocessor(&per_cu, fwd_megakernel, 256, LDS_TOTAL);
    if (per_cu < 1) per_cu = 1;
    if (per_cu > 2) per_cu = 2;
    grid_blocks = cus * per_cu;
    fprintf(stderr, "grid_blocks=%d (cus=%d per_cu=%d) ws_need=%zu ws_size=%zu\n", grid_blocks, cus, per_cu, (size_t)WS_NEED, ws_size);
  }
  if (ws_size < WS_NEED || n_in < 24) { fprintf(stderr, "kernel_launch: workspace too small or bad inputs\n"); return; }
  (void)hipMemsetAsync((unsigned char*)d_ws + O_BAR, 0, 16384, stream);
  Params p{};
  const float** pp = (const float**)&p;
  for (int i = 0; i < 24; ++i) pp[i] = (const float*)d_in[i];
  p.out = (float*)d_out;
  p.ws = (unsigned char*)d_ws;
  void* args[] = {&p};
  hipError_t e = hipLaunchCooperativeKernel((void*)fwd_megakernel, dim3(grid_blocks), dim3(256), args, LDS_TOTAL, stream);
  if (e != hipSuccess) fprintf(stderr, "cooperative launch failed: %s (grid %d)\n", hipGetErrorString(e), grid_blocks);
}
```

```cpp
#include <hip/hip_runtime.h>
#include <hip/hip_cooperative_groups.h>
#include <cstdio>
#include <cstdint>
namespace cg = cooperative_groups;

#define DI __device__ __forceinline__
typedef unsigned short u16;
typedef unsigned long long u64;
typedef __attribute__((ext_vector_type(8))) short bf16x8;
typedef __attribute__((ext_vector_type(4))) short s16x4;
typedef __attribute__((ext_vector_type(4))) float f32x4;
typedef __attribute__((ext_vector_type(16))) float f32x16;
typedef __attribute__((ext_vector_type(2))) __bf16 bf2_t;

constexpr int T_ = 8192;
constexpr int M_ = 65536;
constexpr float ALPHA_ = 1.189207115002721f;
constexpr float LOG2E_ = 1.4426950408889634f;

constexpr size_t AL(size_t x) { return (x + 255) & ~(size_t)255; }
constexpr size_t O_WT_IN   = 0;
constexpr size_t O_WT_UQ   = O_WT_IN   + AL((size_t)1792 * 1024 * 2);
constexpr size_t O_WT_UKV  = O_WT_UQ   + AL((size_t)768 * 256 * 2);
constexpr size_t O_WT_CK1  = O_WT_UKV  + AL((size_t)1024 * 128 * 2);
constexpr size_t O_WT_CV1  = O_WT_CK1  + AL((size_t)256 * 2048 * 2);
constexpr size_t O_WT_CK2  = O_WT_CV1  + AL((size_t)256 * 2048 * 2);
constexpr size_t O_WT_CV2  = O_WT_CK2  + AL((size_t)128 * 256 * 2);
constexpr size_t O_WT_OUT  = O_WT_CV2  + AL((size_t)128 * 256 * 2);
constexpr size_t O_WT_UP   = O_WT_OUT  + AL((size_t)1024 * 1024 * 2);
constexpr size_t O_WT_DOWN = O_WT_UP   + AL((size_t)5632 * 1024 * 2);
constexpr size_t O_WT_GATE = O_WT_DOWN + AL((size_t)1024 * 2816 * 2);
constexpr size_t O_WT_PLE  = O_WT_GATE + AL((size_t)1024 * 1024 * 2);
constexpr size_t O_BIAS1K  = O_WT_PLE  + AL((size_t)1024 * 256 * 2);
constexpr size_t O_BIAS1V  = O_BIAS1K  + AL(256 * 4);
constexpr size_t O_BIAS_UP = O_BIAS1V  + AL(256 * 4);
constexpr size_t O_BIAS_G  = O_BIAS_UP + AL(5632 * 4);
constexpr size_t O_CSUM_UP = O_BIAS_G  + AL(1024 * 4);
constexpr size_t O_CSUM_G  = O_CSUM_UP + AL(5632 * 4);
constexpr size_t O_ROPE_C  = O_CSUM_G  + AL(1024 * 4);
constexpr size_t O_ROPE_S  = O_ROPE_C  + AL((size_t)8192 * 16 * 4);
constexpr size_t O_STATS   = O_ROPE_S  + AL((size_t)8192 * 16 * 4);
constexpr size_t O_SSQ     = O_STATS   + AL((size_t)3 * M_ * 2 * 4);
constexpr size_t O_CTR     = O_SSQ     + AL((size_t)2 * M_ * 4);
constexpr size_t O_BAR     = O_CTR     + 256;
constexpr size_t O_HID     = O_BAR     + 16384;
constexpr size_t O_CMPK    = O_HID     + AL((size_t)2 * 8192 * 256 * 2);
constexpr size_t O_CMPVT   = O_CMPK    + AL((size_t)16 * 512 * 64 * 2);
constexpr size_t O_CONCAT  = O_CMPVT   + AL((size_t)16 * 64 * 512 * 2);
constexpr size_t O_Y2      = O_CONCAT  + AL((size_t)M_ * 1024 * 2);
constexpr size_t O_R1      = O_Y2      + AL((size_t)M_ * 1024 * 4);
constexpr size_t O_QN      = O_R1;
constexpr size_t O_KC      = O_QN   + AL((size_t)M_ * 512 * 2);
constexpr size_t O_VC      = O_KC   + AL((size_t)M_ * 128 * 2);
constexpr size_t O_KS      = O_VC   + AL((size_t)M_ * 128 * 2);
constexpr size_t O_VST     = O_KS   + AL((size_t)M_ * 128 * 2);
constexpr size_t O_KW      = O_VST  + AL((size_t)M_ * 128 * 2);
constexpr size_t O_VWT     = O_KW   + AL((size_t)M_ * 128 * 2);
constexpr size_t O_CQ      = O_VWT  + AL((size_t)M_ * 128 * 2);
constexpr size_t O_CKV     = O_CQ   + AL((size_t)M_ * 256 * 2);
constexpr size_t O_KPE     = O_CKV  + AL((size_t)M_ * 128 * 2);
constexpr size_t O_GATES   = O_KPE  + AL((size_t)M_ * 32 * 2);
constexpr size_t O_QM      = O_GATES + AL((size_t)M_ * 24 * 4);
constexpr size_t O_KN      = O_QM   + AL((size_t)M_ * 768 * 2);
constexpr size_t O_VMT     = O_KN   + AL((size_t)M_ * 512 * 2);
constexpr size_t O_R1_END  = O_VMT  + AL((size_t)M_ * 512 * 2);
constexpr size_t O_HBUF    = O_R1;
constexpr size_t O_PB      = O_R1 + AL((size_t)M_ * 2816 * 2);
static_assert(O_PB + (size_t)M_ * 256 * 2 <= O_R1_END, "PB alias");
static_assert(O_R1_END - O_R1 >= (size_t)M_ * 2816 * 2, "HBUF alias too small");
constexpr size_t O_YB      = O_R1_END;
constexpr size_t WS_NEED   = O_YB + AL((size_t)M_ * 1024 * 2);
static_assert(WS_NEED <= (size_t)1073741824, "workspace budget (4 x largest tensor)");

struct Params {
  const float *x, *p, *w_in, *w_ck1, *w_ck2, *pos_ck, *w_cv1, *w_cv2, *pos_cv, *qn_g, *w_uq, *kvn_g, *w_ukv, *w_out,
      *ln1_g, *ln1_b, *w_up, *w_down, *ln2_g, *ln2_b, *w_pg, *w_ple, *ln3_g, *ln3_b;
  float* out;
  unsigned char* ws;
};

DI unsigned pack2(float a, float b) { bf2_t v; v[0] = (__bf16)a; v[1] = (__bf16)b; return __builtin_bit_cast(unsigned, v); }
DI void store4bf(u16* p, float a, float b, float c, float d) { *(uint2*)p = make_uint2(pack2(a, b), pack2(c, d)); }
DI float bflo(unsigned u) { return __uint_as_float(u << 16); }
DI float bfhi(unsigned u) { return __uint_as_float(u & 0xffff0000u); }
DI float sigmoid_(float x) { return 1.f / (1.f + __expf(-x)); }
DI float gelu_tanh_(float x) {
  float u = 0.7978845608028654f * (x + 0.044715f * x * x * x);
  float e = __expf(2.f * u);
  float th = 1.f - 2.f / (e + 1.f);
  return 0.5f * x * (1.f + th);
}
DI float ex2(float x) { return __builtin_amdgcn_exp2f(x); }
#define MFMA16(a, b, c) __builtin_amdgcn_mfma_f32_16x16x32_bf16((a), (b), (c), 0, 0, 0)
#define MFMA32(a, b, c) __builtin_amdgcn_mfma_f32_32x32x16_bf16((a), (b), (c), 0, 0, 0)

DI int map_in(int n) {
  if (n < 1280) return n;
  if (n < 1536) return 1304 + (n - 1280);
  if (n < 1664) return 1560 + (n - 1536);
  if (n < 1696) return 1688 + (n - 1664);
  if (n < 1720) return 1280 + (n - 1696);
  return -1;
}
DI int map_up(int n) {
  int t = n >> 7, c = n & 127, wc = c >> 6, j = (c >> 4) & 3, i = c & 15;
  int base = 64 * t + wc * 32 + (i >> 2) * 8 + (j & 1) * 4 + (i & 3);
  return (j < 2) ? base : 2816 + base;
}

struct TJob { const float* src; u16* dst; const float* scale; int K, Nsrc, map; };
DI TJob get_tjob(const Params& P, int j) {
  TJob t; t.scale = nullptr; t.map = 0;
  unsigned char* ws = P.ws;
  switch (j) {
    case 0: t.src = P.w_in; t.dst = (u16*)(ws + O_WT_IN); t.K = 1024; t.Nsrc = 1720; t.map = 1; break;
    case 1: t.src = P.w_uq; t.dst = (u16*)(ws + O_WT_UQ); t.K = 256; t.Nsrc = 768; t.scale = P.qn_g; break;
    case 2: t.src = P.w_ukv; t.dst = (u16*)(ws + O_WT_UKV); t.K = 128; t.Nsrc = 1024; t.scale = P.kvn_g; break;
    case 3: t.src = P.w_ck1; t.dst = (u16*)(ws + O_WT_CK1); t.K = 2048; t.Nsrc = 256; break;
    case 4: t.src = P.w_cv1; t.dst = (u16*)(ws + O_WT_CV1); t.K = 2048; t.Nsrc = 256; break;
    case 5: t.src = P.w_ck2; t.dst = (u16*)(ws + O_WT_CK2); t.K = 256; t.Nsrc = 64; break;
    case 6: t.src = P.w_cv2; t.dst = (u16*)(ws + O_WT_CV2); t.K = 256; t.Nsrc = 64; break;
    case 7: t.src = P.w_out; t.dst = (u16*)(ws + O_WT_OUT); t.K = 1024; t.Nsrc = 1024; break;
    case 8: t.src = P.w_up; t.dst = (u16*)(ws + O_WT_UP); t.K = 1024; t.Nsrc = 5632; t.map = 2; t.scale = P.ln1_g; break;
    case 9: t.src = P.w_down; t.dst = (u16*)(ws + O_WT_DOWN); t.K = 2816; t.Nsrc = 1024; break;
    case 10: t.src = P.w_pg; t.dst = (u16*)(ws + O_WT_GATE); t.K = 1024; t.Nsrc = 1024; t.scale = P.ln2_g; break;
    default: t.src = P.w_ple; t.dst = (u16*)(ws + O_WT_PLE); t.K = 256; t.Nsrc = 1024; break;
  }
  return t;
}

DI void phase0(const Params& P, unsigned char* smem, int tid) {
  const int NTL[12] = {448, 48, 32, 128, 128, 4, 4, 256, 1408, 704, 256, 64};
  constexpr int TOT_T = 3480;
  constexpr int TOT_U = TOT_T + 896;
  float* tl = (float*)smem;
  for (int pass = 0; pass < 2; ++pass) {
  if ((pass ^ (int)(blockIdx.x >> 3)) & 1) {
  for (int u = blockIdx.x; u < TOT_U; u += gridDim.x) {
    __syncthreads();
    if (u < TOT_T) {
      int j = 0, ti = u;
#pragma unroll
      for (int q = 0; q < 12; ++q) { if (j == q && ti >= NTL[q]) { ti -= NTL[q]; j = q + 1; } }
      TJob jb = get_tjob(P, j);
      const int nkt = jb.K >> 6;
      const int k0 = (ti % nkt) * 64, n0 = (ti / nkt) * 64;
#pragma unroll
      for (int i = 0; i < 16; ++i) {
        int kk = i * 4 + (tid >> 6), nn = tid & 63;
        int n = n0 + nn;
        int sn = (jb.map == 1) ? map_in(n) : (jb.map == 2 ? map_up(n) : n);
        float v = 0.f;
        if (sn >= 0) v = jb.src[(long)(k0 + kk) * jb.Nsrc + sn];
        if (jb.scale) v *= jb.scale[k0 + kk];
        tl[kk * 65 + nn] = v;
      }
      __syncthreads();
      {
        int n = tid >> 2, kq = tid & 3;
        unsigned w[8];
#pragma unroll
        for (int e = 0; e < 8; ++e) w[e] = pack2(tl[(kq * 16 + 2 * e) * 65 + n], tl[(kq * 16 + 2 * e + 1) * 65 + n]);
        u16* d = jb.dst + (long)(n0 + n) * jb.K + k0 + kq * 16;
        *(uint4*)d = make_uint4(w[0], w[1], w[2], w[3]);
        *(uint4*)(d + 8) = make_uint4(w[4], w[5], w[6], w[7]);
      }
    } else {
      int bu = u - TOT_T;
      const float* vec; const float* vec2 = nullptr; const float* W; float* dst; float* dst2 = nullptr; int K, Nsrc, mp = 0;
      if (bu < 32) { vec = P.pos_ck; W = P.w_ck1; dst = (float*)(P.ws + O_BIAS1K); K = 2048; Nsrc = 256; }
      else if (bu < 64) { bu -= 32; vec = P.pos_cv; W = P.w_cv1; dst = (float*)(P.ws + O_BIAS1V); K = 2048; Nsrc = 256; }
      else if (bu < 768) { bu -= 64; vec = P.ln1_b; vec2 = P.ln1_g; W = P.w_up; dst = (float*)(P.ws + O_BIAS_UP); dst2 = (float*)(P.ws + O_CSUM_UP); K = 1024; Nsrc = 5632; mp = 2; }
      else { bu -= 768; vec = P.ln2_b; vec2 = P.ln2_g; W = P.w_pg; dst = (float*)(P.ws + O_BIAS_G); dst2 = (float*)(P.ws + O_CSUM_G); K = 1024; Nsrc = 1024; }
      int c = tid & 7, kg = tid >> 3;
      int n = bu * 8 + c;
      int sn = (mp == 2) ? map_up(n) : n;
      float sa = 0.f, sb = 0.f;
      if (vec2) {
#pragma unroll 8
        for (int k = kg; k < K; k += 32) { const float w = W[(long)k * Nsrc + sn]; sa += vec[k] * w; sb += vec2[k] * w; }
      } else {
#pragma unroll 8
        for (int k = kg; k < K; k += 32) sa += vec[k] * W[(long)k * Nsrc + sn];
      }
      tl[kg * 8 + c] = sa; tl[256 + kg * 8 + c] = sb;
      __syncthreads();
      if (tid < 8) {
        float a0 = 0.f, a1 = 0.f;
#pragma unroll
        for (int q = 0; q < 32; ++q) { a0 += tl[q * 8 + tid]; a1 += tl[256 + q * 8 + tid]; }
        dst[bu * 8 + tid] = a0;
        if (dst2) dst2[bu * 8 + tid] = a1;
      }
    }
  }
  } else {
    const long gtid0 = (long)blockIdx.x * 256 + tid, gstr0 = (long)gridDim.x * 256;
    u16* xb = (u16*)(P.ws + O_CONCAT);
    for (long i = gtid0; i < (long)M_ * 1024 / 8; i += gstr0) {
      const float4 a = *(const float4*)(P.x + i * 8), b = *(const float4*)(P.x + i * 8 + 4);
      *(uint4*)(xb + i * 8) = make_uint4(pack2(a.x, a.y), pack2(a.z, a.w), pack2(b.x, b.y), pack2(b.z, b.w));
    }
  }
  }
  const long gtid = (long)blockIdx.x * 256 + tid, gstr = (long)gridDim.x * 256;
  float* rc = (float*)(P.ws + O_ROPE_C);
  float* rs = (float*)(P.ws + O_ROPE_S);
  for (long i = gtid; i < 8192 * 16; i += gstr) {
    int pos = (int)(i >> 4), f = (int)(i & 15);
    float inv = powf(10000.0f, -(float)f / 16.0f);
    float ang = (float)pos * inv;
    rc[i] = cosf(ang); rs[i] = sinf(ang);
  }
  float* st = (float*)(P.ws + O_STATS);
  for (long i = gtid; i < (long)3 * M_ * 2; i += gstr) st[i] = 0.f;
  { float* sq = (float*)(P.ws + O_SSQ); for (long i = gtid; i < (long)2 * M_; i += gstr) sq[i] = 0.f; }
  if (gtid < 64) ((int*)(P.ws + O_CTR))[gtid] = 0;
}

constexpr int LDS_BUF = 32768;
constexpr int LDS_RS_OFF = 2 * LDS_BUF;

template <int AMODE, int FAKE = 0>
DI void gemm_mainloop(f32x4 (&acc)[4][4], unsigned char* smem, const void* A, long lda, int m0, int K,
                      const u16* Bt, int n0, const float* stats, bool ns, int tid) {
  const int lane = tid & 63, wave = tid >> 6, wm = wave >> 1, wn = wave & 1;
  const int l16 = lane & 15, lq = lane >> 4;
  const int crow = tid >> 3, cch = tid & 7;
  int gtok0 = 0;
  const int nk = K >> 6;
  const int swz = (cch ^ (crow & 7)) * 8;
  const unsigned boff = ((unsigned)(n0 + crow) * (unsigned)K + (unsigned)cch * 8u) * 2u;
  const unsigned bstrb = 64u * (unsigned)K;
  unsigned aoff = 0u; const unsigned astrb = 64u * (unsigned)lda;
  if constexpr (AMODE == 0) aoff = ((unsigned)(m0 + crow) * (unsigned)lda + (unsigned)cch * 8u) * 2u;
  if constexpr (AMODE == 3) { const int r_ = m0 + crow; const int bg_ = r_ >> 9; gtok0 = (r_ & 511) * 16;
    aoff = ((unsigned)(bg_ >> 1) * (unsigned)T_ * 128u + (unsigned)(bg_ & 1) * 64u + (unsigned)cch * 8u) * 2u; }
  const unsigned gch = (unsigned)(cch ^ (crow & 7)) * 16u;
  const unsigned boffd = ((unsigned)(n0 + crow) * (unsigned)K) * 2u + gch;
  unsigned aoffd = 0u;
  if constexpr (AMODE == 0) aoffd = ((unsigned)(m0 + crow) * (unsigned)lda) * 2u + gch;
  if constexpr (AMODE == 3) { const int r_ = m0 + crow; const int bg_ = r_ >> 9;
    aoffd = ((unsigned)(bg_ >> 1) * (unsigned)T_ * 128u + (unsigned)(bg_ & 1) * 64u) * 2u + gch; }
  const int wbase = __builtin_amdgcn_readfirstlane(wave) * 1024;
#define GP(base_, off_) ((const unsigned*)((const char*)(base_) + (unsigned)(off_)))
#define LP(BUF, off_) ((unsigned*)(smem + (BUF) * LDS_BUF + wbase + (off_)))
#define D_LOAD(BUF, ks) { const unsigned qb_ = boffd + (unsigned)(ks) * 128u; \
    __builtin_amdgcn_global_load_lds(GP(Bt, qb_), LP(BUF, 16384), 16, 0, 0); \
    __builtin_amdgcn_global_load_lds(GP(Bt, qb_ + bstrb), LP(BUF, 16384 + 4096), 16, 0, 0); \
    __builtin_amdgcn_global_load_lds(GP(Bt, qb_ + 2u * bstrb), LP(BUF, 16384 + 8192), 16, 0, 0); \
    __builtin_amdgcn_global_load_lds(GP(Bt, qb_ + 3u * bstrb), LP(BUF, 16384 + 12288), 16, 0, 0); \
    if constexpr (AMODE == 0) { const unsigned qa_ = aoffd + (unsigned)(ks) * 128u; \
      __builtin_amdgcn_global_load_lds(GP(A, qa_), LP(BUF, 0), 16, 0, 0); \
      __builtin_amdgcn_global_load_lds(GP(A, qa_ + astrb), LP(BUF, 4096), 16, 0, 0); \
      __builtin_amdgcn_global_load_lds(GP(A, qa_ + 2u * astrb), LP(BUF, 8192), 16, 0, 0); \
      __builtin_amdgcn_global_load_lds(GP(A, qa_ + 3u * astrb), LP(BUF, 12288), 16, 0, 0); } \
    else { \
      __builtin_amdgcn_global_load_lds(GP(A, aoffd + (unsigned)min(gtok0 + (ks), T_ - 1) * 256u), LP(BUF, 0), 16, 0, 0); \
      __builtin_amdgcn_global_load_lds(GP(A, aoffd + (unsigned)min(gtok0 + 512 + (ks), T_ - 1) * 256u), LP(BUF, 4096), 16, 0, 0); \
      __builtin_amdgcn_global_load_lds(GP(A, aoffd + (unsigned)min(gtok0 + 1024 + (ks), T_ - 1) * 256u), LP(BUF, 8192), 16, 0, 0); \
      __builtin_amdgcn_global_load_lds(GP(A, aoffd + (unsigned)min(gtok0 + 1536 + (ks), T_ - 1) * 256u), LP(BUF, 12288), 16, 0, 0); } }
#define D_SYNC() { asm volatile("s_waitcnt vmcnt(0)" ::: "memory"); asm volatile("s_waitcnt lgkmcnt(0)" ::: "memory"); __builtin_amdgcn_s_barrier(); asm volatile("" ::: "memory"); }
#define G_ROW(mi, fa_) \
      if (ns) { acc[mi][0] = MFMA16(fa_, fb0, acc[mi][0]); acc[mi][1] = MFMA16(fa_, fb1, acc[mi][1]); acc[mi][2] = MFMA16(fa_, fb2, acc[mi][2]); acc[mi][3] = MFMA16(fa_, fb3, acc[mi][3]); } \
      else    { acc[mi][0] = MFMA16(fb0, fa_, acc[mi][0]); acc[mi][1] = MFMA16(fb1, fa_, acc[mi][1]); acc[mi][2] = MFMA16(fb2, fa_, acc[mi][2]); acc[mi][3] = MFMA16(fb3, fa_, acc[mi][3]); }
#define G_HALF(BUF, kk) { \
      const int co = (((kk) * 4 + lq) ^ (l16 & 7)) * 8; \
      const u16* pa = (const u16*)(smem + (BUF) * LDS_BUF) + (wm * 64 + l16) * 64 + co; \
      const u16* pb = (const u16*)(smem + (BUF) * LDS_BUF) + 8192 + (wn * 64 + l16) * 64 + co; \
      const bf16x8 fa0 = *(const bf16x8*)pa, fa1 = *(const bf16x8*)(pa + 16 * 64), fa2 = *(const bf16x8*)(pa + 32 * 64), fa3 = *(const bf16x8*)(pa + 48 * 64); \
      const bf16x8 fb0 = *(const bf16x8*)pb, fb1 = *(const bf16x8*)(pb + 16 * 64), fb2 = *(const bf16x8*)(pb + 32 * 64), fb3 = *(const bf16x8*)(pb + 48 * 64); \
      G_ROW(0, fa0) G_ROW(1, fa1) G_ROW(2, fa2) G_ROW(3, fa3) }
#define R_STEP(CUR, ks) { \
    if ((ks) + 1 < nk && FAKE != 1) D_LOAD((CUR) ^ 1, (ks) + 1) \
    __builtin_amdgcn_sched_barrier(0); \
    if (FAKE != 2) { G_HALF(CUR, 0) G_HALF(CUR, 1) } \
    D_SYNC() }
  __syncthreads();
  D_LOAD(0, 0)
  D_SYNC()
  for (int ks = 0; ks < nk; ks += 2) {
    R_STEP(0, ks)
    if (ks + 1 < nk) R_STEP(1, ks + 1)
  }
#undef GP
#undef LP
#undef D_LOAD
#undef D_SYNC
#undef G_ROW
#undef G_HALF
#undef R_STEP
}

constexpr int LDS_BIG = 24576;
template <int FAKE = 0>
DI void gemm_mainloop_big(f32x4 (&acc)[8][4], unsigned char* smem, const void* A, long lda, int m0, int K,
                          const u16* Bt, int n0, bool ns, int tid) {
  const int lane = tid & 63, wave = tid >> 6, wm = wave >> 1, wn = wave & 1;
  const int l16 = lane & 15, lq = lane >> 4;
  const int nk = K >> 5;
  const int prow = lane >> 2, ppos = lane & 3;
  const unsigned gch = (unsigned)(ppos ^ ((4 - ((lane >> 4) & 3)) & 3)) * 16u;
  const unsigned aoffd = ((unsigned)(m0 + 16 * wave + prow) * (unsigned)lda) * 2u + gch;
  const unsigned boffd = ((unsigned)(n0 + 16 * wave + prow) * (unsigned)K) * 2u + gch;
  const unsigned astrb = 128u * (unsigned)lda, bstrb = 128u * (unsigned)K;
  const int wbase = __builtin_amdgcn_readfirstlane(wave) * 1024;
#define GP(base_, off_) ((const unsigned*)((const char*)(base_) + (unsigned)(off_)))
#define LP(BUF, off_) ((unsigned*)(smem + (BUF) * LDS_BIG + wbase + (off_)))
#define D_LOAD(BUF, ks) { const unsigned ko_ = (unsigned)(ks) * 64u; \
    __builtin_amdgcn_global_load_lds(GP(A, aoffd + ko_), LP(BUF, 0), 16, 0, 0); \
    __builtin_amdgcn_global_load_lds(GP(A, aoffd + ko_ + astrb), LP(BUF, 4096), 16, 0, 0); \
    __builtin_amdgcn_global_load_lds(GP(A, aoffd + ko_ + 2u * astrb), LP(BUF, 8192), 16, 0, 0); \
    __builtin_amdgcn_global_load_lds(GP(A, aoffd + ko_ + 3u * astrb), LP(BUF, 12288), 16, 0, 0); \
    __builtin_amdgcn_global_load_lds(GP(Bt, boffd + ko_), LP(BUF, 16384), 16, 0, 0); \
    __builtin_amdgcn_global_load_lds(GP(Bt, boffd + ko_ + bstrb), LP(BUF, 16384 + 4096), 16, 0, 0); }
#define D_SYNC() { asm volatile("s_waitcnt vmcnt(0)" ::: "memory"); asm volatile("s_waitcnt lgkmcnt(0)" ::: "memory"); __builtin_amdgcn_s_barrier(); asm volatile("" ::: "memory"); }
  const int pp = (lq ^ ((4 - ((l16 >> 2) & 3)) & 3)) * 8;
#define B_ROW(mi) { const bf16x8 fa_ = *(const bf16x8*)(pa + (mi) * 16 * 32); \
      if (ns) { acc[mi][0] = MFMA16(fa_, fb0, acc[mi][0]); acc[mi][1] = MFMA16(fa_, fb1, acc[mi][1]); acc[mi][2] = MFMA16(fa_, fb2, acc[mi][2]); acc[mi][3] = MFMA16(fa_, fb3, acc[mi][3]); } \
      else    { acc[mi][0] = MFMA16(fb0, fa_, acc[mi][0]); acc[mi][1] = MFMA16(fb1, fa_, acc[mi][1]); acc[mi][2] = MFMA16(fb2, fa_, acc[mi][2]); acc[mi][3] = MFMA16(fb3, fa_, acc[mi][3]); } }
#define B_COMPUTE(BUF) { \
      const u16* pa = (const u16*)(smem + (BUF) * LDS_BIG) + (wm * 128 + l16) * 32 + pp; \
      const u16* pb = (const u16*)(smem + (BUF) * LDS_BIG + 16384) + (wn * 64 + l16) * 32 + pp; \
      const bf16x8 fb0 = *(const bf16x8*)pb, fb1 = *(const bf16x8*)(pb + 16 * 32), fb2 = *(const bf16x8*)(pb + 32 * 32), fb3 = *(const bf16x8*)(pb + 48 * 32); \
      B_ROW(0) B_ROW(1) B_ROW(2) B_ROW(3) B_ROW(4) B_ROW(5) B_ROW(6) B_ROW(7) }
#define B_STEP(CUR, ks) { \
    if ((ks) + 1 < nk && FAKE != 1) D_LOAD((CUR) ^ 1, (ks) + 1) \
    __builtin_amdgcn_sched_barrier(0); \
    if (FAKE != 2) B_COMPUTE(CUR) \
    D_SYNC() }
  __syncthreads();
  D_LOAD(0, 0)
  D_SYNC()
  for (int ks = 0; ks < nk; ks += 2) {
    B_STEP(0, ks)
    if (ks + 1 < nk) B_STEP(1, ks + 1)
  }
#undef GP
#undef LP
#undef D_LOAD
#undef D_SYNC
#undef B_ROW
#undef B_COMPUTE
#undef B_STEP
}

template <int MI>
DI void zero_acc(f32x4 (&acc)[MI][4]) {
#pragma unroll
  for (int i = 0; i < MI; ++i)
#pragma unroll
    for (int j = 0; j < 4; ++j) acc[i][j] = f32x4{0.f, 0.f, 0.f, 0.f};
}

DI void stat_push(float* stats, int tok, float s1, float s2, int lq) {
  s1 += __shfl_xor(s1, 16); s2 += __shfl_xor(s2, 16);
  s1 += __shfl_xor(s1, 32); s2 += __shfl_xor(s2, 32);
  if (lq == 0) { atomicAdd(stats + 2 * (long)tok, s1); atomicAdd(stats + 2 * (long)tok + 1, s2); }
}

enum { PH_IN = 1, PH_UQ, PH_UKV, PH_C1, PH_C2, PH_OUT, PH_UP, PH_DOWN, PH_PLE };

template <int PH, int FAKE = 0>
DI void gemm_tile(const Params& P, unsigned char* smem, int mt, int nt, int which, int tid_in) {
  int tid = tid_in;
  asm volatile("" : "+v"(tid));
  unsigned char* ws = P.ws;
  const int lane = tid & 63, wave = tid >> 6, wm = wave >> 1, wn = wave & 1;
  const int l16 = lane & 15, lq = lane >> 4;
  constexpr int MI = (PH == PH_OUT || PH == PH_UP || PH == PH_DOWN || PH == PH_PLE) ? 8 : 4;
  constexpr int WR = MI * 16;
  const int m0 = mt * (2 * WR), n0 = nt * 128;
  f32x4 acc[MI][4];
  zero_acc<MI>(acc);
  float* rsq = (float*)(smem + LDS_RS_OFF);

  if constexpr (PH == PH_IN) {
    const bool ns = (nt == 7 || nt == 9);
    gemm_mainloop<0>(acc, smem, (const u16*)(ws + O_CONCAT), 1024, m0, 1024, (const u16*)(ws + O_WT_IN), n0, nullptr, ns, tid);
    const float QSC = 0.125f * LOG2E_;
#pragma unroll
    for (int mi = 0; mi < MI; ++mi) {
      if (!ns) {
        const int tok = m0 + wm * WR + mi * 16 + l16;
        if (nt < 4) {
#pragma unroll
          for (int nj = 0; nj < 4; ++nj) {
            int col = n0 + wn * 64 + nj * 16 + lq * 4;
            f32x4 a = acc[mi][nj];
            store4bf((u16*)(ws + O_QN) + (long)tok * 512 + col, a[0] * QSC, a[1] * QSC, a[2] * QSC, a[3] * QSC);
          }
        } else if (nt == 4 || nt == 5 || nt == 6 || nt == 8 || nt == 12) {
          u16* dst = (u16*)(ws + (nt == 4 ? O_KC : nt == 5 ? O_VC : nt == 6 ? O_KS : nt == 8 ? O_KW : O_CKV));
          float ss = 0.f;
#pragma unroll
          for (int nj = 0; nj < 4; ++nj) {
            int col = wn * 64 + nj * 16 + lq * 4;
            f32x4 a = acc[mi][nj];
            ss += a[0] * a[0] + a[1] * a[1] + a[2] * a[2] + a[3] * a[3];
            store4bf(dst + (long)tok * 128 + col, a[0], a[1], a[2], a[3]);
          }
          if (nt == 12) {
            ss += __shfl_xor(ss, 16); ss += __shfl_xor(ss, 32);
            if (lq == 0) atomicAdd((float*)(ws + O_SSQ) + M_ + tok, ss);
          }
        } else if (nt == 10 || nt == 11) {
          float ss = 0.f;
#pragma unroll
          for (int nj = 0; nj < 4; ++nj) {
            int col = (nt - 10) * 128 + wn * 64 + nj * 16 + lq * 4;
            f32x4 a = acc[mi][nj];
            ss += a[0] * a[0] + a[1] * a[1] + a[2] * a[2] + a[3] * a[3];
            store4bf((u16*)(ws + O_CQ) + (long)tok * 256 + col, a[0], a[1], a[2], a[3]);
          }
          ss += __shfl_xor(ss, 16); ss += __shfl_xor(ss, 32);
          if (lq == 0) atomicAdd((float*)(ws + O_SSQ) + tok, ss);
        } else {
          if (wn == 0) {
            const int pos = tok & (T_ - 1);
            const float4 cs = *(const float4*)((const float*)(ws + O_ROPE_C) + pos * 16 + lq * 4);
            const float4 sn = *(const float4*)((const float*)(ws + O_ROPE_S) + pos * 16 + lq * 4);
            f32x4 x1 = acc[mi][0], x2 = acc[mi][1];
            u16* kp = (u16*)(ws + O_KPE) + (long)tok * 32;
            store4bf(kp + lq * 4, x1[0] * cs.x - x2[0] * sn.x, x1[1] * cs.y - x2[1] * sn.y, x1[2] * cs.z - x2[2] * sn.z, x1[3] * cs.w - x2[3] * sn.w);
            store4bf(kp + 16 + lq * 4, x2[0] * cs.x + x1[0] * sn.x, x2[1] * cs.y + x1[1] * sn.y, x2[2] * cs.z + x1[2] * sn.z, x2[3] * cs.w + x1[3] * sn.w);
            float* gp = (float*)(ws + O_GATES) + (long)tok * 24;
            f32x4 g0 = acc[mi][2], g1 = acc[mi][3];
            *(float4*)(gp + lq * 4) = make_float4(sigmoid_(g0[0]), sigmoid_(g0[1]), sigmoid_(g0[2]), sigmoid_(g0[3]));
            if (lq < 2) *(float4*)(gp + 16 + lq * 4) = make_float4(sigmoid_(g1[0]), sigmoid_(g1[1]), sigmoid_(g1[2]), sigmoid_(g1[3]));
          }
        }
      } else {
        const int tok4 = m0 + wm * WR + mi * 16 + lq * 4;
        const int b = tok4 >> 13, t = tok4 & (T_ - 1);
        u16* dstb = (u16*)(ws + (nt == 7 ? O_VST : O_VWT));
#pragma unroll
        for (int nj = 0; nj < 4; ++nj) {
          int c = wn * 64 + nj * 16 + l16, g = c >> 6, d = c & 63;
          f32x4 a = acc[mi][nj];
          store4bf(dstb + ((long)((b * 2 + g) * 64 + d)) * T_ + t, a[0], a[1], a[2], a[3]);
        }
      }
    }
  }

  if constexpr (PH == PH_UQ || PH == PH_UKV) {
    constexpr int K = (PH == PH_UQ) ? 256 : 128;
    const u16* A = (const u16*)(ws + (PH == PH_UQ ? O_CQ : O_CKV));
    __syncthreads();
    if (tid < 128) {
      const float ss = ((const float*)(ws + O_SSQ))[(PH == PH_UQ ? 0 : M_) + m0 + tid];
      rsq[tid] = rsqrtf(ss * (1.f / K) + 1e-6f);
    }
    if constexpr (PH == PH_UQ) {
      gemm_mainloop<0>(acc, smem, A, 256, m0, 256, (const u16*)(ws + O_WT_UQ), n0, nullptr, false, tid);
      const float SC = 0.10206207261596577f * LOG2E_;
#pragma unroll
      for (int mi = 0; mi < MI; ++mi) {
        const int tok = m0 + wm * WR + mi * 16 + l16;
        const float rs = rsq[wm * WR + mi * 16 + l16] * SC;
        const int pos = tok & (T_ - 1);
        const int ct0 = nt * 8 + wn * 4;
#pragma unroll
        for (int njp = 0; njp < 4; njp += 2) {
          f32x4 a = acc[mi][njp], b2 = acc[mi][njp + 1];
          if (((ct0 + njp) % 6) == 4) {
            const float4 cs = *(const float4*)((const float*)(ws + O_ROPE_C) + pos * 16 + lq * 4);
            const float4 sn = *(const float4*)((const float*)(ws + O_ROPE_S) + pos * 16 + lq * 4);
            f32x4 o1, o2;
            o1[0] = a[0] * cs.x - b2[0] * sn.x; o2[0] = b2[0] * cs.x + a[0] * sn.x;
            o1[1] = a[1] * cs.y - b2[1] * sn.y; o2[1] = b2[1] * cs.y + a[1] * sn.y;
            o1[2] = a[2] * cs.z - b2[2] * sn.z; o2[2] = b2[2] * cs.z + a[2] * sn.z;
            o1[3] = a[3] * cs.w - b2[3] * sn.w; o2[3] = b2[3] * cs.w + a[3] * sn.w;
            a = o1; b2 = o2;
          }
          u16* dst = (u16*)(ws + O_QM) + (long)tok * 768 + n0 + wn * 64 + njp * 16 + lq * 4;
          store4bf(dst, a[0] * rs, a[1] * rs, a[2] * rs, a[3] * rs);
          store4bf(dst + 16, b2[0] * rs, b2[1] * rs, b2[2] * rs, b2[3] * rs);
        }
      }
    } else {
      const bool ns = (wn == 1);
      gemm_mainloop<0>(acc, smem, A, 128, m0, 128, (const u16*)(ws + O_WT_UKV), n0, nullptr, ns, tid);
#pragma unroll
      for (int mi = 0; mi < MI; ++mi) {
        if (!ns) {
          const int tok = m0 + wm * WR + mi * 16 + l16;
          const float rs = rsq[wm * WR + mi * 16 + l16];
#pragma unroll
          for (int nj = 0; nj < 4; ++nj) {
            f32x4 a = acc[mi][nj];
            store4bf((u16*)(ws + O_KN) + (long)tok * 512 + nt * 64 + nj * 16 + lq * 4, a[0] * rs, a[1] * rs, a[2] * rs, a[3] * rs);
          }
        } else {
          const int lr = wm * WR + mi * 16 + lq * 4;
          const int tok4 = m0 + lr;
          const int b = tok4 >> 13, t = tok4 & (T_ - 1);
          const float r0 = rsq[lr], r1 = rsq[lr + 1], r2 = rsq[lr + 2], r3 = rsq[lr + 3];
#pragma unroll
          for (int nj = 0; nj < 4; ++nj) {
            int d = nj * 16 + l16;
            f32x4 a = acc[mi][nj];
            store4bf((u16*)(ws + O_VMT) + ((long)((b * 8 + nt) * 64 + d)) * T_ + t, a[0] * r0, a[1] * r1, a[2] * r2, a[3] * r3);
          }
        }
      }
    }
  }

  if constexpr (PH == PH_C1) {
    const u16* A = (const u16*)(ws + (which ? O_VC : O_KC));
    const u16* Bt = (const u16*)(ws + (which ? O_WT_CV1 : O_WT_CK1));
    const float* bias = (const float*)(ws + (which ? O_BIAS1V : O_BIAS1K));
    gemm_mainloop<3>(acc, smem, A, 128, m0, 2048, Bt, n0, nullptr, false, tid);
    u16* hid = (u16*)(ws + O_HID) + (long)which * 8192 * 256;
#pragma unroll
    for (int mi = 0; mi < MI; ++mi) {
      const int row = m0 + wm * WR + mi * 16 + l16;
#pragma unroll
      for (int nj = 0; nj < 4; ++nj) {
        int col = n0 + wn * 64 + nj * 16 + lq * 4;
        const float4 bb = *(const float4*)(bias + col);
        f32x4 a = acc[mi][nj];
        store4bf(hid + (long)row * 256 + col, gelu_tanh_(a[0] + bb.x), gelu_tanh_(a[1] + bb.y), gelu_tanh_(a[2] + bb.z), gelu_tanh_(a[3] + bb.w));
      }
    }
  }

  if constexpr (PH == PH_C2) {
    const u16* A = (const u16*)(ws + O_HID) + (long)which * 8192 * 256;
    const u16* Bt = (const u16*)(ws + (which ? O_WT_CV2 : O_WT_CK2));
    const bool ns = (which == 1);
    gemm_mainloop<0>(acc, smem, A, 256, m0, 256, Bt, 0, nullptr, ns, tid);
    if (wn == 0) {
#pragma unroll
      for (int mi = 0; mi < MI; ++mi) {
        if (!ns) {
          const int row = m0 + wm * WR + mi * 16 + l16;
#pragma unroll
          for (int nj = 0; nj < 4; ++nj) {
            f32x4 a = acc[mi][nj];
            store4bf((u16*)(ws + O_CMPK) + (long)row * 64 + nj * 16 + lq * 4, a[0], a[1], a[2], a[3]);
          }
        } else {
          const int r4 = m0 + wm * WR + mi * 16 + lq * 4;
          const int bg = r4 >> 9, c = r4 & 511;
#pragma unroll
          for (int nj = 0; nj < 4; ++nj) {
            int d = nj * 16 + l16;
            f32x4 a = acc[mi][nj];
            store4bf((u16*)(ws + O_CMPVT) + ((long)(bg * 64 + d)) * 512 + c, a[0], a[1], a[2], a[3]);
          }
        }
      }
    }
  }

  if constexpr (PH == PH_OUT) {
    gemm_mainloop_big<0>(acc, smem, (const u16*)(ws + O_CONCAT), 1024, m0, 1024, (const u16*)(ws + O_WT_OUT), n0, false, tid);
    float* stats = (float*)(ws + O_STATS);
    unsigned char* swv = smem + wave * 18432;
#pragma unroll
    for (int mi = 0; mi < MI; ++mi) {
      const int tok = m0 + wm * WR + mi * 16 + l16;
      float s1 = 0.f, s2 = 0.f;
#pragma unroll
      for (int nj = 0; nj < 4; ++nj) {
        int col = n0 + wn * 64 + nj * 16 + lq * 4;
        const float4 xv = *(const float4*)(P.x + (long)tok * 1024 + col);
        f32x4 a = acc[mi][nj];
        float4 y = make_float4(ALPHA_ * xv.x + a[0], ALPHA_ * xv.y + a[1], ALPHA_ * xv.z + a[2], ALPHA_ * xv.w + a[3]);
        *(uint2*)(swv + (mi * 16 + l16) * 144 + nj * 32 + lq * 8) = make_uint2(pack2(y.x, y.y), pack2(y.z, y.w));
        s1 += y.x + y.y + y.z + y.w;
        s2 += y.x * y.x + y.y * y.y + y.z * y.z + y.w * y.w;
      }
      stat_push(stats, tok, s1, s2, lq);
    }
    asm volatile("s_waitcnt lgkmcnt(0)" ::: "memory");
    {
      u16* yb = (u16*)(ws + O_YB) + (long)(m0 + wm * WR) * 1024 + n0 + wn * 64;
#pragma unroll
      for (int r = 0; r < 16; ++r) {
        const int row = r * 8 + (lane >> 3), ch = lane & 7;
        const uint4 v = *(const uint4*)(swv + row * 144 + ch * 16);
        *(uint4*)(yb + (long)row * 1024 + ch * 8) = v;
      }
    }
  }

  if constexpr (PH == PH_UP) {
    gemm_mainloop_big<FAKE>(acc, smem, (const u16*)(ws + O_YB), 1024, m0, 1024, (const u16*)(ws + O_WT_UP), n0, false, tid);
    if (FAKE != 0 && acc[0][0][0] + acc[3][3][3] + acc[1][2][1] != 123456.75f) return;
    const float* bias = (const float*)(ws + O_BIAS_UP);
    const float* csum = (const float*)(ws + O_CSUM_UP);
    const float* st1 = (const float*)(ws + O_STATS);
    const int cb0 = n0 + wn * 64 + lq * 4;
    const float4 bgv[2] = {*(const float4*)(bias + cb0), *(const float4*)(bias + cb0 + 16)};
    const float4 buv[2] = {*(const float4*)(bias + cb0 + 32), *(const float4*)(bias + cb0 + 48)};
    const float4 cgv[2] = {*(const float4*)(csum + cb0), *(const float4*)(csum + cb0 + 16)};
    const float4 cuv[2] = {*(const float4*)(csum + cb0 + 32), *(const float4*)(csum + cb0 + 48)};
#pragma unroll
    for (int mi = 0; mi < MI; ++mi) {
      const int tok = m0 + wm * WR + mi * 16 + l16;
      const float mean = st1[2 * tok] * (1.f / 1024.f);
      const float rstd = rsqrtf(st1[2 * tok + 1] * (1.f / 1024.f) - mean * mean + 1e-5f);
      unsigned hw[4];
#pragma unroll
      for (int nj = 0; nj < 2; ++nj) {
        const float4 bg = bgv[nj], bu = buv[nj], cg = cgv[nj], cu = cuv[nj];
        f32x4 g = acc[mi][nj], u = acc[mi][nj + 2];
        float h0, h1, h2, h3, v;
        v = rstd * (g[0] - mean * cg.x) + bg.x; h0 = v * sigmoid_(v) * (rstd * (u[0] - mean * cu.x) + bu.x);
        v = rstd * (g[1] - mean * cg.y) + bg.y; h1 = v * sigmoid_(v) * (rstd * (u[1] - mean * cu.y) + bu.y);
        v = rstd * (g[2] - mean * cg.z) + bg.z; h2 = v * sigmoid_(v) * (rstd * (u[2] - mean * cu.z) + bu.z);
        v = rstd * (g[3] - mean * cg.w) + bg.w; h3 = v * sigmoid_(v) * (rstd * (u[3] - mean * cu.w) + bu.w);
        hw[2 * nj] = pack2(h0, h1); hw[2 * nj + 1] = pack2(h2, h3);
      }
      *(uint4*)((u16*)(ws + O_HBUF) + (long)tok * 2816 + nt * 64 + wn * 32 + lq * 8) = make_uint4(hw[0], hw[1], hw[2], hw[3]);
    }
  }

  if constexpr (PH == PH_DOWN) {
    gemm_mainloop_big<0>(acc, smem, (const u16*)(ws + O_HBUF), 2816, m0, 2816, (const u16*)(ws + O_WT_DOWN), n0, false, tid);
    const float* st1 = (const float*)(ws + O_STATS);
    float* st2 = (float*)(ws + O_STATS) + (long)M_ * 2;
    u16* yb = (u16*)(ws + O_YB);
#pragma unroll
    for (int mi = 0; mi < MI; ++mi) {
      const int tok = m0 + wm * WR + mi * 16 + l16;
      const float mean = st1[2 * tok] * (1.f / 1024.f);
      const float rstd = rsqrtf(st1[2 * tok + 1] * (1.f / 1024.f) - mean * mean + 1e-5f);
      float s1 = 0.f, s2 = 0.f;
#pragma unroll
      for (int nj = 0; nj < 4; ++nj) {
        int col = n0 + wn * 64 + nj * 16 + lq * 4;
        const uint2 yq = *(const uint2*)(yb + (long)tok * 1024 + col);
        const float4 yv = make_float4(bflo(yq.x), bfhi(yq.x), bflo(yq.y), bfhi(yq.y));
        const float4 gg = *(const float4*)(P.ln1_g + col);
        const float4 bb = *(const float4*)(P.ln1_b + col);
        f32x4 a = acc[mi][nj];
        float4 y;
        y.x = ALPHA_ * ((yv.x - mean) * rstd * gg.x + bb.x) + a[0];
        y.y = ALPHA_ * ((yv.y - mean) * rstd * gg.y + bb.y) + a[1];
        y.z = ALPHA_ * ((yv.z - mean) * rstd * gg.z + bb.z) + a[2];
        y.w = ALPHA_ * ((yv.w - mean) * rstd * gg.w + bb.w) + a[3];
        store4bf(yb + (long)tok * 1024 + col, y.x, y.y, y.z, y.w);
        s1 += y.x + y.y + y.z + y.w;
        s2 += y.x * y.x + y.y * y.y + y.z * y.z + y.w * y.w;
      }
      stat_push(st2, tok, s1, s2, lq);
    }
  }

  if constexpr (PH == PH_PLE) {
    const float* st2 = (const float*)(ws + O_STATS) + (long)M_ * 2;
    float* st3 = (float*)(ws + O_STATS) + (long)M_ * 4;
    u16* yb = (u16*)(ws + O_YB);
    gemm_mainloop_big<0>(acc, smem, (const u16*)(ws + O_YB), 1024, m0, 1024, (const u16*)(ws + O_WT_GATE), n0, false, tid);
    const float* bias = (const float*)(ws + O_BIAS_G);
    uint4* gsp4 = (uint4*)(ws + O_HBUF) + (long)(mt * 8 + nt) * 16 * 256;
    const int cg0 = n0 + wn * 64 + lq * 4;
    const float4 gbv[4] = {*(const float4*)(bias + cg0), *(const float4*)(bias + cg0 + 16), *(const float4*)(bias + cg0 + 32), *(const float4*)(bias + cg0 + 48)};
    const float* csg = (const float*)(ws + O_CSUM_G);
    const float4 gcv[4] = {*(const float4*)(csg + cg0), *(const float4*)(csg + cg0 + 16), *(const float4*)(csg + cg0 + 32), *(const float4*)(csg + cg0 + 48)};
#pragma unroll
    for (int mi = 0; mi < MI; ++mi) {
      const int tok = m0 + wm * WR + mi * 16 + l16;
      const float mean_g = st2[2 * tok] * (1.f / 1024.f);
      const float rstd_g = rsqrtf(st2[2 * tok + 1] * (1.f / 1024.f) - mean_g * mean_g + 1e-5f);
      unsigned gw[8];
#pragma unroll
      for (int nj = 0; nj < 4; ++nj) {
        const float4 bb = gbv[nj], cs = gcv[nj];
        f32x4 a = acc[mi][nj];
        gw[2 * nj] = pack2(sigmoid_(rstd_g * (a[0] - mean_g * cs.x) + bb.x), sigmoid_(rstd_g * (a[1] - mean_g * cs.y) + bb.y));
        gw[2 * nj + 1] = pack2(sigmoid_(rstd_g * (a[2] - mean_g * cs.z) + bb.z), sigmoid_(rstd_g * (a[3] - mean_g * cs.w) + bb.w));
      }
      gsp4[(mi * 2 + 0) * 256 + tid] = make_uint4(gw[0], gw[1], gw[2], gw[3]);
      gsp4[(mi * 2 + 1) * 256 + tid] = make_uint4(gw[4], gw[5], gw[6], gw[7]);
    }
    zero_acc<MI>(acc);
    gemm_mainloop_big<0>(acc, smem, (const u16*)(ws + O_PB), 256, m0, 256, (const u16*)(ws + O_WT_PLE), n0, false, tid);
#pragma unroll
    for (int mi = 0; mi < MI; ++mi) {
      const int tok = m0 + wm * WR + mi * 16 + l16;
      const float mean = st2[2 * tok] * (1.f / 1024.f);
      const float rstd = rsqrtf(st2[2 * tok + 1] * (1.f / 1024.f) - mean * mean + 1e-5f);
      float s1 = 0.f, s2 = 0.f;
      const uint4 gqa = gsp4[(mi * 2 + 0) * 256 + tid], gqb = gsp4[(mi * 2 + 1) * 256 + tid];
#pragma unroll
      for (int nj = 0; nj < 4; ++nj) {
        int col = n0 + wn * 64 + nj * 16 + lq * 4;
        const uint2 yq = *(const uint2*)(yb + (long)tok * 1024 + col);
        const float4 yv = make_float4(bflo(yq.x), bfhi(yq.x), bflo(yq.y), bfhi(yq.y));
        const float4 gg = *(const float4*)(P.ln2_g + col);
        const float4 bb = *(const float4*)(P.ln2_b + col);
        f32x4 a = acc[mi][nj];
        const unsigned g01 = (nj == 0) ? gqa.x : (nj == 1) ? gqa.z : (nj == 2) ? gqb.x : gqb.z;
        const unsigned g23 = (nj == 0) ? gqa.y : (nj == 1) ? gqa.w : (nj == 2) ? gqb.y : gqb.w;
        float4 y;
        y.x = ALPHA_ * ((yv.x - mean) * rstd * gg.x + bb.x) + bflo(g01) * a[0];
        y.y = ALPHA_ * ((yv.y - mean) * rstd * gg.y + bb.y) + bfhi(g01) * a[1];
        y.z = ALPHA_ * ((yv.z - mean) * rstd * gg.z + bb.z) + bflo(g23) * a[2];
        y.w = ALPHA_ * ((yv.w - mean) * rstd * gg.w + bb.w) + bfhi(g23) * a[3];
        store4bf((u16*)(ws + O_CONCAT) + (long)tok * 1024 + col, y.x, y.y, y.z, y.w);
        s1 += y.x + y.y + y.z + y.w;
        s2 += y.x * y.x + y.y * y.y + y.z * y.z + y.w * y.w;
      }
      stat_push(st3, tok, s1, s2, lq);
    }
  }
}

constexpr int LDS_TOTAL = 4 * 18432 + 512;
constexpr int CTL_OFF = 53248;
constexpr int SEL_OFF = CTL_OFF + 1024;
constexpr int IMP_OFF = 35840;
static_assert(IMP_OFF + 32 * 130 * 4 <= CTL_OFF, "lds");
static_assert(SEL_OFF + 512 <= LDS_TOTAL, "lds");

struct AttnSrc { const u16* K; long ldk; const u16* K2; const u16* V; long ldv; };
enum { AM_MLA = 0, AM_WIN = 1, AM_SLC = 2, AM_CMP = 3 };

template <int MODE, int DQ, bool DO_PV, bool FIXED_M, bool DO_IMP, bool USE_LIST, int FK = 0>
DI void attn_loop(unsigned char* smem, const AttnSrc src, int ntiles, int tile_lo, const int* tlist,
                  const bf16x8 (&qf)[DQ / 16], float& m, float& l, f32x16 (&O)[2], int t, float slope2,
                  unsigned sw0, unsigned sw1, unsigned sw2, unsigned sw3, float inv_l, unsigned* imp, int tid_in) {
  int tid = tid_in;
  asm volatile("" : "+v"(tid));
  constexpr int KST = DQ + 8;
  constexpr int KCH = DQ / 8;
  constexpr int NKL = KCH * 64 / 256;
  constexpr int KBYTES = 64 * KST * 2;
  constexpr int VST = 68;
  constexpr int VBYTES = 64 * VST * 2;
  const int lane = tid & 63, l32 = lane & 31, h = lane >> 5;
  u16* sK0 = (u16*)smem;
  u16* sV0 = (u16*)(smem + 2 * KBYTES);
  uint4 rk0, rk1, rk2, rv0, rv1;
  const int kr0 = tid / KCH, kc0 = tid % KCH;
  const int kr1 = (tid + 256) / KCH, kc1 = (tid + 256) % KCH;
  const int kr2 = (tid + 512) / KCH, kc2 = (tid + 512) % KCH;
  const int vr0 = tid >> 3, vc0 = tid & 7;
#define A_KLD(dst_, row_, ch_, tile_) { \
    if constexpr (MODE == AM_MLA) { \
      if ((ch_) < 8) dst_ = *(const uint4*)(src.K + ((long)(tile_) * 64 + (row_)) * src.ldk + (ch_) * 8); \
      else dst_ = *(const uint4*)(src.K2 + ((long)(tile_) * 64 + (row_)) * 32 + ((ch_) - 8) * 8); \
    } else dst_ = *(const uint4*)(src.K + ((long)(tile_) * 64 + (row_)) * src.ldk + (ch_) * 8); }
#define A_GLOAD(tile_) { \
    A_KLD(rk0, kr0, kc0, tile_) A_KLD(rk1, kr1, kc1, tile_) \
    if constexpr (NKL == 3) A_KLD(rk2, kr2, kc2, tile_) \
    if constexpr (DO_PV) { \
      rv0 = *(const uint4*)(src.V + (long)vr0 * src.ldv + (long)(tile_) * 64 + vc0 * 8); \
      rv1 = *(const uint4*)(src.V + (long)(vr0 + 32) * src.ldv + (long)(tile_) * 64 + vc0 * 8); } }
#define A_LSTORE(buf_) { \
    u16* sK_ = sK0 + (buf_) * (KBYTES / 2); u16* sV_ = sV0 + (buf_) * (VBYTES / 2); \
    *(uint4*)(sK_ + kr0 * KST + kc0 * 8) = rk0; *(uint4*)(sK_ + kr1 * KST + kc1 * 8) = rk1; \
    if constexpr (NKL == 3) *(uint4*)(sK_ + kr2 * KST + kc2 * 8) = rk2; \
    if constexpr (DO_PV) { \
      *(uint2*)(sV_ + vr0 * VST + vc0 * 8) = make_uint2(rv0.x, rv0.y); *(uint2*)(sV_ + vr0 * VST + vc0 * 8 + 4) = make_uint2(rv0.z, rv0.w); \
      *(uint2*)(sV_ + (vr0 + 32) * VST + vc0 * 8) = make_uint2(rv1.x, rv1.y); *(uint2*)(sV_ + (vr0 + 32) * VST + vc0 * 8 + 4) = make_uint2(rv1.z, rv1.w); } }
  __syncthreads();
  if (ntiles > 0) { const int tf = USE_LIST ? tlist[0] : tile_lo; A_GLOAD(tf) A_LSTORE(0) }
  __syncthreads();
  for (int it = 0; it < ntiles; ++it) {
    const int tile = USE_LIST ? tlist[it] : tile_lo + it;
    if (it + 1 < ntiles && FK != 1) { const int tn = USE_LIST ? tlist[it + 1] : tile_lo + it + 1; A_GLOAD(tn) }
    __builtin_amdgcn_sched_barrier(0);
    const u16* sK = sK0 + (it & 1) * (KBYTES / 2);
    const u16* sV = sV0 + (it & 1) * (VBYTES / 2);
    f32x16 S[2];
#pragma unroll
    for (int kb = 0; kb < 2; ++kb) {
#pragma unroll
      for (int i = 0; i < 16; ++i) S[kb][i] = 0.f;
#pragma unroll
      for (int s = 0; s < DQ / 16; ++s) {
        bf16x8 kf = *(const bf16x8*)(sK + (kb * 32 + l32) * KST + s * 16 + h * 8);
        S[kb] = MFMA32(kf, qf[s], S[kb]);
      }
    }
    float c0 = 0.f;
    {
      constexpr int MUL = (MODE == AM_CMP) ? 16 : 1;
      int d0;
      if constexpr (MODE == AM_CMP) d0 = t - 31 - 16 * (tile * 64 + 4 * h);
      else d0 = t - tile * 64 - 4 * h;
      bool need = true;
      if constexpr (MODE == AM_MLA) need = (tile * 64 + 63 > t - l32);
      bool selbit = true;
      if constexpr (MODE == AM_SLC) {
        const int w = tile >> 5;
        const unsigned swd = (w == 0) ? sw0 : (w == 1) ? sw1 : (w == 2) ? sw2 : sw3;
        selbit = (swd >> (tile & 31)) & 1u;
      }
      bool full = false;
      if constexpr (MODE != AM_MLA) {
        const int tw = t - l32;
        if constexpr (MODE == AM_CMP) full = ((tile * 64 + 63) * 16 + 31 <= tw);
        if constexpr (MODE == AM_WIN) full = (tile * 64 + 63 <= tw) && (tw + 31 - tile * 64 < 512);
        if constexpr (MODE == AM_SLC) full = (tile * 64 + 63 <= tw) && __all(selbit);
      }
      const float fd0 = (float)d0;
      if constexpr (MODE != AM_MLA) {
#pragma unroll
        for (int kb = 0; kb < 2; ++kb)
#pragma unroll
          for (int i = 0; i < 16; ++i) {
            const float ci = (float)(MUL * ((i & 3) + 8 * (i >> 2) + 32 * kb));
            S[kb][i] = fmaf(slope2, ci, S[kb][i]);
          }
      }
      c0 = (MODE != AM_MLA) ? -slope2 * fd0 : 0.f;
      if (need && !full) {
#pragma unroll
        for (int kb = 0; kb < 2; ++kb)
#pragma unroll
          for (int i = 0; i < 16; ++i) {
            const float ci = (float)(MUL * ((i & 3) + 8 * (i >> 2) + 32 * kb));
            const float dist = fd0 - ci;
            bool valid = dist >= 0.f;
            if constexpr (MODE == AM_WIN) valid = valid && (dist < 512.f);
            if constexpr (MODE == AM_SLC) valid = valid && selbit;
            S[kb][i] = valid ? S[kb][i] : -INFINITY;
          }
      }
    }
    if constexpr (FK != 2) {
    if constexpr (!FIXED_M) {
      float tmax = -INFINITY;
#pragma unroll
      for (int kb = 0; kb < 2; ++kb)
#pragma unroll
        for (int i = 0; i < 16; ++i) tmax = fmaxf(tmax, S[kb][i]);
      tmax += c0;
      tmax = fmaxf(tmax, __shfl_xor(tmax, 32));
      const bool need = tmax > m + 8.f;
      if (__any(need)) {
        const float mnew = need ? tmax : m;
        const float alpha = ex2(m - mnew);
        m = mnew;
        l *= alpha;
        if constexpr (DO_PV) {
#pragma unroll
          for (int db = 0; db < 2; ++db)
#pragma unroll
            for (int i = 0; i < 16; ++i) O[db][i] *= alpha;
        }
      }
    }
    const float mx = m - c0;
    {
      float ps = 0.f;
#pragma unroll
      for (int kb = 0; kb < 2; ++kb)
#pragma unroll
        for (int i = 0; i < 16; ++i) { float p = ex2(S[kb][i] - mx); S[kb][i] = p; ps += p; }
      l += ps;
    }
    }
    if constexpr (DO_IMP) {
#pragma unroll
      for (int kb = 0; kb < 2; ++kb)
#pragma unroll
        for (int a = 0; a < 4; ++a) {
          const float p0 = S[kb][4 * a] * inv_l, p1 = S[kb][4 * a + 1] * inv_l, p2 = S[kb][4 * a + 2] * inv_l, p3 = S[kb][4 * a + 3] * inv_l;
          const float mainv = 2.f * (p0 + p1 + p2) + p3;
          const int n = tile * 16 + kb * 8 + 2 * a + h;
          atomicAdd(imp + l32 * 130 + n, (unsigned)(mainv * 268435456.f));
          atomicAdd(imp + l32 * 130 + n + 1, (unsigned)(p3 * 268435456.f));
        }
    }
    if (it + 1 < ntiles) { A_LSTORE((it + 1) & 1) }
    if constexpr (DO_PV) {
#pragma unroll
      for (int sp = 0; sp < 4; ++sp) {
        const int kb = sp >> 1, hf = sp & 1;
        unsigned w0 = pack2(S[kb][8 * hf + 0], S[kb][8 * hf + 1]);
        unsigned w1 = pack2(S[kb][8 * hf + 2], S[kb][8 * hf + 3]);
        unsigned w2 = pack2(S[kb][8 * hf + 4], S[kb][8 * hf + 5]);
        unsigned w3 = pack2(S[kb][8 * hf + 6], S[kb][8 * hf + 7]);
        uint4 pw = make_uint4(w0, w1, w2, w3);
        bf16x8 pf = __builtin_bit_cast(bf16x8, pw);
#pragma unroll
        for (int db = 0; db < 2; ++db) {
          const u16* vp = sV + (db * 32 + l32) * VST + 16 * sp + 4 * h;
          s16x4 lo = *(const s16x4*)vp;
          s16x4 hi = *(const s16x4*)(vp + 8);
          bf16x8 vf = __builtin_shufflevector(lo, hi, 0, 1, 2, 3, 4, 5, 6, 7);
          O[db] = MFMA32(vf, pf, O[db]);
        }
      }
    }
    __syncthreads();
  }
  l += __shfl_xor(l, 32);
#undef A_KLD
#undef A_GLOAD
#undef A_LSTORE
}

DI void zero_o(f32x16 (&O)[2]) {
#pragma unroll
  for (int db = 0; db < 2; ++db)
#pragma unroll
    for (int i = 0; i < 16; ++i) O[db][i] = 0.f;
}

template <int FK = 0>
DI void mla_item(const Params& P, unsigned char* smem, int b, int hh, int qt, int tid_in) {
  int tid = tid_in;
  asm volatile("" : "+v"(tid));
  unsigned char* ws = P.ws;
  const int lane = tid & 63, w = tid >> 6, l32 = lane & 31, h = lane >> 5;
  const int t = qt * 128 + w * 32 + l32;
  const long tok = (long)b * T_ + t;
  bf16x8 qf[6];
#pragma unroll
  for (int s = 0; s < 6; ++s) qf[s] = *(const bf16x8*)((const u16*)(ws + O_QM) + tok * 768 + hh * 96 + s * 16 + h * 8);
  float m = -1e30f, l = 0.f;
  f32x16 O[2];
  zero_o(O);
  AttnSrc src;
  src.K = (const u16*)(ws + O_KN) + (long)b * T_ * 512 + hh * 64; src.ldk = 512;
  src.K2 = (const u16*)(ws + O_KPE) + (long)b * T_ * 32;
  src.V = (const u16*)(ws + O_VMT) + ((long)(b * 8 + hh) * 64) * T_; src.ldv = T_;
  attn_loop<AM_MLA, 96, true, false, false, false, FK>(smem, src, 2 * qt + 2, 0, nullptr, qf, m, l, O, t, 0.f, 0, 0, 0, 0, 0.f, nullptr, tid);
  if (FK != 0 && O[0][0] + O[1][5] + l != 123456.75f) return;
  const float lt = l;
  const float inv = lt > 0.f ? 1.f / lt : 0.f;
  u16* dst = (u16*)(ws + O_CONCAT) + tok * 1024 + 512 + hh * 64;
#pragma unroll
  for (int db = 0; db < 2; ++db)
#pragma unroll
    for (int a = 0; a < 4; ++a)
      store4bf(dst + db * 32 + 8 * a + 4 * h, O[db][4 * a] * inv, O[db][4 * a + 1] * inv, O[db][4 * a + 2] * inv, O[db][4 * a + 3] * inv);
}

DI u64 mk_key(int n, unsigned v, int cur) {
  if (n > cur) return 0ull;
  if (n == 0 || n == cur || n == cur - 1) v = 0xFFFFFFFFu;
  return ((u64)v << 8) | (u64)(128 - n);
}

DI void nsa_item(const Params& P, unsigned char* smem, int b, int g, int tt, int tid_in) {
  int tid = tid_in;
  asm volatile("" : "+v"(tid));
  unsigned char* ws = P.ws;
  const int lane = tid & 63, w = tid >> 6, l32 = lane & 31, h = lane >> 5;
  const int t0 = tt * 32;
  const int t = t0 + l32;
  const long tok = (long)b * T_ + t;
  const int head8 = g * 4 + w;
  int* ctl = (int*)(smem + CTL_OFF);
  unsigned* sel = (unsigned*)(smem + SEL_OFF);
  unsigned* imp = (unsigned*)(smem + IMP_OFF);
  bf16x8 qf[4];
#pragma unroll
  for (int s = 0; s < 4; ++s) qf[s] = *(const bf16x8*)((const u16*)(ws + O_QN) + tok * 512 + head8 * 64 + s * 16 + h * 8);
  const float* gp = (const float*)(ws + O_GATES) + tok * 24 + head8 * 3;
  const float g0 = gp[0], g1 = gp[1], g2 = gp[2];
  const float slope2 = LOG2E_ * exp2f(-(float)(head8 + 1));
  __syncthreads();
  for (int i = tid; i < 32 * 130; i += 256) imp[i] = 0u;
  if (tid < 4) ctl[4 + tid] = 0;
  f32x16 O[2];
  float m = -1e30f, l = 0.f;
  float* osp = (float*)(ws + O_Y2) + (long)blockIdx.x * 16384 + tid;
  AttnSrc sc;
  sc.K = (const u16*)(ws + O_CMPK) + ((long)(b * 2 + g) * 512) * 64; sc.ldk = 64; sc.K2 = nullptr;
  sc.V = (const u16*)(ws + O_CMPVT) + ((long)(b * 2 + g) * 64) * 512; sc.ldv = 512;
  const int ntc = (t0 >> 10) + 1;
  attn_loop<AM_CMP, 64, false, false, false, false>(smem, sc, ntc, 0, nullptr, qf, m, l, O, t, slope2, 0, 0, 0, 0, 0.f, nullptr, tid);
  {
    const float lt = l;
    const float inv_l = lt > 0.f ? 1.f / lt : 0.f;
    zero_o(O);
    float l2 = 0.f;
    attn_loop<AM_CMP, 64, true, true, true, false>(smem, sc, ntc, 0, nullptr, qf, m, l2, O, t, slope2, 0, 0, 0, 0, inv_l, imp, tid);
    const float sc0 = g0 * inv_l;
#pragma unroll
    for (int db = 0; db < 2; ++db)
#pragma unroll
      for (int i = 0; i < 16; ++i) osp[(db * 16 + i) * 256] = O[db][i] * sc0;
  }
  for (int tk = 0; tk < 8; ++tk) {
    const int token = w * 8 + tk;
    const int cur = (t0 + token) >> 6;
    const u64 k0 = mk_key(lane, imp[token * 130 + lane], cur);
    const u64 k1 = mk_key(lane + 64, imp[token * 130 + lane + 64], cur);
    u64 thr = 0ull;
    for (int bit = 39; bit >= 0; --bit) {
      const u64 cand = thr | (1ull << bit);
      const int c = __popcll(__ballot(k0 >= cand)) + __popcll(__ballot(k1 >= cand));
      if (c >= 16) thr = cand;
    }
    const u64 m0 = __ballot(k0 >= thr && k0 > 0ull);
    const u64 m1 = __ballot(k1 >= thr && k1 > 0ull);
    if (lane == 0) {
      sel[token * 4 + 0] = (unsigned)m0; sel[token * 4 + 1] = (unsigned)(m0 >> 32);
      sel[token * 4 + 2] = (unsigned)m1; sel[token * 4 + 3] = (unsigned)(m1 >> 32);
      atomicOr((unsigned*)&ctl[4], (unsigned)m0); atomicOr((unsigned*)&ctl[5], (unsigned)(m0 >> 32));
      atomicOr((unsigned*)&ctl[6], (unsigned)m1); atomicOr((unsigned*)&ctl[7], (unsigned)(m1 >> 32));
    }
  }
  __syncthreads();
  if (tid == 0) {
    int c = 0;
    for (int q = 0; q < 4; ++q) {
      unsigned u = (unsigned)ctl[4 + q];
      while (u) { int bp = __ffs(u) - 1; ctl[8 + c] = q * 32 + bp; ++c; u &= u - 1; }
    }
    ctl[1] = c;
  }
  __syncthreads();
  const int nsl = ctl[1];
  const unsigned sw0 = sel[l32 * 4 + 0], sw1 = sel[l32 * 4 + 1], sw2 = sel[l32 * 4 + 2], sw3 = sel[l32 * 4 + 3];
  {
    AttnSrc ss;
    ss.K = (const u16*)(ws + O_KS) + (long)b * T_ * 128 + g * 64; ss.ldk = 128; ss.K2 = nullptr;
    ss.V = (const u16*)(ws + O_VST) + ((long)(b * 2 + g) * 64) * T_; ss.ldv = T_;
    m = -1e30f; l = 0.f; zero_o(O);
    attn_loop<AM_SLC, 64, true, false, false, true>(smem, ss, nsl, 0, ctl + 8, qf, m, l, O, t, slope2, sw0, sw1, sw2, sw3, 0.f, nullptr, tid);
    const float lt = l;
    const float sc1 = lt > 0.f ? g1 / lt : 0.f;
#pragma unroll
    for (int db = 0; db < 2; ++db)
#pragma unroll
      for (int i = 0; i < 16; ++i) osp[8192 + (db * 16 + i) * 256] = O[db][i] * sc1;
  }
  {
    AttnSrc sw;
    sw.K = (const u16*)(ws + O_KW) + (long)b * T_ * 128 + g * 64; sw.ldk = 128; sw.K2 = nullptr;
    sw.V = (const u16*)(ws + O_VWT) + ((long)(b * 2 + g) * 64) * T_; sw.ldv = T_;
    const int lo = (t0 > 511 ? (t0 - 511) : 0) >> 6, hi = (t0 + 31) >> 6;
    m = -1e30f; l = 0.f; zero_o(O);
    attn_loop<AM_WIN, 64, true, false, false, false>(smem, sw, hi - lo + 1, lo, nullptr, qf, m, l, O, t, slope2, 0, 0, 0, 0, 0.f, nullptr, tid);
    const float lt = l;
    const float sc2 = lt > 0.f ? g2 / lt : 0.f;
#pragma unroll
    for (int db = 0; db < 2; ++db)
#pragma unroll
      for (int i = 0; i < 16; ++i) O[db][i] = O[db][i] * sc2 + osp[(db * 16 + i) * 256] + osp[8192 + (db * 16 + i) * 256];
  }
  u16* dst = (u16*)(ws + O_CONCAT) + tok * 1024 + head8 * 64;
#pragma unroll
  for (int db = 0; db < 2; ++db)
#pragma unroll
    for (int a = 0; a < 4; ++a)
      store4bf(dst + db * 32 + 8 * a + 4 * h, O[db][4 * a], O[db][4 * a + 1], O[db][4 * a + 2], O[db][4 * a + 3]);
}

DI void ln_apply_pass(const u16* src, const float* st, u16* dst, int tid, int nb) {
  const int lane = tid & 63;
  for (int row = blockIdx.x * 4 + (tid >> 6); row < M_; row += nb * 4) {
    const float mean = st[2 * row] * (1.f / 1024.f);
    const float rstd = rsqrtf(st[2 * row + 1] * (1.f / 1024.f) - mean * mean + 1e-5f);
    const u16* o = src + (long)row * 1024;
#pragma unroll
    for (int i = 0; i < 2; ++i) {
      const int c = lane * 8 + 512 * i;
      const uint4 v = *(const uint4*)(o + c);
      *(uint4*)(dst + (long)row * 1024 + c) = make_uint4(pack2((bflo(v.x) - mean) * rstd, (bfhi(v.x) - mean) * rstd), pack2((bflo(v.y) - mean) * rstd, (bfhi(v.y) - mean) * rstd),
                                                        pack2((bflo(v.z) - mean) * rstd, (bfhi(v.z) - mean) * rstd), pack2((bflo(v.w) - mean) * rstd, (bfhi(v.w) - mean) * rstd));
    }
  }
}

#ifndef REP
#define REP 0
#endif
#ifndef FAKEV
#define FAKEV 0
#endif
DI void tile_map(int i, int NT, int& mt, int& nt, int mpx = 64) {
  const int xcd = i & 7, j = i >> 3;
  const int ms = j / (8 * NT), r = j - ms * 8 * NT;
  nt = r >> 3;
  mt = xcd * mpx + ms * 8 + (r & 7);
}

template <int PMODE = 0, int FK = 0>
DI void phase4(const Params& P, unsigned char* smem, int tid, int cbase) {
  {
    int* ctr = (int*)(P.ws + O_CTR) + cbase;
    int* ctl = (int*)(smem + CTL_OFF);
    const int xcd = blockIdx.x & 7;
    bool mla_done = false;
    for (;;) {
      __syncthreads();
      if (tid == 0) {
        int it = -1;
        if (!mla_done) { int k = atomicAdd(ctr + xcd, 1); if (k < 512) it = k; }
        if (it < 0) { if (PMODE == 1) it = 8192; else { int j = atomicAdd(ctr + 8, 1); it = (j < 4096) ? 4096 + j : 8192; } }
        ctl[0] = it;
      }
      __syncthreads();
      const int item = ctl[0];
      if (item >= 8192) break;
#ifndef SKIP_MLA
      if (item < 4096) {
        const int qt = 63 - (item & 63), bh = (item >> 6) * 8 + xcd;
        mla_item<FK>(P, smem, bh >> 3, bh & 7, qt, tid);
      }
#endif
      if (item >= 4096) mla_done = true;
#ifndef SKIP_NSA
      if (item >= 4096) {
        const int j = item - 4096;
        const int tt = 255 - (j >> 4), bg = j & 15;
        nsa_item(P, smem, bg >> 1, bg & 1, tt, tid);
      }
#endif
    }
  }
}

#define XB_XCNT(j)  (64 * (j))
#define XB_XSUB(j)  (1024 + 64 * (j))
#define XB_XGEN(j)  (2048 + 64 * (j))
#define XB_TOP      3072
#define XB_TOPGEN   3136
#define XB_WORDS    3200
DI unsigned xb_ld(unsigned* p) { return __hip_atomic_load(p, __ATOMIC_RELAXED, __HIP_MEMORY_SCOPE_AGENT); }
DI unsigned xb_add(unsigned* p, unsigned v) { return __hip_atomic_fetch_add(p, v, __ATOMIC_RELAXED, __HIP_MEMORY_SCOPE_AGENT); }
DI unsigned xb_xcc_id() { return (unsigned)__builtin_amdgcn_s_getreg((3 << 11) | 20) & 0xFu; }
struct XBar { unsigned* bar; unsigned x, nloc, nx; };
DI void gsync(const XBar& b, int tid) {
  asm volatile("s_waitcnt vmcnt(0)" ::: "memory");
  __syncthreads();
  if (tid == 0) {
    unsigned* bar = b.bar;
    __builtin_amdgcn_s_waitcnt(0);
    const unsigned old = xb_add(&bar[XB_XSUB(b.x)], 1u);
    const unsigned gen = old / b.nloc;
    if (old + 1u == (gen + 1u) * b.nloc) {
      __builtin_amdgcn_fence(__ATOMIC_RELEASE, "agent");
      asm volatile("s_waitcnt vmcnt(0)" ::: "memory");
      const unsigned og = xb_add(&bar[XB_TOP], 1u);
      const unsigned tg = og / b.nx;
      if (og + 1u == (tg + 1u) * b.nx) xb_add(&bar[XB_TOPGEN], 1u);
      else while (xb_ld(&bar[XB_TOPGEN]) == tg) __builtin_amdgcn_s_sleep(1);
      __builtin_amdgcn_fence(__ATOMIC_ACQUIRE, "agent");
      xb_add(&bar[XB_XGEN(b.x)], 1u);
      asm volatile("s_waitcnt vmcnt(0)" ::: "memory");
    } else {
      while (xb_ld(&bar[XB_XGEN(b.x)]) == gen) __builtin_amdgcn_s_sleep(1);
      __builtin_amdgcn_fence(__ATOMIC_ACQUIRE, "agent");
      asm volatile("s_waitcnt vmcnt(0)" ::: "memory");
    }
  }
  __syncthreads();
}

__global__ void __launch_bounds__(256, 2) fwd_megakernel(Params P) {
  cg::grid_group grid = cg::this_grid();
  extern __shared__ __attribute__((aligned(16))) unsigned char smem[];
  const int tid = threadIdx.x;
  const int nb = gridDim.x;
  XBar xb; xb.bar = (unsigned*)(P.ws + O_BAR); xb.x = xb_xcc_id(); xb.nloc = 1u; xb.nx = 1u;
  if (tid == 0) (void)xb_add(&xb.bar[XB_XCNT(xb.x)], 1u);

#ifndef SKIP_P0
  phase0(P, smem, tid);
#endif
  if (P.ws == nullptr) grid.sync();
  if (tid == 0) {
    unsigned mine = 0u, cnt = 0u, sum = 0u;
    for (;;) {
      mine = 0u; cnt = 0u; sum = 0u;
#pragma unroll
      for (unsigned j = 0; j < 16; ++j) { const unsigned c = xb_ld(&xb.bar[XB_XCNT(j)]); sum += c; cnt += (c > 0u) ? 1u : 0u; mine = (j == xb.x) ? c : mine; }
      if (sum == gridDim.x) break;
      __builtin_amdgcn_s_sleep(1);
    }
    xb.nloc = mine > 0u ? mine : 1u; xb.nx = cnt > 0u ? cnt : 1u;
  }
  gsync(xb, tid);
#ifndef SKIP_P1
  for (int i = blockIdx.x; i < 512 * 14; i += nb) { int mt, nt; tile_map(i, 14, mt, nt); gemm_tile<PH_IN>(P, smem, mt, nt, 0, tid); }
#if REP == 11
  for (int q = 0; q < 20; ++q) gsync(xb, tid);
#endif
#if REP == 1
  gsync(xb, tid);
  for (int i = blockIdx.x; i < 512 * 14; i += nb) { int mt, nt; tile_map(i, 14, mt, nt); gemm_tile<PH_IN>(P, smem, mt, nt, 0, tid); }
#endif
#endif
  gsync(xb, tid);
#ifndef SKIP_P2
  for (int i = blockIdx.x; i < 256 + 3072 + 4096; i += nb) {
    if (i < 256) gemm_tile<PH_C1>(P, smem, (i >> 1) & 63, i & 1, i >> 7, tid);
    else if (i < 256 + 3072) { int mt, nt; tile_map(i - 256, 6, mt, nt); gemm_tile<PH_UQ>(P, smem, mt, nt, 0, tid); }
    else { int mt, nt; tile_map(i - 256 - 3072, 8, mt, nt); gemm_tile<PH_UKV>(P, smem, mt, nt, 0, tid); }
  }
#endif
#if REP == 2
  gsync(xb, tid);
  for (int i = blockIdx.x; i < 256 + 3072 + 4096; i += nb) {
    if (i < 256) gemm_tile<PH_C1>(P, smem, (i >> 1) & 63, i & 1, i >> 7, tid);
    else if (i < 256 + 3072) { int mt, nt; tile_map(i - 256, 6, mt, nt); gemm_tile<PH_UQ>(P, smem, mt, nt, 0, tid); }
    else { int mt, nt; tile_map(i - 256 - 3072, 8, mt, nt); gemm_tile<PH_UKV>(P, smem, mt, nt, 0, tid); }
  }
#endif
  gsync(xb, tid);
#ifndef SKIP_P3
  for (int i = blockIdx.x; i < 128; i += nb) gemm_tile<PH_C2>(P, smem, i & 63, 0, i >> 6, tid);
#endif
  gsync(xb, tid);
  phase4(P, smem, tid, 0);
#if REP == 4
  gsync(xb, tid);
  phase4<0, 0>(P, smem, tid, 16);
#endif
#if REP == 41
  gsync(xb, tid);
  phase4<1, FAKEV>(P, smem, tid, 16);
#endif
  gsync(xb, tid);
  {
    u16* pb = (u16*)(P.ws + O_PB);
    for (long i = (long)blockIdx.x * 256 + tid; i < (long)M_ * 256 / 8; i += (long)nb * 256) {
      const float4 a = *(const float4*)(P.p + i * 8), b = *(const float4*)(P.p + i * 8 + 4);
      *(uint4*)(pb + i * 8) = make_uint4(pack2(a.x, a.y), pack2(a.z, a.w), pack2(b.x, b.y), pack2(b.z, b.w));
    }
  }
#ifndef SKIP_P5
  for (int i = blockIdx.x; i < 256 * 8; i += nb) { int mt, nt; tile_map(i, 8, mt, nt, 32); gemm_tile<PH_OUT>(P, smem, mt, nt, 0, tid); }
#endif
  gsync(xb, tid);
#ifndef SKIP_P6
  for (int i = blockIdx.x; i < 256 * 44; i += nb) { int mt, nt; tile_map(i, 44, mt, nt, 32); gemm_tile<PH_UP>(P, smem, mt, nt, 0, tid); }
#if REP == 6
  gsync(xb, tid);
  for (int i = blockIdx.x; i < 256 * 44; i += nb) { int mt, nt; tile_map(i, 44, mt, nt, 32); gemm_tile<PH_UP, FAKEV>(P, smem, mt, nt, 0, tid); }
#endif
#endif
  gsync(xb, tid);
#ifndef SKIP_P7
  for (int i = blockIdx.x; i < 256 * 8; i += nb) { int mt, nt; tile_map(i, 8, mt, nt, 32); gemm_tile<PH_DOWN>(P, smem, mt, nt, 0, tid); }
#endif
  gsync(xb, tid);
#ifndef SKIP_P8
  for (int i = blockIdx.x; i < 256 * 8; i += nb) { int mt, nt; tile_map(i, 8, mt, nt, 32); gemm_tile<PH_PLE>(P, smem, mt, nt, 0, tid); }
#endif
  gsync(xb, tid);
  {
    const float* st3 = (const float*)(P.ws + O_STATS) + (long)M_ * 4;
    const int lane = tid & 63;
    for (int row = blockIdx.x * 4 + (tid >> 6); row < M_; row += nb * 4) {
      const float mean = st3[2 * row] * (1.f / 1024.f);
      const float rstd = rsqrtf(st3[2 * row + 1] * (1.f / 1024.f) - mean * mean + 1e-5f);
      float* o = P.out + (long)row * 1024;
      const u16* yb = (const u16*)(P.ws + O_CONCAT) + (long)row * 1024;
#pragma unroll
      for (int i = 0; i < 4; ++i) {
        const int c = lane * 4 + 256 * i;
        const uint2 yq = *(const uint2*)(yb + c);
        float4 v = make_float4(bflo(yq.x), bfhi(yq.x), bflo(yq.y), bfhi(yq.y));
        const float4 gg = *(const float4*)(P.ln3_g + c);
        const float4 bb = *(const float4*)(P.ln3_b + c);
        v.x = (v.x - mean) * rstd * gg.x + bb.x;
        v.y = (v.y - mean) * rstd * gg.y + bb.y;
        v.z = (v.z - mean) * rstd * gg.z + bb.z;
        v.w = (v.w - mean) * rstd * gg.w + bb.w;
        *(float4*)(o + c) = v;
      }
    }
  }
}

extern "C" void kernel_launch(void* const* d_in, const int* in_sizes, int n_in,
                              void* d_out, int out_size, void* d_ws, size_t ws_size,
                              hipStream_t stream) {
  static int grid_blocks = 0;
  if (!grid_blocks) {
    int dev = 0, cus = 0, per_cu = 0;
    (void)hipGetDevice(&dev);
    (void)hipDeviceGetAttribute(&cus, hipDeviceAttributeMultiprocessorCount, dev);
    (void)hipFuncSetAttribute((const void*)fwd_megakernel, hipFuncAttributeMaxDynamicSharedMemorySize, LDS_TOTAL);
    (void)hipOccupancyMaxActiveBlocksPerMultiprocessor(&per_cu, fwd_megakernel, 256, LDS_TOTAL);
    if (per_cu < 1) per_cu = 1;
    if (per_cu > 2) per_cu = 2;
    grid_blocks = cus * per_cu;
    fprintf(stderr, "grid_blocks=%d (cus=%d per_cu=%d) ws_need=%zu ws_size=%zu\n", grid_blocks, cus, per_cu, (size_t)WS_NEED, ws_size);
  }
  if (ws_size < WS_NEED || n_in < 24) { fprintf(stderr, "kernel_launch: workspace too small or bad inputs\n"); return; }
  (void)hipMemsetAsync((unsigned char*)d_ws + O_BAR, 0, 16384, stream);
  Params p{};
  const float** pp = (const float**)&p;
  for (int i = 0; i < 24; ++i) pp[i] = (const float*)d_in[i];
  p.out = (float*)d_out;
  p.ws = (unsigned char*)d_ws;
  void* args[] = {&p};
  hipError_t e = hipLaunchCooperativeKernel((void*)fwd_megakernel, dim3(grid_blocks), dim3(256), args, LDS_TOTAL, stream);
  if (e != hipSuccess) fprintf(stderr, "cooperative launch failed: %s (grid %d)\n", hipGetErrorString(e), grid_blocks);
}
```

```cpp
#include <hip/hip_runtime.h>
#include <hip/hip_cooperative_groups.h>
#include <cstdio>
#include <cstdint>
namespace cg = cooperative_groups;

#define DI __device__ __forceinline__
typedef unsigned short u16;
typedef unsigned long long u64;
typedef __attribute__((ext_vector_type(8))) short bf16x8;
typedef __attribute__((ext_vector_type(4))) short s16x4;
typedef __attribute__((ext_vector_type(4))) float f32x4;
typedef __attribute__((ext_vector_type(16))) float f32x16;
typedef __attribute__((ext_vector_type(2))) __bf16 bf2_t;

constexpr int T_ = 8192;
constexpr int M_ = 65536;
constexpr float ALPHA_ = 1.189207115002721f;
constexpr float LOG2E_ = 1.4426950408889634f;

constexpr size_t AL(size_t x) { return (x + 255) & ~(size_t)255; }
constexpr size_t O_WT_IN   = 0;
constexpr size_t O_WT_UQ   = O_WT_IN   + AL((size_t)1792 * 1024 * 2);
constexpr size_t O_WT_UKV  = O_WT_UQ   + AL((size_t)768 * 256 * 2);
constexpr size_t O_WT_CK1  = O_WT_UKV  + AL((size_t)1024 * 128 * 2);
constexpr size_t O_WT_CV1  = O_WT_CK1  + AL((size_t)256 * 2048 * 2);
constexpr size_t O_WT_CK2  = O_WT_CV1  + AL((size_t)256 * 2048 * 2);
constexpr size_t O_WT_CV2  = O_WT_CK2  + AL((size_t)128 * 256 * 2);
constexpr size_t O_WT_OUT  = O_WT_CV2  + AL((size_t)128 * 256 * 2);
constexpr size_t O_WT_UP   = O_WT_OUT  + AL((size_t)1024 * 1024 * 2);
constexpr size_t O_WT_DOWN = O_WT_UP   + AL((size_t)5632 * 1024 * 2);
constexpr size_t O_WT_GATE = O_WT_DOWN + AL((size_t)1024 * 2816 * 2);
constexpr size_t O_WT_PLE  = O_WT_GATE + AL((size_t)1024 * 1024 * 2);
constexpr size_t O_BIAS1K  = O_WT_PLE  + AL((size_t)1024 * 256 * 2);
constexpr size_t O_BIAS1V  = O_BIAS1K  + AL(256 * 4);
constexpr size_t O_BIAS_UP = O_BIAS1V  + AL(256 * 4);
constexpr size_t O_BIAS_G  = O_BIAS_UP + AL(5632 * 4);
constexpr size_t O_CSUM_UP = O_BIAS_G  + AL(1024 * 4);
constexpr size_t O_CSUM_G  = O_CSUM_UP + AL(5632 * 4);
constexpr size_t O_ROPE_C  = O_CSUM_G  + AL(1024 * 4);
constexpr size_t O_ROPE_S  = O_ROPE_C  + AL((size_t)8192 * 16 * 4);
constexpr size_t O_STATS   = O_ROPE_S  + AL((size_t)8192 * 16 * 4);
constexpr size_t O_SSQ     = O_STATS   + AL((size_t)3 * M_ * 2 * 4);
constexpr size_t O_CTR     = O_SSQ     + AL((size_t)2 * M_ * 4);
constexpr size_t O_BAR     = O_CTR     + 256;
constexpr size_t O_HID     = O_BAR     + 16384;
constexpr size_t O_CMPK    = O_HID     + AL((size_t)2 * 8192 * 256 * 2);
constexpr size_t O_CMPVT   = O_CMPK    + AL((size_t)16 * 512 * 64 * 2);
constexpr size_t O_CONCAT  = O_CMPVT   + AL((size_t)16 * 64 * 512 * 2);
constexpr size_t O_Y2      = O_CONCAT  + AL((size_t)M_ * 1024 * 2);
constexpr size_t O_R1      = O_Y2      + AL((size_t)M_ * 1024 * 4);
constexpr size_t O_QN      = O_R1;
constexpr size_t O_KC      = O_QN   + AL((size_t)M_ * 512 * 2);
constexpr size_t O_VC      = O_KC   + AL((size_t)M_ * 128 * 2);
constexpr size_t O_KS      = O_VC   + AL((size_t)M_ * 128 * 2);
constexpr size_t O_VST     = O_KS   + AL((size_t)M_ * 128 * 2);
constexpr size_t O_KW      = O_VST  + AL((size_t)M_ * 128 * 2);
constexpr size_t O_VWT     = O_KW   + AL((size_t)M_ * 128 * 2);
constexpr size_t O_CQ      = O_VWT  + AL((size_t)M_ * 128 * 2);
constexpr size_t O_CKV     = O_CQ   + AL((size_t)M_ * 256 * 2);
constexpr size_t O_KPE     = O_CKV  + AL((size_t)M_ * 128 * 2);
constexpr size_t O_GATES   = O_KPE  + AL((size_t)M_ * 32 * 2);
constexpr size_t O_QM      = O_GATES + AL((size_t)M_ * 24 * 4);
constexpr size_t O_KN      = O_QM   + AL((size_t)M_ * 768 * 2);
constexpr size_t O_VMT     = O_KN   + AL((size_t)M_ * 512 * 2);
constexpr size_t O_R1_END  = O_VMT  + AL((size_t)M_ * 512 * 2);
constexpr size_t O_HBUF    = O_R1;
constexpr size_t O_PB      = O_R1 + AL((size_t)M_ * 2816 * 2);
static_assert(O_PB + (size_t)M_ * 256 * 2 <= O_R1_END, "PB alias");
static_assert(O_R1_END - O_R1 >= (size_t)M_ * 2816 * 2, "HBUF alias too small");
constexpr size_t O_YB      = O_R1_END;
constexpr size_t WS_NEED   = O_YB + AL((size_t)M_ * 1024 * 2);
static_assert(WS_NEED <= (size_t)1073741824, "workspace budget (4 x largest tensor)");

struct Params {
  const float *x, *p, *w_in, *w_ck1, *w_ck2, *pos_ck, *w_cv1, *w_cv2, *pos_cv, *qn_g, *w_uq, *kvn_g, *w_ukv, *w_out,
      *ln1_g, *ln1_b, *w_up, *w_down, *ln2_g, *ln2_b, *w_pg, *w_ple, *ln3_g, *ln3_b;
  float* out;
  unsigned char* ws;
};

DI unsigned pack2(float a, float b) { bf2_t v; v[0] = (__bf16)a; v[1] = (__bf16)b; return __builtin_bit_cast(unsigned, v); }
DI void store4bf(u16* p, float a, float b, float c, float d) { *(uint2*)p = make_uint2(pack2(a, b), pack2(c, d)); }
DI float bflo(unsigned u) { return __uint_as_float(u << 16); }
DI float bfhi(unsigned u) { return __uint_as_float(u & 0xffff0000u); }
DI float sigmoid_(float x) { return 1.f / (1.f + __expf(-x)); }
DI float gelu_tanh_(float x) {
  float u = 0.7978845608028654f * (x + 0.044715f * x * x * x);
  float e = __expf(2.f * u);
  float th = 1.f - 2.f / (e + 1.f);
  return 0.5f * x * (1.f + th);
}
DI float ex2(float x) { return __builtin_amdgcn_exp2f(x); }
#define MFMA16(a, b, c) __builtin_amdgcn_mfma_f32_16x16x32_bf16((a), (b), (c), 0, 0, 0)
#define MFMA32(a, b, c) __builtin_amdgcn_mfma_f32_32x32x16_bf16((a), (b), (c), 0, 0, 0)

DI int map_in(int n) {
  if (n < 1280) return n;
  if (n < 1536) return 1304 + (n - 1280);
  if (n < 1664) return 1560 + (n - 1536);
  if (n < 1696) return 1688 + (n - 1664);
  if (n < 1720) return 1280 + (n - 1696);
  return -1;
}
DI int map_up(int n) {
  int t = n >> 7, c = n & 127, wc = c >> 6, j = (c >> 4) & 3, i = c & 15;
  int base = 64 * t + wc * 32 + (i >> 2) * 8 + (j & 1) * 4 + (i & 3);
  return (j < 2) ? base : 2816 + base;
}

struct TJob { const float* src; u16* dst; const float* scale; int K, Nsrc, map; };
DI TJob get_tjob(const Params& P, int j) {
  TJob t; t.scale = nullptr; t.map = 0;
  unsigned char* ws = P.ws;
  switch (j) {
    case 0: t.src = P.w_in; t.dst = (u16*)(ws + O_WT_IN); t.K = 1024; t.Nsrc = 1720; t.map = 1; break;
    case 1: t.src = P.w_uq; t.dst = (u16*)(ws + O_WT_UQ); t.K = 256; t.Nsrc = 768; t.scale = P.qn_g; break;
    case 2: t.src = P.w_ukv; t.dst = (u16*)(ws + O_WT_UKV); t.K = 128; t.Nsrc = 1024; t.scale = P.kvn_g; break;
    case 3: t.src = P.w_ck1; t.dst = (u16*)(ws + O_WT_CK1); t.K = 2048; t.Nsrc = 256; break;
    case 4: t.src = P.w_cv1; t.dst = (u16*)(ws + O_WT_CV1); t.K = 2048; t.Nsrc = 256; break;
    case 5: t.src = P.w_ck2; t.dst = (u16*)(ws + O_WT_CK2); t.K = 256; t.Nsrc = 64; break;
    case 6: t.src = P.w_cv2; t.dst = (u16*)(ws + O_WT_CV2); t.K = 256; t.Nsrc = 64; break;
    case 7: t.src = P.w_out; t.dst = (u16*)(ws + O_WT_OUT); t.K = 1024; t.Nsrc = 1024; break;
    case 8: t.src = P.w_up; t.dst = (u16*)(ws + O_WT_UP); t.K = 1024; t.Nsrc = 5632; t.map = 2; t.scale = P.ln1_g; break;
    case 9: t.src = P.w_down; t.dst = (u16*)(ws + O_WT_DOWN); t.K = 2816; t.Nsrc = 1024; break;
    case 10: t.src = P.w_pg; t.dst = (u16*)(ws + O_WT_GATE); t.K = 1024; t.Nsrc = 1024; t.scale = P.ln2_g; break;
    default: t.src = P.w_ple; t.dst = (u16*)(ws + O_WT_PLE); t.K = 256; t.Nsrc = 1024; break;
  }
  return t;
}

DI void phase0(const Params& P, unsigned char* smem, int tid) {
  const int NTL[12] = {448, 48, 32, 128, 128, 4, 4, 256, 1408, 704, 256, 64};
  constexpr int TOT_T = 3480;
  constexpr int TOT_U = TOT_T + 896;
  float* tl = (float*)smem;
  for (int pass = 0; pass < 2; ++pass) {
  if ((pass ^ (int)(blockIdx.x >> 3)) & 1) {
  for (int u = blockIdx.x; u < TOT_U; u += gridDim.x) {
    __syncthreads();
    if (u < TOT_T) {
      int j = 0, ti = u;
#pragma unroll
      for (int q = 0; q < 12; ++q) { if (j == q && ti >= NTL[q]) { ti -= NTL[q]; j = q + 1; } }
      TJob jb = get_tjob(P, j);
      const int nkt = jb.K >> 6;
      const int k0 = (ti % nkt) * 64, n0 = (ti / nkt) * 64;
#pragma unroll
      for (int i = 0; i < 16; ++i) {
        int kk = i * 4 + (tid >> 6), nn = tid & 63;
        int n = n0 + nn;
        int sn = (jb.map == 1) ? map_in(n) : (jb.map == 2 ? map_up(n) : n);
        float v = 0.f;
        if (sn >= 0) v = jb.src[(long)(k0 + kk) * jb.Nsrc + sn];
        if (jb.scale) v *= jb.scale[k0 + kk];
        tl[kk * 65 + nn] = v;
      }
      __syncthreads();
      {
        int n = tid >> 2, kq = tid & 3;
        unsigned w[8];
#pragma unroll
        for (int e = 0; e < 8; ++e) w[e] = pack2(tl[(kq * 16 + 2 * e) * 65 + n], tl[(kq * 16 + 2 * e + 1) * 65 + n]);
        u16* d = jb.dst + (long)(n0 + n) * jb.K + k0 + kq * 16;
        *(uint4*)d = make_uint4(w[0], w[1], w[2], w[3]);
        *(uint4*)(d + 8) = make_uint4(w[4], w[5], w[6], w[7]);
      }
    } else {
      int bu = u - TOT_T;
      const float* vec; const float* vec2 = nullptr; const float* W; float* dst; float* dst2 = nullptr; int K, Nsrc, mp = 0;
      if (bu < 32) { vec = P.pos_ck; W = P.w_ck1; dst = (float*)(P.ws + O_BIAS1K); K = 2048; Nsrc = 256; }
      else if (bu < 64) { bu -= 32; vec = P.pos_cv; W = P.w_cv1; dst = (float*)(P.ws + O_BIAS1V); K = 2048; Nsrc = 256; }
      else if (bu < 768) { bu -= 64; vec = P.ln1_b; vec2 = P.ln1_g; W = P.w_up; dst = (float*)(P.ws + O_BIAS_UP); dst2 = (float*)(P.ws + O_CSUM_UP); K = 1024; Nsrc = 5632; mp = 2; }
      else { bu -= 768; vec = P.ln2_b; vec2 = P.ln2_g; W = P.w_pg; dst = (float*)(P.ws + O_BIAS_G); dst2 = (float*)(P.ws + O_CSUM_G); K = 1024; Nsrc = 1024; }
      int c = tid & 7, kg = tid >> 3;
      int n = bu * 8 + c;
      int sn = (mp == 2) ? map_up(n) : n;
      float sa = 0.f, sb = 0.f;
      if (vec2) {
#pragma unroll 8
        for (int k = kg; k < K; k += 32) { const float w = W[(long)k * Nsrc + sn]; sa += vec[k] * w; sb += vec2[k] * w; }
      } else {
#pragma unroll 8
        for (int k = kg; k < K; k += 32) sa += vec[k] * W[(long)k * Nsrc + sn];
      }
      tl[kg * 8 + c] = sa; tl[256 + kg * 8 + c] = sb;
      __syncthreads();
      if (tid < 8) {
        float a0 = 0.f, a1 = 0.f;
#pragma unroll
        for (int q = 0; q < 32; ++q) { a0 += tl[q * 8 + tid]; a1 += tl[256 + q * 8 + tid]; }
        dst[bu * 8 + tid] = a0;
        if (dst2) dst2[bu * 8 + tid] = a1;
      }
    }
  }
  } else {
    const long gtid0 = (long)blockIdx.x * 256 + tid, gstr0 = (long)gridDim.x * 256;
    u16* xb = (u16*)(P.ws + O_CONCAT);
    for (long i = gtid0; i < (long)M_ * 1024 / 8; i += gstr0) {
      const float4 a = *(const float4*)(P.x + i * 8), b = *(const float4*)(P.x + i * 8 + 4);
      *(uint4*)(xb + i * 8) = make_uint4(pack2(a.x, a.y), pack2(a.z, a.w), pack2(b.x, b.y), pack2(b.z, b.w));
    }
  }
  }
  const long gtid = (long)blockIdx.x * 256 + tid, gstr = (long)gridDim.x * 256;
  float* rc = (float*)(P.ws + O_ROPE_C);
  float* rs = (float*)(P.ws + O_ROPE_S);
  for (long i = gtid; i < 8192 * 16; i += gstr) {
    int pos = (int)(i >> 4), f = (int)(i & 15);
    float inv = powf(10000.0f, -(float)f / 16.0f);
    float ang = (float)pos * inv;
    rc[i] = cosf(ang); rs[i] = sinf(ang);
  }
  float* st = (float*)(P.ws + O_STATS);
  for (long i = gtid; i < (long)3 * M_ * 2; i += gstr) st[i] = 0.f;
  { float* sq = (float*)(P.ws + O_SSQ); for (long i = gtid; i < (long)2 * M_; i += gstr) sq[i] = 0.f; }
  if (gtid < 64) ((int*)(P.ws + O_CTR))[gtid] = 0;
}

constexpr int LDS_BUF = 32768;
constexpr int LDS_RS_OFF = 2 * LDS_BUF;

template <int AMODE, int FAKE = 0>
DI void gemm_mainloop(f32x4 (&acc)[4][4], unsigned char* smem, const void* A, long lda, int m0, int K,
                      const u16* Bt, int n0, const float* stats, bool ns, int tid) {
  const int lane = tid & 63, wave = tid >> 6, wm = wave >> 1, wn = wave & 1;
  const int l16 = lane & 15, lq = lane >> 4;
  const int crow = tid >> 3, cch = tid & 7;
  int gtok0 = 0;
  const int nk = K >> 6;
  const int swz = (cch ^ (crow & 7)) * 8;
  const unsigned boff = ((unsigned)(n0 + crow) * (unsigned)K + (unsigned)cch * 8u) * 2u;
  const unsigned bstrb = 64u * (unsigned)K;
  unsigned aoff = 0u; const unsigned astrb = 64u * (unsigned)lda;
  if constexpr (AMODE == 0) aoff = ((unsigned)(m0 + crow) * (unsigned)lda + (unsigned)cch * 8u) * 2u;
  if constexpr (AMODE == 3) { const int r_ = m0 + crow; const int bg_ = r_ >> 9; gtok0 = (r_ & 511) * 16;
    aoff = ((unsigned)(bg_ >> 1) * (unsigned)T_ * 128u + (unsigned)(bg_ & 1) * 64u + (unsigned)cch * 8u) * 2u; }
  const unsigned gch = (unsigned)(cch ^ (crow & 7)) * 16u;
  const unsigned boffd = ((unsigned)(n0 + crow) * (unsigned)K) * 2u + gch;
  unsigned aoffd = 0u;
  if constexpr (AMODE == 0) aoffd = ((unsigned)(m0 + crow) * (unsigned)lda) * 2u + gch;
  if constexpr (AMODE == 3) { const int r_ = m0 + crow; const int bg_ = r_ >> 9;
    aoffd = ((unsigned)(bg_ >> 1) * (unsigned)T_ * 128u + (unsigned)(bg_ & 1) * 64u) * 2u + gch; }
  const int wbase = __builtin_amdgcn_readfirstlane(wave) * 1024;
#define GP(base_, off_) ((const unsigned*)((const char*)(base_) + (unsigned)(off_)))
#define LP(BUF, off_) ((unsigned*)(smem + (BUF) * LDS_BUF + wbase + (off_)))
#define D_LOAD(BUF, ks) { const unsigned qb_ = boffd + (unsigned)(ks) * 128u; \
    __builtin_amdgcn_global_load_lds(GP(Bt, qb_), LP(BUF, 16384), 16, 0, 0); \
    __builtin_amdgcn_global_load_lds(GP(Bt, qb_ + bstrb), LP(BUF, 16384 + 4096), 16, 0, 0); \
    __builtin_amdgcn_global_load_lds(GP(Bt, qb_ + 2u * bstrb), LP(BUF, 16384 + 8192), 16, 0, 0); \
    __builtin_amdgcn_global_load_lds(GP(Bt, qb_ + 3u * bstrb), LP(BUF, 16384 + 12288), 16, 0, 0); \
    if constexpr (AMODE == 0) { const unsigned qa_ = aoffd + (unsigned)(ks) * 128u; \
      __builtin_amdgcn_global_load_lds(GP(A, qa_), LP(BUF, 0), 16, 0, 0); \
      __builtin_amdgcn_global_load_lds(GP(A, qa_ + astrb), LP(BUF, 4096), 16, 0, 0); \
      __builtin_amdgcn_global_load_lds(GP(A, qa_ + 2u * astrb), LP(BUF, 8192), 16, 0, 0); \
      __builtin_amdgcn_global_load_lds(GP(A, qa_ + 3u * astrb), LP(BUF, 12288), 16, 0, 0); } \
    else { \
      __builtin_amdgcn_global_load_lds(GP(A, aoffd + (unsigned)min(gtok0 + (ks), T_ - 1) * 256u), LP(BUF, 0), 16, 0, 0); \
      __builtin_amdgcn_global_load_lds(GP(A, aoffd + (unsigned)min(gtok0 + 512 + (ks), T_ - 1) * 256u), LP(BUF, 4096), 16, 0, 0); \
      __builtin_amdgcn_global_load_lds(GP(A, aoffd + (unsigned)min(gtok0 + 1024 + (ks), T_ - 1) * 256u), LP(BUF, 8192), 16, 0, 0); \
      __builtin_amdgcn_global_load_lds(GP(A, aoffd + (unsigned)min(gtok0 + 1536 + (ks), T_ - 1) * 256u), LP(BUF, 12288), 16, 0, 0); } }
#define D_SYNC() { asm volatile("s_waitcnt vmcnt(0)" ::: "memory"); asm volatile("s_waitcnt lgkmcnt(0)" ::: "memory"); __builtin_amdgcn_s_barrier(); asm volatile("" ::: "memory"); }
#define G_ROW(mi, fa_) \
      if (ns) { acc[mi][0] = MFMA16(fa_, fb0, acc[mi][0]); acc[mi][1] = MFMA16(fa_, fb1, acc[mi][1]); acc[mi][2] = MFMA16(fa_, fb2, acc[mi][2]); acc[mi][3] = MFMA16(fa_, fb3, acc[mi][3]); } \
      else    { acc[mi][0] = MFMA16(fb0, fa_, acc[mi][0]); acc[mi][1] = MFMA16(fb1, fa_, acc[mi][1]); acc[mi][2] = MFMA16(fb2, fa_, acc[mi][2]); acc[mi][3] = MFMA16(fb3, fa_, acc[mi][3]); }
#define G_HALF(BUF, kk) { \
      const int co = (((kk) * 4 + lq) ^ (l16 & 7)) * 8; \
      const u16* pa = (const u16*)(smem + (BUF) * LDS_BUF) + (wm * 64 + l16) * 64 + co; \
      const u16* pb = (const u16*)(smem + (BUF) * LDS_BUF) + 8192 + (wn * 64 + l16) * 64 + co; \
      const bf16x8 fa0 = *(const bf16x8*)pa, fa1 = *(const bf16x8*)(pa + 16 * 64), fa2 = *(const bf16x8*)(pa + 32 * 64), fa3 = *(const bf16x8*)(pa + 48 * 64); \
      const bf16x8 fb0 = *(const bf16x8*)pb, fb1 = *(const bf16x8*)(pb + 16 * 64), fb2 = *(const bf16x8*)(pb + 32 * 64), fb3 = *(const bf16x8*)(pb + 48 * 64); \
      G_ROW(0, fa0) G_ROW(1, fa1) G_ROW(2, fa2) G_ROW(3, fa3) }
#define R_STEP(CUR, ks) { \
    if ((ks) + 1 < nk && FAKE != 1) D_LOAD((CUR) ^ 1, (ks) + 1) \
    __builtin_amdgcn_sched_barrier(0); \
    if (FAKE != 2) { G_HALF(CUR, 0) G_HALF(CUR, 1) } \
    D_SYNC() }
  __syncthreads();
  D_LOAD(0, 0)
  D_SYNC()
  for (int ks = 0; ks < nk; ks += 2) {
    R_STEP(0, ks)
    if (ks + 1 < nk) R_STEP(1, ks + 1)
  }
#undef GP
#undef LP
#undef D_LOAD
#undef D_SYNC
#undef G_ROW
#undef G_HALF
#undef R_STEP
}

constexpr int LDS_BIG = 24576;
template <int FAKE = 0>
DI void gemm_mainloop_big(f32x4 (&acc)[8][4], unsigned char* smem, const void* A, long lda, int m0, int K,
                          const u16* Bt, int n0, bool ns, int tid) {
  const int lane = tid & 63, wave = tid >> 6, wm = wave >> 1, wn = wave & 1;
  const int l16 = lane & 15, lq = lane >> 4;
  const int nk = K >> 5;
  const int prow = lane >> 2, ppos = lane & 3;
  const unsigned gch = (unsigned)(ppos ^ ((4 - ((lane >> 4) & 3)) & 3)) * 16u;
  const unsigned aoffd = ((unsigned)(m0 + 16 * wave + prow) * (unsigned)lda) * 2u + gch;
  const unsigned boffd = ((unsigned)(n0 + 16 * wave + prow) * (unsigned)K) * 2u + gch;
  const unsigned astrb = 128u * (unsigned)lda, bstrb = 128u * (unsigned)K;
  const int wbase = __builtin_amdgcn_readfirstlane(wave) * 1024;
#define GP(base_, off_) ((const unsigned*)((const char*)(base_) + (unsigned)(off_)))
#define LP(BUF, off_) ((unsigned*)(smem + (BUF) * LDS_BIG + wbase + (off_)))
#define D_LOAD(BUF, ks) { const unsigned ko_ = (unsigned)(ks) * 64u; \
    __builtin_amdgcn_global_load_lds(GP(A, aoffd + ko_), LP(BUF, 0), 16, 0, 0); \
    __builtin_amdgcn_global_load_lds(GP(A, aoffd + ko_ + astrb), LP(BUF, 4096), 16, 0, 0); \
    __builtin_amdgcn_global_load_lds(GP(A, aoffd + ko_ + 2u * astrb), LP(BUF, 8192), 16, 0, 0); \
    __builtin_amdgcn_global_load_lds(GP(A, aoffd + ko_ + 3u * astrb), LP(BUF, 12288), 16, 0, 0); \
    __builtin_amdgcn_global_load_lds(GP(Bt, boffd + ko_), LP(BUF, 16384), 16, 0, 0); \
    __builtin_amdgcn_global_load_lds(GP(Bt, boffd + ko_ + bstrb), LP(BUF, 16384 + 4096), 16, 0, 0); }
#define D_SYNC() { asm volatile("s_waitcnt vmcnt(0)" ::: "memory"); asm volatile("s_waitcnt lgkmcnt(0)" ::: "memory"); __builtin_amdgcn_s_barrier(); asm volatile("" ::: "memory"); }
  const int pp = (lq ^ ((4 - ((l16 >> 2) & 3)) & 3)) * 8;
#define B_ROW(mi) { const bf16x8 fa_ = *(const bf16x8*)(pa + (mi) * 16 * 32); \
      if (ns) { acc[mi][0] = MFMA16(fa_, fb0, acc[mi][0]); acc[mi][1] = MFMA16(fa_, fb1, acc[mi][1]); acc[mi][2] = MFMA16(fa_, fb2, acc[mi][2]); acc[mi][3] = MFMA16(fa_, fb3, acc[mi][3]); } \
      else    { acc[mi][0] = MFMA16(fb0, fa_, acc[mi][0]); acc[mi][1] = MFMA16(fb1, fa_, acc[mi][1]); acc[mi][2] = MFMA16(fb2, fa_, acc[mi][2]); acc[mi][3] = MFMA16(fb3, fa_, acc[mi][3]); } }
#define B_COMPUTE(BUF) { \
      const u16* pa = (const u16*)(smem + (BUF) * LDS_BIG) + (wm * 128 + l16) * 32 + pp; \
      const u16* pb = (const u16*)(smem + (BUF) * LDS_BIG + 16384) + (wn * 64 + l16) * 32 + pp; \
      const bf16x8 fb0 = *(const bf16x8*)pb, fb1 = *(const bf16x8*)(pb + 16 * 32), fb2 = *(const bf16x8*)(pb + 32 * 32), fb3 = *(const bf16x8*)(pb + 48 * 32); \
      B_ROW(0) B_ROW(1) B_ROW(2) B_ROW(3) B_ROW(4) B_ROW(5) B_ROW(6) B_ROW(7) }
#define B_STEP(CUR, ks) { \
    if ((ks) + 1 < nk && FAKE != 1) D_LOAD((CUR) ^ 1, (ks) + 1) \
    __builtin_amdgcn_sched_barrier(0); \
    if (FAKE != 2) B_COMPUTE(CUR) \
    D_SYNC() }
  __syncthreads();
  D_LOAD(0, 0)
  D_SYNC()
  for (int ks = 0; ks < nk; ks += 2) {
    B_STEP(0, ks)
    if (ks + 1 < nk) B_STEP(1, ks + 1)
  }
#undef GP
#undef LP
#undef D_LOAD
#undef D_SYNC
#undef B_ROW
#undef B_COMPUTE
#undef B_STEP
}

template <int MI>
DI void zero_acc(f32x4 (&acc)[MI][4]) {
#pragma unroll
  for (int i = 0; i < MI; ++i)
#pragma unroll
    for (int j = 0; j < 4; ++j) acc[i][j] = f32x4{0.f, 0.f, 0.f, 0.f};
}

DI void stat_push(float* stats, int tok, float s1, float s2, int lq) {
  s1 += __shfl_xor(s1, 16); s2 += __shfl_xor(s2, 16);
  s1 += __shfl_xor(s1, 32); s2 += __shfl_xor(s2, 32);
  if (lq == 0) { atomicAdd(stats + 2 * (long)tok, s1); atomicAdd(stats + 2 * (long)tok + 1, s2); }
}

enum { PH_IN = 1, PH_UQ, PH_UKV, PH_C1, PH_C2, PH_OUT, PH_UP, PH_DOWN, PH_PLE };

template <int PH, int FAKE = 0>
DI void gemm_tile(const Params& P, unsigned char* smem, int mt, int nt, int which, int tid_in) {
  int tid = tid_in;
  asm volatile("" : "+v"(tid));
  unsigned char* ws = P.ws;
  const int lane = tid & 63, wave = tid >> 6, wm = wave >> 1, wn = wave & 1;
  const int l16 = lane & 15, lq = lane >> 4;
  constexpr int MI = (PH == PH_OUT || PH == PH_UP || PH == PH_DOWN || PH == PH_PLE) ? 8 : 4;
  constexpr int WR = MI * 16;
  const int m0 = mt * (2 * WR), n0 = nt * 128;
  f32x4 acc[MI][4];
  zero_acc<MI>(acc);
  float* rsq = (float*)(smem + LDS_RS_OFF);

  if constexpr (PH == PH_IN) {
    const bool ns = (nt == 7 || nt == 9);
    gemm_mainloop<0>(acc, smem, (const u16*)(ws + O_CONCAT), 1024, m0, 1024, (const u16*)(ws + O_WT_IN), n0, nullptr, ns, tid);
    const float QSC = 0.125f * LOG2E_;
#pragma unroll
    for (int mi = 0; mi < MI; ++mi) {
      if (!ns) {
        const int tok = m0 + wm * WR + mi * 16 + l16;
        if (nt < 4) {
#pragma unroll
          for (int nj = 0; nj < 4; ++nj) {
            int col = n0 + wn * 64 + nj * 16 + lq * 4;
            f32x4 a = acc[mi][nj];
            store4bf((u16*)(ws + O_QN) + (long)tok * 512 + col, a[0] * QSC, a[1] * QSC, a[2] * QSC, a[3] * QSC);
          }
        } else if (nt == 4 || nt == 5 || nt == 6 || nt == 8 || nt == 12) {
          u16* dst = (u16*)(ws + (nt == 4 ? O_KC : nt == 5 ? O_VC : nt == 6 ? O_KS : nt == 8 ? O_KW : O_CKV));
          float ss = 0.f;
#pragma unroll
          for (int nj = 0; nj < 4; ++nj) {
            int col = wn * 64 + nj * 16 + lq * 4;
            f32x4 a = acc[mi][nj];
            ss += a[0] * a[0] + a[1] * a[1] + a[2] * a[2] + a[3] * a[3];
            store4bf(dst + (long)tok * 128 + col, a[0], a[1], a[2], a[3]);
          }
          if (nt == 12) {
            ss += __shfl_xor(ss, 16); ss += __shfl_xor(ss, 32);
            if (lq == 0) atomicAdd((float*)(ws + O_SSQ) + M_ + tok, ss);
          }
        } else if (nt == 10 || nt == 11) {
          float ss = 0.f;
#pragma unroll
          for (int nj = 0; nj < 4; ++nj) {
            int col = (nt - 10) * 128 + wn * 64 + nj * 16 + lq * 4;
            f32x4 a = acc[mi][nj];
            ss += a[0] * a[0] + a[1] * a[1] + a[2] * a[2] + a[3] * a[3];
            store4bf((u16*)(ws + O_CQ) + (long)tok * 256 + col, a[0], a[1], a[2], a[3]);
          }
          ss += __shfl_xor(ss, 16); ss += __shfl_xor(ss, 32);
          if (lq == 0) atomicAdd((float*)(ws + O_SSQ) + tok, ss);
        } else {
          if (wn == 0) {
            const int pos = tok & (T_ - 1);
            const float4 cs = *(const float4*)((const float*)(ws + O_ROPE_C) + pos * 16 + lq * 4);
            const float4 sn = *(const float4*)((const float*)(ws + O_ROPE_S) + pos * 16 + lq * 4);
            f32x4 x1 = acc[mi][0], x2 = acc[mi][1];
            u16* kp = (u16*)(ws + O_KPE) + (long)tok * 32;
            store4bf(kp + lq * 4, x1[0] * cs.x - x2[0] * sn.x, x1[1] * cs.y - x2[1] * sn.y, x1[2] * cs.z - x2[2] * sn.z, x1[3] * cs.w - x2[3] * sn.w);
            store4bf(kp + 16 + lq * 4, x2[0] * cs.x + x1[0] * sn.x, x2[1] * cs.y + x1[1] * sn.y, x2[2] * cs.z + x1[2] * sn.z, x2[3] * cs.w + x1[3] * sn.w);
            float* gp = (float*)(ws + O_GATES) + (long)tok * 24;
            f32x4 g0 = acc[mi][2], g1 = acc[mi][3];
            *(float4*)(gp + lq * 4) = make_float4(sigmoid_(g0[0]), sigmoid_(g0[1]), sigmoid_(g0[2]), sigmoid_(g0[3]));
            if (lq < 2) *(float4*)(gp + 16 + lq * 4) = make_float4(sigmoid_(g1[0]), sigmoid_(g1[1]), sigmoid_(g1[2]), sigmoid_(g1[3]));
          }
        }
      } else {
        const int tok4 = m0 + wm * WR + mi * 16 + lq * 4;
        const int b = tok4 >> 13, t = tok4 & (T_ - 1);
        u16* dstb = (u16*)(ws + (nt == 7 ? O_VST : O_VWT));
#pragma unroll
        for (int nj = 0; nj < 4; ++nj) {
          int c = wn * 64 + nj * 16 + l16, g = c >> 6, d = c & 63;
          f32x4 a = acc[mi][nj];
          store4bf(dstb + ((long)((b * 2 + g) * 64 + d)) * T_ + t, a[0], a[1], a[2], a[3]);
        }
      }
    }
  }

  if constexpr (PH == PH_UQ || PH == PH_UKV) {
    constexpr int K = (PH == PH_UQ) ? 256 : 128;
    const u16* A = (const u16*)(ws + (PH == PH_UQ ? O_CQ : O_CKV));
    __syncthreads();
    if (tid < 128) {
      const float ss = ((const float*)(ws + O_SSQ))[(PH == PH_UQ ? 0 : M_) + m0 + tid];
      rsq[tid] = rsqrtf(ss * (1.f / K) + 1e-6f);
    }
    if constexpr (PH == PH_UQ) {
      gemm_mainloop<0>(acc, smem, A, 256, m0, 256, (const u16*)(ws + O_WT_UQ), n0, nullptr, false, tid);
      const float SC = 0.10206207261596577f * LOG2E_;
#pragma unroll
      for (int mi = 0; mi < MI; ++mi) {
        const int tok = m0 + wm * WR + mi * 16 + l16;
        const float rs = rsq[wm * WR + mi * 16 + l16] * SC;
        const int pos = tok & (T_ - 1);
        const int ct0 = nt * 8 + wn * 4;
#pragma unroll
        for (int njp = 0; njp < 4; njp += 2) {
          f32x4 a = acc[mi][njp], b2 = acc[mi][njp + 1];
          if (((ct0 + njp) % 6) == 4) {
            const float4 cs = *(const float4*)((const float*)(ws + O_ROPE_C) + pos * 16 + lq * 4);
            const float4 sn = *(const float4*)((const float*)(ws + O_ROPE_S) + pos * 16 + lq * 4);
            f32x4 o1, o2;
            o1[0] = a[0] * cs.x - b2[0] * sn.x; o2[0] = b2[0] * cs.x + a[0] * sn.x;
            o1[1] = a[1] * cs.y - b2[1] * sn.y; o2[1] = b2[1] * cs.y + a[1] * sn.y;
            o1[2] = a[2] * cs.z - b2[2] * sn.z; o2[2] = b2[2] * cs.z + a[2] * sn.z;
            o1[3] = a[3] * cs.w - b2[3] * sn.w; o2[3] = b2[3] * cs.w + a[3] * sn.w;
            a = o1; b2 = o2;
          }
          u16* dst = (u16*)(ws + O_QM) + (long)tok * 768 + n0 + wn * 64 + njp * 16 + lq * 4;
          store4bf(dst, a[0] * rs, a[1] * rs, a[2] * rs, a[3] * rs);
          store4bf(dst + 16, b2[0] * rs, b2[1] * rs, b2[2] * rs, b2[3] * rs);
        }
      }
    } else {
      const bool ns = (wn == 1);
      gemm_mainloop<0>(acc, smem, A, 128, m0, 128, (const u16*)(ws + O_WT_UKV), n0, nullptr, ns, tid);
#pragma unroll
      for (int mi = 0; mi < MI; ++mi) {
        if (!ns) {
          const int tok = m0 + wm * WR + mi * 16 + l16;
          const float rs = rsq[wm * WR + mi * 16 + l16];
#pragma unroll
          for (int nj = 0; nj < 4; ++nj) {
            f32x4 a = acc[mi][nj];
            store4bf((u16*)(ws + O_KN) + (long)tok * 512 + nt * 64 + nj * 16 + lq * 4, a[0] * rs, a[1] * rs, a[2] * rs, a[3] * rs);
          }
        } else {
          const int lr = wm * WR + mi * 16 + lq * 4;
          const int tok4 = m0 + lr;
          const int b = tok4 >> 13, t = tok4 & (T_ - 1);
          const float r0 = rsq[lr], r1 = rsq[lr + 1], r2 = rsq[lr + 2], r3 = rsq[lr + 3];
#pragma unroll
          for (int nj = 0; nj < 4; ++nj) {
            int d = nj * 16 + l16;
            f32x4 a = acc[mi][nj];
            store4bf((u16*)(ws + O_VMT) + ((long)((b * 8 + nt) * 64 + d)) * T_ + t, a[0] * r0, a[1] * r1, a[2] * r2, a[3] * r3);
          }
        }
      }
    }
  }

  if constexpr (PH == PH_C1) {
    const u16* A = (const u16*)(ws + (which ? O_VC : O_KC));
    const u16* Bt = (const u16*)(ws + (which ? O_WT_CV1 : O_WT_CK1));
    const float* bias = (const float*)(ws + (which ? O_BIAS1V : O_BIAS1K));
    gemm_mainloop<3>(acc, smem, A, 128, m0, 2048, Bt, n0, nullptr, false, tid);
    u16* hid = (u16*)(ws + O_HID) + (long)which * 8192 * 256;
#pragma unroll
    for (int mi = 0; mi < MI; ++mi) {
      const int row = m0 + wm * WR + mi * 16 + l16;
#pragma unroll
      for (int nj = 0; nj < 4; ++nj) {
        int col = n0 + wn * 64 + nj * 16 + lq * 4;
        const float4 bb = *(const float4*)(bias + col);
        f32x4 a = acc[mi][nj];
        store4bf(hid + (long)row * 256 + col, gelu_tanh_(a[0] + bb.x), gelu_tanh_(a[1] + bb.y), gelu_tanh_(a[2] + bb.z), gelu_tanh_(a[3] + bb.w));
      }
    }
  }

  if constexpr (PH == PH_C2) {
    const u16* A = (const u16*)(ws + O_HID) + (long)which * 8192 * 256;
    const u16* Bt = (const u16*)(ws + (which ? O_WT_CV2 : O_WT_CK2));
    const bool ns = (which == 1);
    gemm_mainloop<0>(acc, smem, A, 256, m0, 256, Bt, 0, nullptr, ns, tid);
    if (wn == 0) {
#pragma unroll
      for (int mi = 0; mi < MI; ++mi) {
        if (!ns) {
          const int row = m0 + wm * WR + mi * 16 + l16;
#pragma unroll
          for (int nj = 0; nj < 4; ++nj) {
            f32x4 a = acc[mi][nj];
            store4bf((u16*)(ws + O_CMPK) + (long)row * 64 + nj * 16 + lq * 4, a[0], a[1], a[2], a[3]);
          }
        } else {
          const int r4 = m0 + wm * WR + mi * 16 + lq * 4;
          const int bg = r4 >> 9, c = r4 & 511;
#pragma unroll
          for (int nj = 0; nj < 4; ++nj) {
            int d = nj * 16 + l16;
            f32x4 a = acc[mi][nj];
            store4bf((u16*)(ws + O_CMPVT) + ((long)(bg * 64 + d)) * 512 + c, a[0], a[1], a[2], a[3]);
          }
        }
      }
    }
  }

  if constexpr (PH == PH_OUT) {
    gemm_mainloop_big<0>(acc, smem, (const u16*)(ws + O_CONCAT), 1024, m0, 1024, (const u16*)(ws + O_WT_OUT), n0, false, tid);
    float* stats = (float*)(ws + O_STATS);
    unsigned char* swv = smem + wave * 18432;
#pragma unroll
    for (int mi = 0; mi < MI; ++mi) {
      const int tok = m0 + wm * WR + mi * 16 + l16;
      float s1 = 0.f, s2 = 0.f;
#pragma unroll
      for (int nj = 0; nj < 4; ++nj) {
        int col = n0 + wn * 64 + nj * 16 + lq * 4;
        const float4 xv = *(const float4*)(P.x + (long)tok * 1024 + col);
        f32x4 a = acc[mi][nj];
        float4 y = make_float4(ALPHA_ * xv.x + a[0], ALPHA_ * xv.y + a[1], ALPHA_ * xv.z + a[2], ALPHA_ * xv.w + a[3]);
        *(uint2*)(swv + (mi * 16 + l16) * 144 + nj * 32 + lq * 8) = make_uint2(pack2(y.x, y.y), pack2(y.z, y.w));
        s1 += y.x + y.y + y.z + y.w;
        s2 += y.x * y.x + y.y * y.y + y.z * y.z + y.w * y.w;
      }
      stat_push(stats, tok, s1, s2, lq);
    }
    asm volatile("s_waitcnt lgkmcnt(0)" ::: "memory");
    {
      u16* yb = (u16*)(ws + O_YB) + (long)(m0 + wm * WR) * 1024 + n0 + wn * 64;
#pragma unroll
      for (int r = 0; r < 16; ++r) {
        const int row = r * 8 + (lane >> 3), ch = lane & 7;
        const uint4 v = *(const uint4*)(swv + row * 144 + ch * 16);
        *(uint4*)(yb + (long)row * 1024 + ch * 8) = v;
      }
    }
  }

  if constexpr (PH == PH_UP) {
    gemm_mainloop_big<FAKE>(acc, smem, (const u16*)(ws + O_YB), 1024, m0, 1024, (const u16*)(ws + O_WT_UP), n0, false, tid);
    if (FAKE != 0 && acc[0][0][0] + acc[3][3][3] + acc[1][2][1] != 123456.75f) return;
    const float* bias = (const float*)(ws + O_BIAS_UP);
    const float* csum = (const float*)(ws + O_CSUM_UP);
    const float* st1 = (const float*)(ws + O_STATS);
    const int cb0 = n0 + wn * 64 + lq * 4;
    const float4 bgv[2] = {*(const float4*)(bias + cb0), *(const float4*)(bias + cb0 + 16)};
    const float4 buv[2] = {*(const float4*)(bias + cb0 + 32), *(const float4*)(bias + cb0 + 48)};
    const float4 cgv[2] = {*(const float4*)(csum + cb0), *(const float4*)(csum + cb0 + 16)};
    const float4 cuv[2] = {*(const float4*)(csum + cb0 + 32), *(const float4*)(csum + cb0 + 48)};
#pragma unroll
    for (int mi = 0; mi < MI; ++mi) {
      const int tok = m0 + wm * WR + mi * 16 + l16;
      const float mean = st1[2 * tok] * (1.f / 1024.f);
      const float rstd = rsqrtf(st1[2 * tok + 1] * (1.f / 1024.f) - mean * mean + 1e-5f);
      unsigned hw[4];
#pragma unroll
      for (int nj = 0; nj < 2; ++nj) {
        const float4 bg = bgv[nj], bu = buv[nj], cg = cgv[nj], cu = cuv[nj];
        f32x4 g = acc[mi][nj], u = acc[mi][nj + 2];
        float h0, h1, h2, h3, v;
        v = rstd * (g[0] - mean * cg.x) + bg.x; h0 = v * sigmoid_(v) * (rstd * (u[0] - mean * cu.x) + bu.x);
        v = rstd * (g[1] - mean * cg.y) + bg.y; h1 = v * sigmoid_(v) * (rstd * (u[1] - mean * cu.y) + bu.y);
        v = rstd * (g[2] - mean * cg.z) + bg.z; h2 = v * sigmoid_(v) * (rstd * (u[2] - mean * cu.z) + bu.z);
        v = rstd * (g[3] - mean * cg.w) + bg.w; h3 = v * sigmoid_(v) * (rstd * (u[3] - mean * cu.w) + bu.w);
        hw[2 * nj] = pack2(h0, h1); hw[2 * nj + 1] = pack2(h2, h3);
      }
      *(uint4*)((u16*)(ws + O_HBUF) + (long)tok * 2816 + nt * 64 + wn * 32 + lq * 8) = make_uint4(hw[0], hw[1], hw[2], hw[3]);
    }
  }

  if constexpr (PH == PH_DOWN) {
    gemm_mainloop_big<0>(acc, smem, (const u16*)(ws + O_HBUF), 2816, m0, 2816, (const u16*)(ws + O_WT_DOWN), n0, false, tid);
    const float* st1 = (const float*)(ws + O_STATS);
    float* st2 = (float*)(ws + O_STATS) + (long)M_ * 2;
    u16* yb = (u16*)(ws + O_YB);
    unsigned char* swv = smem + wave * 18432;
#pragma unroll
    for (int mi = 0; mi < MI; ++mi) {
      const int tok = m0 + wm * WR + mi * 16 + l16;
      const float mean = st1[2 * tok] * (1.f / 1024.f);
      const float rstd = rsqrtf(st1[2 * tok + 1] * (1.f / 1024.f) - mean * mean + 1e-5f);
      float s1 = 0.f, s2 = 0.f;
#pragma unroll
      for (int nj = 0; nj < 4; ++nj) {
        int col = n0 + wn * 64 + nj * 16 + lq * 4;
        const uint2 yq = *(const uint2*)(yb + (long)tok * 1024 + col);
        const float4 yv = make_float4(bflo(yq.x), bfhi(yq.x), bflo(yq.y), bfhi(yq.y));
        const float4 gg = *(const float4*)(P.ln1_g + col);
        const float4 bb = *(const float4*)(P.ln1_b + col);
        f32x4 a = acc[mi][nj];
        float4 y;
        y.x = ALPHA_ * ((yv.x - mean) * rstd * gg.x + bb.x) + a[0];
        y.y = ALPHA_ * ((yv.y - mean) * rstd * gg.y + bb.y) + a[1];
        y.z = ALPHA_ * ((yv.z - mean) * rstd * gg.z + bb.z) + a[2];
        y.w = ALPHA_ * ((yv.w - mean) * rstd * gg.w + bb.w) + a[3];
        *(uint2*)(swv + (mi * 16 + l16) * 144 + nj * 32 + lq * 8) = make_uint2(pack2(y.x, y.y), pack2(y.z, y.w));
        s1 += y.x + y.y + y.z + y.w;
        s2 += y.x * y.x + y.y * y.y + y.z * y.z + y.w * y.w;
      }
      stat_push(st2, tok, s1, s2, lq);
    }
    asm volatile("s_waitcnt lgkmcnt(0)" ::: "memory");
    {
      u16* ydst = (u16*)(ws + O_YB) + (long)(m0 + wm * WR) * 1024 + n0 + wn * 64;
#pragma unroll
      for (int r = 0; r < 16; ++r) {
        const int row = r * 8 + (lane >> 3), ch = lane & 7;
        const uint4 v = *(const uint4*)(swv + row * 144 + ch * 16);
        *(uint4*)(ydst + (long)row * 1024 + ch * 8) = v;
      }
    }
  }

  if constexpr (PH == PH_PLE) {
    const float* st2 = (const float*)(ws + O_STATS) + (long)M_ * 2;
    float* st3 = (float*)(ws + O_STATS) + (long)M_ * 4;
    u16* yb = (u16*)(ws + O_YB);
    unsigned char* swv = smem + wave * 18432;
    gemm_mainloop_big<0>(acc, smem, (const u16*)(ws + O_YB), 1024, m0, 1024, (const u16*)(ws + O_WT_GATE), n0, false, tid);
    const float* bias = (const float*)(ws + O_BIAS_G);
    uint4* gsp4 = (uint4*)(ws + O_HBUF) + (long)(mt * 8 + nt) * 16 * 256;
    const int cg0 = n0 + wn * 64 + lq * 4;
    const float4 gbv[4] = {*(const float4*)(bias + cg0), *(const float4*)(bias + cg0 + 16), *(const float4*)(bias + cg0 + 32), *(const float4*)(bias + cg0 + 48)};
    const float* csg = (const float*)(ws + O_CSUM_G);
    const float4 gcv[4] = {*(const float4*)(csg + cg0), *(const float4*)(csg + cg0 + 16), *(const float4*)(csg + cg0 + 32), *(const float4*)(csg + cg0 + 48)};
#pragma unroll
    for (int mi = 0; mi < MI; ++mi) {
      const int tok = m0 + wm * WR + mi * 16 + l16;
      const float mean_g = st2[2 * tok] * (1.f / 1024.f);
      const float rstd_g = rsqrtf(st2[2 * tok + 1] * (1.f / 1024.f) - mean_g * mean_g + 1e-5f);
      unsigned gw[8];
#pragma unroll
      for (int nj = 0; nj < 4; ++nj) {
        const float4 bb = gbv[nj], cs = gcv[nj];
        f32x4 a = acc[mi][nj];
        gw[2 * nj] = pack2(sigmoid_(rstd_g * (a[0] - mean_g * cs.x) + bb.x), sigmoid_(rstd_g * (a[1] - mean_g * cs.y) + bb.y));
        gw[2 * nj + 1] = pack2(sigmoid_(rstd_g * (a[2] - mean_g * cs.z) + bb.z), sigmoid_(rstd_g * (a[3] - mean_g * cs.w) + bb.w));
      }
      gsp4[(mi * 2 + 0) * 256 + tid] = make_uint4(gw[0], gw[1], gw[2], gw[3]);
      gsp4[(mi * 2 + 1) * 256 + tid] = make_uint4(gw[4], gw[5], gw[6], gw[7]);
    }
    zero_acc<MI>(acc);
    gemm_mainloop_big<0>(acc, smem, (const u16*)(ws + O_PB), 256, m0, 256, (const u16*)(ws + O_WT_PLE), n0, false, tid);
#pragma unroll
    for (int mi = 0; mi < MI; ++mi) {
      const int tok = m0 + wm * WR + mi * 16 + l16;
      const float mean = st2[2 * tok] * (1.f / 1024.f);
      const float rstd = rsqrtf(st2[2 * tok + 1] * (1.f / 1024.f) - mean * mean + 1e-5f);
      float s1 = 0.f, s2 = 0.f;
      const uint4 gqa = gsp4[(mi * 2 + 0) * 256 + tid], gqb = gsp4[(mi * 2 + 1) * 256 + tid];
#pragma unroll
      for (int nj = 0; nj < 4; ++nj) {
        int col = n0 + wn * 64 + nj * 16 + lq * 4;
        const uint2 yq = *(const uint2*)(yb + (long)tok * 1024 + col);
        const float4 yv = make_float4(bflo(yq.x), bfhi(yq.x), bflo(yq.y), bfhi(yq.y));
        const float4 gg = *(const float4*)(P.ln2_g + col);
        const float4 bb = *(const float4*)(P.ln2_b + col);
        f32x4 a = acc[mi][nj];
        const unsigned g01 = (nj == 0) ? gqa.x : (nj == 1) ? gqa.z : (nj == 2) ? gqb.x : gqb.z;
        const unsigned g23 = (nj == 0) ? gqa.y : (nj == 1) ? gqa.w : (nj == 2) ? gqb.y : gqb.w;
        float4 y;
        y.x = ALPHA_ * ((yv.x - mean) * rstd * gg.x + bb.x) + bflo(g01) * a[0];
        y.y = ALPHA_ * ((yv.y - mean) * rstd * gg.y + bb.y) + bfhi(g01) * a[1];
        y.z = ALPHA_ * ((yv.z - mean) * rstd * gg.z + bb.z) + bflo(g23) * a[2];
        y.w = ALPHA_ * ((yv.w - mean) * rstd * gg.w + bb.w) + bfhi(g23) * a[3];
        *(uint2*)(swv + (mi * 16 + l16) * 144 + nj * 32 + lq * 8) = make_uint2(pack2(y.x, y.y), pack2(y.z, y.w));
        s1 += y.x + y.y + y.z + y.w;
        s2 += y.x * y.x + y.y * y.y + y.z * y.z + y.w * y.w;
      }
      stat_push(st3, tok, s1, s2, lq);
    }
    asm volatile("s_waitcnt lgkmcnt(0)" ::: "memory");
    {
      u16* ydst = (u16*)(ws + O_CONCAT) + (long)(m0 + wm * WR) * 1024 + n0 + wn * 64;
#pragma unroll
      for (int r = 0; r < 16; ++r) {
        const int row = r * 8 + (lane >> 3), ch = lane & 7;
        const uint4 v = *(const uint4*)(swv + row * 144 + ch * 16);
        *(uint4*)(ydst + (long)row * 1024 + ch * 8) = v;
      }
    }
  }
}

constexpr int LDS_TOTAL = 4 * 18432 + 512;
constexpr int CTL_OFF = 53248;
constexpr int SEL_OFF = CTL_OFF + 1024;
constexpr int IMP_OFF = 35840;
static_assert(IMP_OFF + 32 * 130 * 4 <= CTL_OFF, "lds");
static_assert(SEL_OFF + 512 <= LDS_TOTAL, "lds");

struct AttnSrc { const u16* K; long ldk; const u16* K2; const u16* V; long ldv; };
enum { AM_MLA = 0, AM_WIN = 1, AM_SLC = 2, AM_CMP = 3 };

template <int MODE, int DQ, bool DO_PV, bool FIXED_M, bool DO_IMP, bool USE_LIST, int FK = 0>
DI void attn_loop(unsigned char* smem, const AttnSrc src, int ntiles, int tile_lo, const int* tlist,
                  const bf16x8 (&qf)[DQ / 16], float& m, float& l, f32x16 (&O)[2], int t, float slope2,
                  unsigned sw0, unsigned sw1, unsigned sw2, unsigned sw3, float inv_l, unsigned* imp, int tid_in) {
  int tid = tid_in;
  asm volatile("" : "+v"(tid));
  constexpr int KST = DQ + 8;
  constexpr int KCH = DQ / 8;
  constexpr int NKL = KCH * 64 / 256;
  constexpr int KBYTES = 64 * KST * 2;
  constexpr int VST = 68;
  constexpr int VBYTES = 64 * VST * 2;
  const int lane = tid & 63, l32 = lane & 31, h = lane >> 5;
  u16* sK0 = (u16*)smem;
  u16* sV0 = (u16*)(smem + 2 * KBYTES);
  uint4 rk0, rk1, rk2, rv0, rv1;
  const int kr0 = tid / KCH, kc0 = tid % KCH;
  const int kr1 = (tid + 256) / KCH, kc1 = (tid + 256) % KCH;
  const int kr2 = (tid + 512) / KCH, kc2 = (tid + 512) % KCH;
  const int vr0 = tid >> 3, vc0 = tid & 7;
#define A_KLD(dst_, row_, ch_, tile_) { \
    if constexpr (MODE == AM_MLA) { \
      if ((ch_) < 8) dst_ = *(const uint4*)(src.K + ((long)(tile_) * 64 + (row_)) * src.ldk + (ch_) * 8); \
      else dst_ = *(const uint4*)(src.K2 + ((long)(tile_) * 64 + (row_)) * 32 + ((ch_) - 8) * 8); \
    } else dst_ = *(const uint4*)(src.K + ((long)(tile_) * 64 + (row_)) * src.ldk + (ch_) * 8); }
#define A_GLOAD(tile_) { \
    A_KLD(rk0, kr0, kc0, tile_) A_KLD(rk1, kr1, kc1, tile_) \
    if constexpr (NKL == 3) A_KLD(rk2, kr2, kc2, tile_) \
    if constexpr (DO_PV) { \
      rv0 = *(const uint4*)(src.V + (long)vr0 * src.ldv + (long)(tile_) * 64 + vc0 * 8); \
      rv1 = *(const uint4*)(src.V + (long)(vr0 + 32) * src.ldv + (long)(tile_) * 64 + vc0 * 8); } }
#define A_LSTORE(buf_) { \
    u16* sK_ = sK0 + (buf_) * (KBYTES / 2); u16* sV_ = sV0 + (buf_) * (VBYTES / 2); \
    *(uint4*)(sK_ + kr0 * KST + kc0 * 8) = rk0; *(uint4*)(sK_ + kr1 * KST + kc1 * 8) = rk1; \
    if constexpr (NKL == 3) *(uint4*)(sK_ + kr2 * KST + kc2 * 8) = rk2; \
    if constexpr (DO_PV) { \
      *(uint2*)(sV_ + vr0 * VST + vc0 * 8) = make_uint2(rv0.x, rv0.y); *(uint2*)(sV_ + vr0 * VST + vc0 * 8 + 4) = make_uint2(rv0.z, rv0.w); \
      *(uint2*)(sV_ + (vr0 + 32) * VST + vc0 * 8) = make_uint2(rv1.x, rv1.y); *(uint2*)(sV_ + (vr0 + 32) * VST + vc0 * 8 + 4) = make_uint2(rv1.z, rv1.w); } }
  __syncthreads();
  if (ntiles > 0) { const int tf = USE_LIST ? tlist[0] : tile_lo; A_GLOAD(tf) A_LSTORE(0) }
  __syncthreads();
  for (int it = 0; it < ntiles; ++it) {
    const int tile = USE_LIST ? tlist[it] : tile_lo + it;
    if (it + 1 < ntiles && FK != 1) { const int tn = USE_LIST ? tlist[it + 1] : tile_lo + it + 1; A_GLOAD(tn) }
    __builtin_amdgcn_sched_barrier(0);
    const u16* sK = sK0 + (it & 1) * (KBYTES / 2);
    const u16* sV = sV0 + (it & 1) * (VBYTES / 2);
    f32x16 S[2];
#pragma unroll
    for (int kb = 0; kb < 2; ++kb) {
#pragma unroll
      for (int i = 0; i < 16; ++i) S[kb][i] = 0.f;
#pragma unroll
      for (int s = 0; s < DQ / 16; ++s) {
        bf16x8 kf = *(const bf16x8*)(sK + (kb * 32 + l32) * KST + s * 16 + h * 8);
        S[kb] = MFMA32(kf, qf[s], S[kb]);
      }
    }
    float c0 = 0.f;
    {
      constexpr int MUL = (MODE == AM_CMP) ? 16 : 1;
      int d0;
      if constexpr (MODE == AM_CMP) d0 = t - 31 - 16 * (tile * 64 + 4 * h);
      else d0 = t - tile * 64 - 4 * h;
      bool need = true;
      if constexpr (MODE == AM_MLA) need = (tile * 64 + 63 > t - l32);
      bool selbit = true;
      if constexpr (MODE == AM_SLC) {
        const int w = tile >> 5;
        const unsigned swd = (w == 0) ? sw0 : (w == 1) ? sw1 : (w == 2) ? sw2 : sw3;
        selbit = (swd >> (tile & 31)) & 1u;
      }
      bool full = false;
      if constexpr (MODE != AM_MLA) {
        const int tw = t - l32;
        if constexpr (MODE == AM_CMP) full = ((tile * 64 + 63) * 16 + 31 <= tw);
        if constexpr (MODE == AM_WIN) full = (tile * 64 + 63 <= tw) && (tw + 31 - tile * 64 < 512);
        if constexpr (MODE == AM_SLC) full = (tile * 64 + 63 <= tw) && __all(selbit);
      }
      const float fd0 = (float)d0;
      if constexpr (MODE != AM_MLA) {
#pragma unroll
        for (int kb = 0; kb < 2; ++kb)
#pragma unroll
          for (int i = 0; i < 16; ++i) {
            const float ci = (float)(MUL * ((i & 3) + 8 * (i >> 2) + 32 * kb));
            S[kb][i] = fmaf(slope2, ci, S[kb][i]);
          }
      }
      c0 = (MODE != AM_MLA) ? -slope2 * fd0 : 0.f;
      if (need && !full) {
#pragma unroll
        for (int kb = 0; kb < 2; ++kb)
#pragma unroll
          for (int i = 0; i < 16; ++i) {
            const float ci = (float)(MUL * ((i & 3) + 8 * (i >> 2) + 32 * kb));
            const float dist = fd0 - ci;
            bool valid = dist >= 0.f;
            if constexpr (MODE == AM_WIN) valid = valid && (dist < 512.f);
            if constexpr (MODE == AM_SLC) valid = valid && selbit;
            S[kb][i] = valid ? S[kb][i] : -INFINITY;
          }
      }
    }
    if constexpr (FK != 2) {
    if constexpr (!FIXED_M) {
      float tmax = -INFINITY;
#pragma unroll
      for (int kb = 0; kb < 2; ++kb)
#pragma unroll
        for (int i = 0; i < 16; ++i) tmax = fmaxf(tmax, S[kb][i]);
      tmax += c0;
      tmax = fmaxf(tmax, __shfl_xor(tmax, 32));
      const bool need = tmax > m + 8.f;
      if (__any(need)) {
        const float mnew = need ? tmax : m;
        const float alpha = ex2(m - mnew);
        m = mnew;
        l *= alpha;
        if constexpr (DO_PV) {
#pragma unroll
          for (int db = 0; db < 2; ++db)
#pragma unroll
            for (int i = 0; i < 16; ++i) O[db][i] *= alpha;
        }
      }
    }
    const float mx = m - c0;
    {
      float ps = 0.f;
#pragma unroll
      for (int kb = 0; kb < 2; ++kb)
#pragma unroll
        for (int i = 0; i < 16; ++i) { float p = ex2(S[kb][i] - mx); S[kb][i] = p; ps += p; }
      l += ps;
    }
    }
    if constexpr (DO_IMP) {
#pragma unroll
      for (int kb = 0; kb < 2; ++kb)
#pragma unroll
        for (int a = 0; a < 4; ++a) {
          const float p0 = S[kb][4 * a] * inv_l, p1 = S[kb][4 * a + 1] * inv_l, p2 = S[kb][4 * a + 2] * inv_l, p3 = S[kb][4 * a + 3] * inv_l;
          const float mainv = 2.f * (p0 + p1 + p2) + p3;
          const int n = tile * 16 + kb * 8 + 2 * a + h;
          atomicAdd(imp + l32 * 130 + n, (unsigned)(mainv * 268435456.f));
          atomicAdd(imp + l32 * 130 + n + 1, (unsigned)(p3 * 268435456.f));
        }
    }
    if (it + 1 < ntiles) { A_LSTORE((it + 1) & 1) }
    if constexpr (DO_PV) {
#pragma unroll
      for (int sp = 0; sp < 4; ++sp) {
        const int kb = sp >> 1, hf = sp & 1;
        unsigned w0 = pack2(S[kb][8 * hf + 0], S[kb][8 * hf + 1]);
        unsigned w1 = pack2(S[kb][8 * hf + 2], S[kb][8 * hf + 3]);
        unsigned w2 = pack2(S[kb][8 * hf + 4], S[kb][8 * hf + 5]);
        unsigned w3 = pack2(S[kb][8 * hf + 6], S[kb][8 * hf + 7]);
        uint4 pw = make_uint4(w0, w1, w2, w3);
        bf16x8 pf = __builtin_bit_cast(bf16x8, pw);
#pragma unroll
        for (int db = 0; db < 2; ++db) {
          const u16* vp = sV + (db * 32 + l32) * VST + 16 * sp + 4 * h;
          s16x4 lo = *(const s16x4*)vp;
          s16x4 hi = *(const s16x4*)(vp + 8);
          bf16x8 vf = __builtin_shufflevector(lo, hi, 0, 1, 2, 3, 4, 5, 6, 7);
          O[db] = MFMA32(vf, pf, O[db]);
        }
      }
    }
    __syncthreads();
  }
  l += __shfl_xor(l, 32);
#undef A_KLD
#undef A_GLOAD
#undef A_LSTORE
}

DI void zero_o(f32x16 (&O)[2]) {
#pragma unroll
  for (int db = 0; db < 2; ++db)
#pragma unroll
    for (int i = 0; i < 16; ++i) O[db][i] = 0.f;
}

template <int FK = 0>
DI void mla_item(const Params& P, unsigned char* smem, int b, int hh, int qt, int tid_in) {
  int tid = tid_in;
  asm volatile("" : "+v"(tid));
  unsigned char* ws = P.ws;
  const int lane = tid & 63, w = tid >> 6, l32 = lane & 31, h = lane >> 5;
  const int t = qt * 128 + w * 32 + l32;
  const long tok = (long)b * T_ + t;
  bf16x8 qf[6];
#pragma unroll
  for (int s = 0; s < 6; ++s) qf[s] = *(const bf16x8*)((const u16*)(ws + O_QM) + tok * 768 + hh * 96 + s * 16 + h * 8);
  float m = -1e30f, l = 0.f;
  f32x16 O[2];
  zero_o(O);
  AttnSrc src;
  src.K = (const u16*)(ws + O_KN) + (long)b * T_ * 512 + hh * 64; src.ldk = 512;
  src.K2 = (const u16*)(ws + O_KPE) + (long)b * T_ * 32;
  src.V = (const u16*)(ws + O_VMT) + ((long)(b * 8 + hh) * 64) * T_; src.ldv = T_;
  attn_loop<AM_MLA, 96, true, false, false, false, FK>(smem, src, 2 * qt + 2, 0, nullptr, qf, m, l, O, t, 0.f, 0, 0, 0, 0, 0.f, nullptr, tid);
  if (FK != 0 && O[0][0] + O[1][5] + l != 123456.75f) return;
  const float lt = l;
  const float inv = lt > 0.f ? 1.f / lt : 0.f;
  u16* dst = (u16*)(ws + O_CONCAT) + tok * 1024 + 512 + hh * 64;
#pragma unroll
  for (int db = 0; db < 2; ++db)
#pragma unroll
    for (int a = 0; a < 4; ++a)
      store4bf(dst + db * 32 + 8 * a + 4 * h, O[db][4 * a] * inv, O[db][4 * a + 1] * inv, O[db][4 * a + 2] * inv, O[db][4 * a + 3] * inv);
}

DI u64 mk_key(int n, unsigned v, int cur) {
  if (n > cur) return 0ull;
  if (n == 0 || n == cur || n == cur - 1) v = 0xFFFFFFFFu;
  return ((u64)v << 8) | (u64)(128 - n);
}

DI void nsa_item(const Params& P, unsigned char* smem, int b, int g, int tt, int tid_in) {
  int tid = tid_in;
  asm volatile("" : "+v"(tid));
  unsigned char* ws = P.ws;
  const int lane = tid & 63, w = tid >> 6, l32 = lane & 31, h = lane >> 5;
  const int t0 = tt * 32;
  const int t = t0 + l32;
  const long tok = (long)b * T_ + t;
  const int head8 = g * 4 + w;
  int* ctl = (int*)(smem + CTL_OFF);
  unsigned* sel = (unsigned*)(smem + SEL_OFF);
  unsigned* imp = (unsigned*)(smem + IMP_OFF);
  bf16x8 qf[4];
#pragma unroll
  for (int s = 0; s < 4; ++s) qf[s] = *(const bf16x8*)((const u16*)(ws + O_QN) + tok * 512 + head8 * 64 + s * 16 + h * 8);
  const float* gp = (const float*)(ws + O_GATES) + tok * 24 + head8 * 3;
  const float g0 = gp[0], g1 = gp[1], g2 = gp[2];
  const float slope2 = LOG2E_ * exp2f(-(float)(head8 + 1));
  __syncthreads();
  for (int i = tid; i < 32 * 130; i += 256) imp[i] = 0u;
  if (tid < 4) ctl[4 + tid] = 0;
  f32x16 O[2];
  float m = -1e30f, l = 0.f;
  float* osp = (float*)(ws + O_Y2) + (long)blockIdx.x * 16384 + tid;
  AttnSrc sc;
  sc.K = (const u16*)(ws + O_CMPK) + ((long)(b * 2 + g) * 512) * 64; sc.ldk = 64; sc.K2 = nullptr;
  sc.V = (const u16*)(ws + O_CMPVT) + ((long)(b * 2 + g) * 64) * 512; sc.ldv = 512;
  const int ntc = (t0 >> 10) + 1;
  attn_loop<AM_CMP, 64, false, false, false, false>(smem, sc, ntc, 0, nullptr, qf, m, l, O, t, slope2, 0, 0, 0, 0, 0.f, nullptr, tid);
  {
    const float lt = l;
    const float inv_l = lt > 0.f ? 1.f / lt : 0.f;
    zero_o(O);
    float l2 = 0.f;
    attn_loop<AM_CMP, 64, true, true, true, false>(smem, sc, ntc, 0, nullptr, qf, m, l2, O, t, slope2, 0, 0, 0, 0, inv_l, imp, tid);
    const float sc0 = g0 * inv_l;
#pragma unroll
    for (int db = 0; db < 2; ++db)
#pragma unroll
      for (int i = 0; i < 16; ++i) osp[(db * 16 + i) * 256] = O[db][i] * sc0;
  }
  for (int tk = 0; tk < 8; ++tk) {
    const int token = w * 8 + tk;
    const int cur = (t0 + token) >> 6;
    const u64 k0 = mk_key(lane, imp[token * 130 + lane], cur);
    const u64 k1 = mk_key(lane + 64, imp[token * 130 + lane + 64], cur);
    u64 thr = 0ull;
    for (int bit = 39; bit >= 0; --bit) {
      const u64 cand = thr | (1ull << bit);
      const int c = __popcll(__ballot(k0 >= cand)) + __popcll(__ballot(k1 >= cand));
      if (c >= 16) thr = cand;
    }
    const u64 m0 = __ballot(k0 >= thr && k0 > 0ull);
    const u64 m1 = __ballot(k1 >= thr && k1 > 0ull);
    if (lane == 0) {
      sel[token * 4 + 0] = (unsigned)m0; sel[token * 4 + 1] = (unsigned)(m0 >> 32);
      sel[token * 4 + 2] = (unsigned)m1; sel[token * 4 + 3] = (unsigned)(m1 >> 32);
      atomicOr((unsigned*)&ctl[4], (unsigned)m0); atomicOr((unsigned*)&ctl[5], (unsigned)(m0 >> 32));
      atomicOr((unsigned*)&ctl[6], (unsigned)m1); atomicOr((unsigned*)&ctl[7], (unsigned)(m1 >> 32));
    }
  }
  __syncthreads();
  if (tid == 0) {
    int c = 0;
    for (int q = 0; q < 4; ++q) {
      unsigned u = (unsigned)ctl[4 + q];
      while (u) { int bp = __ffs(u) - 1; ctl[8 + c] = q * 32 + bp; ++c; u &= u - 1; }
    }
    ctl[1] = c;
  }
  __syncthreads();
  const int nsl = ctl[1];
  const unsigned sw0 = sel[l32 * 4 + 0], sw1 = sel[l32 * 4 + 1], sw2 = sel[l32 * 4 + 2], sw3 = sel[l32 * 4 + 3];
  {
    AttnSrc ss;
    ss.K = (const u16*)(ws + O_KS) + (long)b * T_ * 128 + g * 64; ss.ldk = 128; ss.K2 = nullptr;
    ss.V = (const u16*)(ws + O_VST) + ((long)(b * 2 + g) * 64) * T_; ss.ldv = T_;
    m = -1e30f; l = 0.f; zero_o(O);
    attn_loop<AM_SLC, 64, true, false, false, true>(smem, ss, nsl, 0, ctl + 8, qf, m, l, O, t, slope2, sw0, sw1, sw2, sw3, 0.f, nullptr, tid);
    const float lt = l;
    const float sc1 = lt > 0.f ? g1 / lt : 0.f;
#pragma unroll
    for (int db = 0; db < 2; ++db)
#pragma unroll
      for (int i = 0; i < 16; ++i) osp[8192 + (db * 16 + i) * 256] = O[db][i] * sc1;
  }
  {
    AttnSrc sw;
    sw.K = (const u16*)(ws + O_KW) + (long)b * T_ * 128 + g * 64; sw.ldk = 128; sw.K2 = nullptr;
    sw.V = (const u16*)(ws + O_VWT) + ((long)(b * 2 + g) * 64) * T_; sw.ldv = T_;
    const int lo = (t0 > 511 ? (t0 - 511) : 0) >> 6, hi = (t0 + 31) >> 6;
    m = -1e30f; l = 0.f; zero_o(O);
    attn_loop<AM_WIN, 64, true, false, false, false>(smem, sw, hi - lo + 1, lo, nullptr, qf, m, l, O, t, slope2, 0, 0, 0, 0, 0.f, nullptr, tid);
    const float lt = l;
    const float sc2 = lt > 0.f ? g2 / lt : 0.f;
#pragma unroll
    for (int db = 0; db < 2; ++db)
#pragma unroll
      for (int i = 0; i < 16; ++i) O[db][i] = O[db][i] * sc2 + osp[(db * 16 + i) * 256] + osp[8192 + (db * 16 + i) * 256];
  }
  u16* dst = (u16*)(ws + O_CONCAT) + tok * 1024 + head8 * 64;
#pragma unroll
  for (int db = 0; db < 2; ++db)
#pragma unroll
    for (int a = 0; a < 4; ++a)
      store4bf(dst + db * 32 + 8 * a + 4 * h, O[db][4 * a], O[db][4 * a + 1], O[db][4 * a + 2], O[db][4 * a + 3]);
}

DI void ln_apply_pass(const u16* src, const float* st, u16* dst, int tid, int nb) {
  const int lane = tid & 63;
  for (int row = blockIdx.x * 4 + (tid >> 6); row < M_; row += nb * 4) {
    const float mean = st[2 * row] * (1.f / 1024.f);
    const float rstd = rsqrtf(st[2 * row + 1] * (1.f / 1024.f) - mean * mean + 1e-5f);
    const u16* o = src + (long)row * 1024;
#pragma unroll
    for (int i = 0; i < 2; ++i) {
      const int c = lane * 8 + 512 * i;
      const uint4 v = *(const uint4*)(o + c);
      *(uint4*)(dst + (long)row * 1024 + c) = make_uint4(pack2((bflo(v.x) - mean) * rstd, (bfhi(v.x) - mean) * rstd), pack2((bflo(v.y) - mean) * rstd, (bfhi(v.y) - mean) * rstd),
                                                        pack2((bflo(v.z) - mean) * rstd, (bfhi(v.z) - mean) * rstd), pack2((bflo(v.w) - mean) * rstd, (bfhi(v.w) - mean) * rstd));
    }
  }
}

#ifndef REP
#define REP 0
#endif
#ifndef FAKEV
#define FAKEV 0
#endif
DI void tile_map(int i, int NT, int& mt, int& nt, int mpx = 64) {
  const int xcd = i & 7, j = i >> 3;
  const int ms = j / (8 * NT), r = j - ms * 8 * NT;
  nt = r >> 3;
  mt = xcd * mpx + ms * 8 + (r & 7);
}

template <int PMODE = 0, int FK = 0>
DI void phase4(const Params& P, unsigned char* smem, int tid, int cbase) {
  {
    int* ctr = (int*)(P.ws + O_CTR) + cbase;
    int* ctl = (int*)(smem + CTL_OFF);
    const int xcd = blockIdx.x & 7;
    bool mla_done = false;
    for (;;) {
      __syncthreads();
      if (tid == 0) {
        int it = -1;
        if (!mla_done) { int k = atomicAdd(ctr + xcd, 1); if (k < 512) it = k; }
        if (it < 0) { if (PMODE == 1) it = 8192; else { int j = atomicAdd(ctr + 8, 1); it = (j < 4096) ? 4096 + j : 8192; } }
        ctl[0] = it;
      }
      __syncthreads();
      const int item = ctl[0];
      if (item >= 8192) break;
#ifndef SKIP_MLA
      if (item < 4096) {
        const int qt = 63 - (item & 63), bh = (item >> 6) * 8 + xcd;
        mla_item<FK>(P, smem, bh >> 3, bh & 7, qt, tid);
      }
#endif
      if (item >= 4096) mla_done = true;
#ifndef SKIP_NSA
      if (item >= 4096) {
        const int j = item - 4096;
        const int tt = 255 - (j >> 4), bg = j & 15;
        nsa_item(P, smem, bg >> 1, bg & 1, tt, tid);
      }
#endif
    }
  }
}

#define XB_XCNT(j)  (64 * (j))
#define XB_XSUB(j)  (1024 + 64 * (j))
#define XB_XGEN(j)  (2048 + 64 * (j))
#define XB_TOP      3072
#define XB_TOPGEN   3136
#define XB_WORDS    3200
DI unsigned xb_ld(unsigned* p) { return __hip_atomic_load(p, __ATOMIC_RELAXED, __HIP_MEMORY_SCOPE_AGENT); }
DI unsigned xb_add(unsigned* p, unsigned v) { return __hip_atomic_fetch_add(p, v, __ATOMIC_RELAXED, __HIP_MEMORY_SCOPE_AGENT); }
DI unsigned xb_xcc_id() { return (unsigned)__builtin_amdgcn_s_getreg((3 << 11) | 20) & 0xFu; }
struct XBar { unsigned* bar; unsigned x, nloc, nx; };
DI void gsync(const XBar& b, int tid) {
  asm volatile("s_waitcnt vmcnt(0)" ::: "memory");
  __syncthreads();
  if (tid == 0) {
    unsigned* bar = b.bar;
    __builtin_amdgcn_s_waitcnt(0);
    const unsigned old = xb_add(&bar[XB_XSUB(b.x)], 1u);
    const unsigned gen = old / b.nloc;
    if (old + 1u == (gen + 1u) * b.nloc) {
      __builtin_amdgcn_fence(__ATOMIC_RELEASE, "agent");
      asm volatile("s_waitcnt vmcnt(0)" ::: "memory");
      const unsigned og = xb_add(&bar[XB_TOP], 1u);
      const unsigned tg = og / b.nx;
      if (og + 1u == (tg + 1u) * b.nx) xb_add(&bar[XB_TOPGEN], 1u);
      else while (xb_ld(&bar[XB_TOPGEN]) == tg) __builtin_amdgcn_s_sleep(1);
      __builtin_amdgcn_fence(__ATOMIC_ACQUIRE, "agent");
      xb_add(&bar[XB_XGEN(b.x)], 1u);
      asm volatile("s_waitcnt vmcnt(0)" ::: "memory");
    } else {
      while (xb_ld(&bar[XB_XGEN(b.x)]) == gen) __builtin_amdgcn_s_sleep(1);
      __builtin_amdgcn_fence(__ATOMIC_ACQUIRE, "agent");
      asm volatile("s_waitcnt vmcnt(0)" ::: "memory");
    }
  }
  __syncthreads();
}

__global__ void __launch_bounds__(256, 2) fwd_megakernel(Params P) {
  cg::grid_group grid = cg::this_grid();
  extern __shared__ __attribute__((aligned(16))) unsigned char smem[];
  const int tid = threadIdx.x;
  const int nb = gridDim.x;
  XBar xb; xb.bar = (unsigned*)(P.ws + O_BAR); xb.x = xb_xcc_id(); xb.nloc = 1u; xb.nx = 1u;
  if (tid == 0) (void)xb_add(&xb.bar[XB_XCNT(xb.x)], 1u);

#ifndef SKIP_P0
  phase0(P, smem, tid);
#endif
  if (P.ws == nullptr) grid.sync();
  if (tid == 0) {
    unsigned mine = 0u, cnt = 0u, sum = 0u;
    for (;;) {
      mine = 0u; cnt = 0u; sum = 0u;
#pragma unroll
      for (unsigned j = 0; j < 16; ++j) { const unsigned c = xb_ld(&xb.bar[XB_XCNT(j)]); sum += c; cnt += (c > 0u) ? 1u : 0u; mine = (j == xb.x) ? c : mine; }
      if (sum == gridDim.x) break;
      __builtin_amdgcn_s_sleep(1);
    }
    xb.nloc = mine > 0u ? mine : 1u; xb.nx = cnt > 0u ? cnt : 1u;
  }
  gsync(xb, tid);
#ifndef SKIP_P1
  for (int i = blockIdx.x; i < 512 * 14; i += nb) { int mt, nt; tile_map(i, 14, mt, nt); gemm_tile<PH_IN>(P, smem, mt, nt, 0, tid); }
#if REP == 11
  for (int q = 0; q < 20; ++q) gsync(xb, tid);
#endif
#if REP == 1
  gsync(xb, tid);
  for (int i = blockIdx.x; i < 512 * 14; i += nb) { int mt, nt; tile_map(i, 14, mt, nt); gemm_tile<PH_IN>(P, smem, mt, nt, 0, tid); }
#endif
#endif
  gsync(xb, tid);
#ifndef SKIP_P2
  for (int i = blockIdx.x; i < 256 + 3072 + 4096; i += nb) {
    if (i < 256) gemm_tile<PH_C1>(P, smem, (i >> 1) & 63, i & 1, i >> 7, tid);
    else if (i < 256 + 3072) { int mt, nt; tile_map(i - 256, 6, mt, nt); gemm_tile<PH_UQ>(P, smem, mt, nt, 0, tid); }
    else { int mt, nt; tile_map(i - 256 - 3072, 8, mt, nt); gemm_tile<PH_UKV>(P, smem, mt, nt, 0, tid); }
  }
#endif
#if REP == 2
  gsync(xb, tid);
  for (int i = blockIdx.x; i < 256 + 3072 + 4096; i += nb) {
    if (i < 256) gemm_tile<PH_C1>(P, smem, (i >> 1) & 63, i & 1, i >> 7, tid);
    else if (i < 256 + 3072) { int mt, nt; tile_map(i - 256, 6, mt, nt); gemm_tile<PH_UQ>(P, smem, mt, nt, 0, tid); }
    else { int mt, nt; tile_map(i - 256 - 3072, 8, mt, nt); gemm_tile<PH_UKV>(P, smem, mt, nt, 0, tid); }
  }
#endif
  gsync(xb, tid);
#ifndef SKIP_P3
  for (int i = blockIdx.x; i < 128; i += nb) gemm_tile<PH_C2>(P, smem, i & 63, 0, i >> 6, tid);
#endif
  gsync(xb, tid);
  phase4(P, smem, tid, 0);
#if REP == 4
  gsync(xb, tid);
  phase4<0, 0>(P, smem, tid, 16);
#endif
#if REP == 41
  gsync(xb, tid);
  phase4<1, FAKEV>(P, smem, tid, 16);
#endif
  gsync(xb, tid);
  {
    u16* pb = (u16*)(P.ws + O_PB);
    for (long i = (long)blockIdx.x * 256 + tid; i < (long)M_ * 256 / 8; i += (long)nb * 256) {
      const float4 a = *(const float4*)(P.p + i * 8), b = *(const float4*)(P.p + i * 8 + 4);
      *(uint4*)(pb + i * 8) = make_uint4(pack2(a.x, a.y), pack2(a.z, a.w), pack2(b.x, b.y), pack2(b.z, b.w));
    }
  }
#ifndef SKIP_P5
  for (int i = blockIdx.x; i < 256 * 8; i += nb) { int mt, nt; tile_map(i, 8, mt, nt, 32); gemm_tile<PH_OUT>(P, smem, mt, nt, 0, tid); }
#endif
  gsync(xb, tid);
#ifndef SKIP_P6
  for (int i = blockIdx.x; i < 256 * 44; i += nb) { int mt, nt; tile_map(i, 44, mt, nt, 32); gemm_tile<PH_UP>(P, smem, mt, nt, 0, tid); }
#if REP == 6
  gsync(xb, tid);
  for (int i = blockIdx.x; i < 256 * 44; i += nb) { int mt, nt; tile_map(i, 44, mt, nt, 32); gemm_tile<PH_UP, FAKEV>(P, smem, mt, nt, 0, tid); }
#endif
#endif
  gsync(xb, tid);
#ifndef SKIP_P7
  for (int i = blockIdx.x; i < 256 * 8; i += nb) { int mt, nt; tile_map(i, 8, mt, nt, 32); gemm_tile<PH_DOWN>(P, smem, mt, nt, 0, tid); }
#endif
  gsync(xb, tid);
#ifndef SKIP_P8
  for (int i = blockIdx.x; i < 256 * 8; i += nb) { int mt, nt; tile_map(i, 8, mt, nt, 32); gemm_tile<PH_PLE>(P, smem, mt, nt, 0, tid); }
#endif
  gsync(xb, tid);
  {
    const float* st3 = (const float*)(P.ws + O_STATS) + (long)M_ * 4;
    const int lane = tid & 63;
    for (int row = blockIdx.x * 4 + (tid >> 6); row < M_; row += nb * 4) {
      const float mean = st3[2 * row] * (1.f / 1024.f);
      const float rstd = rsqrtf(st3[2 * row + 1] * (1.f / 1024.f) - mean * mean + 1e-5f);
      float* o = P.out + (long)row * 1024;
      const u16* yb = (const u16*)(P.ws + O_CONCAT) + (long)row * 1024;
#pragma unroll
      for (int i = 0; i < 4; ++i) {
        const int c = lane * 4 + 256 * i;
        const uint2 yq = *(const uint2*)(yb + c);
        float4 v = make_float4(bflo(yq.x), bfhi(yq.x), bflo(yq.y), bfhi(yq.y));
        const float4 gg = *(const float4*)(P.ln3_g + c);
        const float4 bb = *(const float4*)(P.ln3_b + c);
        v.x = (v.x - mean) * rstd * gg.x + bb.x;
        v.y = (v.y - mean) * rstd * gg.y + bb.y;
        v.z = (v.z - mean) * rstd * gg.z + bb.z;
        v.w = (v.w - mean) * rstd * gg.w + bb.w;
        *(float4*)(o + c) = v;
      }
    }
  }
}

extern "C" void kernel_launch(void* const* d_in, const int* in_sizes, int n_in,
                              void* d_out, int out_size, void* d_ws, size_t ws_size,
                              hipStream_t stream) {
  static int grid_blocks = 0;
  if (!grid_blocks) {
    int dev = 0, cus = 0, per_cu = 0;
    (void)hipGetDevice(&dev);
    (void)hipDeviceGetAttribute(&cus, hipDeviceAttributeMultiprocessorCount, dev);
    (void)hipFuncSetAttribute((const void*)fwd_megakernel, hipFuncAttributeMaxDynamicSharedMemorySize, LDS_TOTAL);
    (void)hipOccupancyMaxActiveBlocksPerMultiprocessor(&per_cu, fwd_megakernel, 256, LDS_TOTAL);
    if (per_cu < 1) per_cu = 1;
    if (per_cu > 2) per_cu = 2;
    grid_blocks = cus * per_cu;
    fprintf(stderr, "grid_blocks=%d (cus=%d per_cu=%d) ws_need=%zu ws_size=%zu\n", grid_blocks, cus, per_cu, (size_t)WS_NEED, ws_size);
  }
  if (ws_size < WS_NEED || n_in < 24) { fprintf(stderr, "kernel_launch: workspace too small or bad inputs\n"); return; }
  (void)hipMemsetAsync((unsigned char*)d_ws + O_BAR, 0, 16384, stream);
  Params p{};
  const float** pp = (const float**)&p;
  for (int i = 0; i < 24; ++i) pp[i] = (const float*)d_in[i];
  p.out = (float*)d_out;
  p.ws = (unsigned char*)d_ws;
  void* args[] = {&p};
  hipError_t e = hipLaunchCooperativeKernel((void*)fwd_megakernel, dim3(grid_blocks), dim3(256), args, LDS_TOTAL, stream);
  if (e != hipSuccess) fprintf(stderr, "cooperative launch failed: %s (grid %d)\n", hipGetErrorString(e), grid_blocks);
}
```

```cpp
#include <hip/hip_runtime.h>
#include <hip/hip_cooperative_groups.h>
#include <cstdio>
#include <cstdint>
namespace cg = cooperative_groups;

#define DI __device__ __forceinline__
typedef unsigned short u16;
typedef unsigned long long u64;
typedef __attribute__((ext_vector_type(8))) short bf16x8;
typedef __attribute__((ext_vector_type(4))) short s16x4;
typedef __attribute__((ext_vector_type(4))) float f32x4;
typedef __attribute__((ext_vector_type(16))) float f32x16;
typedef __attribute__((ext_vector_type(2))) __bf16 bf2_t;

constexpr int T_ = 8192;
constexpr int M_ = 65536;
constexpr float ALPHA_ = 1.189207115002721f;
constexpr float LOG2E_ = 1.4426950408889634f;

constexpr size_t AL(size_t x) { return (x + 255) & ~(size_t)255; }
constexpr size_t O_WT_IN   = 0;
constexpr size_t O_WT_UQ   = O_WT_IN   + AL((size_t)1792 * 1024 * 2);
constexpr size_t O_WT_UKV  = O_WT_UQ   + AL((size_t)768 * 256 * 2);
constexpr size_t O_WT_CK1  = O_WT_UKV  + AL((size_t)1024 * 128 * 2);
constexpr size_t O_WT_CV1  = O_WT_CK1  + AL((size_t)256 * 2048 * 2);
constexpr size_t O_WT_CK2  = O_WT_CV1  + AL((size_t)256 * 2048 * 2);
constexpr size_t O_WT_CV2  = O_WT_CK2  + AL((size_t)128 * 256 * 2);
constexpr size_t O_WT_OUT  = O_WT_CV2  + AL((size_t)128 * 256 * 2);
constexpr size_t O_WT_UP   = O_WT_OUT  + AL((size_t)1024 * 1024 * 2);
constexpr size_t O_WT_DOWN = O_WT_UP   + AL((size_t)5632 * 1024 * 2);
constexpr size_t O_WT_GATE = O_WT_DOWN + AL((size_t)1024 * 2816 * 2);
constexpr size_t O_WT_PLE  = O_WT_GATE + AL((size_t)1024 * 1024 * 2);
constexpr size_t O_BIAS1K  = O_WT_PLE  + AL((size_t)1024 * 256 * 2);
constexpr size_t O_BIAS1V  = O_BIAS1K  + AL(256 * 4);
constexpr size_t O_BIAS_UP = O_BIAS1V  + AL(256 * 4);
constexpr size_t O_BIAS_G  = O_BIAS_UP + AL(5632 * 4);
constexpr size_t O_CSUM_UP = O_BIAS_G  + AL(1024 * 4);
constexpr size_t O_CSUM_G  = O_CSUM_UP + AL(5632 * 4);
constexpr size_t O_ROPE_C  = O_CSUM_G  + AL(1024 * 4);
constexpr size_t O_ROPE_S  = O_ROPE_C  + AL((size_t)8192 * 16 * 4);
constexpr size_t O_STATS   = O_ROPE_S  + AL((size_t)8192 * 16 * 4);
constexpr size_t O_SSQ     = O_STATS   + AL((size_t)3 * M_ * 2 * 4);
constexpr size_t O_CTR     = O_SSQ     + AL((size_t)2 * M_ * 4);
constexpr size_t O_BAR     = O_CTR     + 256;
constexpr size_t O_HID     = O_BAR     + 16384;
constexpr size_t O_CMPK    = O_HID     + AL((size_t)2 * 8192 * 256 * 2);
constexpr size_t O_CMPVT   = O_CMPK    + AL((size_t)16 * 512 * 64 * 2);
constexpr size_t O_CONCAT  = O_CMPVT   + AL((size_t)16 * 64 * 512 * 2);
constexpr size_t O_Y2      = O_CONCAT  + AL((size_t)M_ * 1024 * 2);
constexpr size_t O_R1      = O_Y2      + AL((size_t)M_ * 1024 * 4);
constexpr size_t O_QN      = O_R1;
constexpr size_t O_KC      = O_QN   + AL((size_t)M_ * 512 * 2);
constexpr size_t O_VC      = O_KC   + AL((size_t)M_ * 128 * 2);
constexpr size_t O_KS      = O_VC   + AL((size_t)M_ * 128 * 2);
constexpr size_t O_VST     = O_KS   + AL((size_t)M_ * 128 * 2);
constexpr size_t O_KW      = O_VST  + AL((size_t)M_ * 128 * 2);
constexpr size_t O_VWT     = O_KW   + AL((size_t)M_ * 128 * 2);
constexpr size_t O_CQ      = O_VWT  + AL((size_t)M_ * 128 * 2);
constexpr size_t O_CKV     = O_CQ   + AL((size_t)M_ * 256 * 2);
constexpr size_t O_KPE     = O_CKV  + AL((size_t)M_ * 128 * 2);
constexpr size_t O_GATES   = O_KPE  + AL((size_t)M_ * 32 * 2);
constexpr size_t O_QM      = O_GATES + AL((size_t)M_ * 24 * 4);
constexpr size_t O_KN      = O_QM   + AL((size_t)M_ * 768 * 2);
constexpr size_t O_VMT     = O_KN   + AL((size_t)M_ * 512 * 2);
constexpr size_t O_R1_END  = O_VMT  + AL((size_t)M_ * 512 * 2);
constexpr size_t O_HBUF    = O_R1;
constexpr size_t O_PB      = O_R1 + AL((size_t)M_ * 2816 * 2);
static_assert(O_PB + (size_t)M_ * 256 * 2 <= O_R1_END, "PB alias");
static_assert(O_R1_END - O_R1 >= (size_t)M_ * 2816 * 2, "HBUF alias too small");
constexpr size_t O_YB      = O_R1_END;
constexpr size_t WS_NEED   = O_YB + AL((size_t)M_ * 1024 * 2);
static_assert(WS_NEED <= (size_t)1073741824, "workspace budget (4 x largest tensor)");

struct Params {
  const float *x, *p, *w_in, *w_ck1, *w_ck2, *pos_ck, *w_cv1, *w_cv2, *pos_cv, *qn_g, *w_uq, *kvn_g, *w_ukv, *w_out,
      *ln1_g, *ln1_b, *w_up, *w_down, *ln2_g, *ln2_b, *w_pg, *w_ple, *ln3_g, *ln3_b;
  float* out;
  unsigned char* ws;
};

DI unsigned pack2(float a, float b) { bf2_t v; v[0] = (__bf16)a; v[1] = (__bf16)b; return __builtin_bit_cast(unsigned, v); }
DI void store4bf(u16* p, float a, float b, float c, float d) { *(uint2*)p = make_uint2(pack2(a, b), pack2(c, d)); }
DI float bflo(unsigned u) { return __uint_as_float(u << 16); }
DI float bfhi(unsigned u) { return __uint_as_float(u & 0xffff0000u); }
DI float sigmoid_(float x) { return 1.f / (1.f + __expf(-x)); }
DI float gelu_tanh_(float x) {
  float u = 0.7978845608028654f * (x + 0.044715f * x * x * x);
  float e = __expf(2.f * u);
  float th = 1.f - 2.f / (e + 1.f);
  return 0.5f * x * (1.f + th);
}
DI float ex2(float x) { return __builtin_amdgcn_exp2f(x); }
#define MFMA16(a, b, c) __builtin_amdgcn_mfma_f32_16x16x32_bf16((a), (b), (c), 0, 0, 0)
#define MFMA32(a, b, c) __builtin_amdgcn_mfma_f32_32x32x16_bf16((a), (b), (c), 0, 0, 0)

DI int map_in(int n) {
  if (n < 1280) return n;
  if (n < 1536) return 1304 + (n - 1280);
  if (n < 1664) return 1560 + (n - 1536);
  if (n < 1696) return 1688 + (n - 1664);
  if (n < 1720) return 1280 + (n - 1696);
  return -1;
}
DI int map_up(int n) {
  int t = n >> 7, c = n & 127, wc = c >> 6, j = (c >> 4) & 3, i = c & 15;
  int base = 64 * t + wc * 32 + (i >> 2) * 8 + (j & 1) * 4 + (i & 3);
  return (j < 2) ? base : 2816 + base;
}

struct TJob { const float* src; u16* dst; const float* scale; int K, Nsrc, map; };
DI TJob get_tjob(const Params& P, int j) {
  TJob t; t.scale = nullptr; t.map = 0;
  unsigned char* ws = P.ws;
  switch (j) {
    case 0: t.src = P.w_in; t.dst = (u16*)(ws + O_WT_IN); t.K = 1024; t.Nsrc = 1720; t.map = 1; break;
    case 1: t.src = P.w_uq; t.dst = (u16*)(ws + O_WT_UQ); t.K = 256; t.Nsrc = 768; t.scale = P.qn_g; break;
    case 2: t.src = P.w_ukv; t.dst = (u16*)(ws + O_WT_UKV); t.K = 128; t.Nsrc = 1024; t.scale = P.kvn_g; break;
    case 3: t.src = P.w_ck1; t.dst = (u16*)(ws + O_WT_CK1); t.K = 2048; t.Nsrc = 256; break;
    case 4: t.src = P.w_cv1; t.dst = (u16*)(ws + O_WT_CV1); t.K = 2048; t.Nsrc = 256; break;
    case 5: t.src = P.w_ck2; t.dst = (u16*)(ws + O_WT_CK2); t.K = 256; t.Nsrc = 64; break;
    case 6: t.src = P.w_cv2; t.dst = (u16*)(ws + O_WT_CV2); t.K = 256; t.Nsrc = 64; break;
    case 7: t.src = P.w_out; t.dst = (u16*)(ws + O_WT_OUT); t.K = 1024; t.Nsrc = 1024; break;
    case 8: t.src = P.w_up; t.dst = (u16*)(ws + O_WT_UP); t.K = 1024; t.Nsrc = 5632; t.map = 2; t.scale = P.ln1_g; break;
    case 9: t.src = P.w_down; t.dst = (u16*)(ws + O_WT_DOWN); t.K = 2816; t.Nsrc = 1024; break;
    case 10: t.src = P.w_pg; t.dst = (u16*)(ws + O_WT_GATE); t.K = 1024; t.Nsrc = 1024; t.scale = P.ln2_g; break;
    default: t.src = P.w_ple; t.dst = (u16*)(ws + O_WT_PLE); t.K = 256; t.Nsrc = 1024; break;
  }
  return t;
}

DI void phase0(const Params& P, unsigned char* smem, int tid) {
  const int NTL[12] = {448, 48, 32, 128, 128, 4, 4, 256, 1408, 704, 256, 64};
  constexpr int TOT_T = 3480;
  constexpr int TOT_U = TOT_T + 896;
  float* tl = (float*)smem;
  for (int pass = 0; pass < 2; ++pass) {
  if ((pass ^ (int)(blockIdx.x >> 3)) & 1) {
  for (int u = blockIdx.x; u < TOT_U; u += gridDim.x) {
    __syncthreads();
    if (u < TOT_T) {
      int j = 0, ti = u;
#pragma unroll
      for (int q = 0; q < 12; ++q) { if (j == q && ti >= NTL[q]) { ti -= NTL[q]; j = q + 1; } }
      TJob jb = get_tjob(P, j);
      const int nkt = jb.K >> 6;
      const int k0 = (ti % nkt) * 64, n0 = (ti / nkt) * 64;
#pragma unroll
      for (int i = 0; i < 16; ++i) {
        int kk = i * 4 + (tid >> 6), nn = tid & 63;
        int n = n0 + nn;
        int sn = (jb.map == 1) ? map_in(n) : (jb.map == 2 ? map_up(n) : n);
        float v = 0.f;
        if (sn >= 0) v = jb.src[(long)(k0 + kk) * jb.Nsrc + sn];
        if (jb.scale) v *= jb.scale[k0 + kk];
        tl[kk * 65 + nn] = v;
      }
      __syncthreads();
      {
        int n = tid >> 2, kq = tid & 3;
        unsigned w[8];
#pragma unroll
        for (int e = 0; e < 8; ++e) w[e] = pack2(tl[(kq * 16 + 2 * e) * 65 + n], tl[(kq * 16 + 2 * e + 1) * 65 + n]);
        u16* d = jb.dst + (long)(n0 + n) * jb.K + k0 + kq * 16;
        *(uint4*)d = make_uint4(w[0], w[1], w[2], w[3]);
        *(uint4*)(d + 8) = make_uint4(w[4], w[5], w[6], w[7]);
      }
    } else {
      int bu = u - TOT_T;
      const float* vec; const float* vec2 = nullptr; const float* W; float* dst; float* dst2 = nullptr; int K, Nsrc, mp = 0;
      if (bu < 32) { vec = P.pos_ck; W = P.w_ck1; dst = (float*)(P.ws + O_BIAS1K); K = 2048; Nsrc = 256; }
      else if (bu < 64) { bu -= 32; vec = P.pos_cv; W = P.w_cv1; dst = (float*)(P.ws + O_BIAS1V); K = 2048; Nsrc = 256; }
      else if (bu < 768) { bu -= 64; vec = P.ln1_b; vec2 = P.ln1_g; W = P.w_up; dst = (float*)(P.ws + O_BIAS_UP); dst2 = (float*)(P.ws + O_CSUM_UP); K = 1024; Nsrc = 5632; mp = 2; }
      else { bu -= 768; vec = P.ln2_b; vec2 = P.ln2_g; W = P.w_pg; dst = (float*)(P.ws + O_BIAS_G); dst2 = (float*)(P.ws + O_CSUM_G); K = 1024; Nsrc = 1024; }
      int c = tid & 7, kg = tid >> 3;
      int n = bu * 8 + c;
      int sn = (mp == 2) ? map_up(n) : n;
      float sa = 0.f, sb = 0.f;
      if (vec2) {
#pragma unroll 8
        for (int k = kg; k < K; k += 32) { const float w = W[(long)k * Nsrc + sn]; sa += vec[k] * w; sb += vec2[k] * w; }
      } else {
#pragma unroll 8
        for (int k = kg; k < K; k += 32) sa += vec[k] * W[(long)k * Nsrc + sn];
      }
      tl[kg * 8 + c] = sa; tl[256 + kg * 8 + c] = sb;
      __syncthreads();
      if (tid < 8) {
        float a0 = 0.f, a1 = 0.f;
#pragma unroll
        for (int q = 0; q < 32; ++q) { a0 += tl[q * 8 + tid]; a1 += tl[256 + q * 8 + tid]; }
        dst[bu * 8 + tid] = a0;
        if (dst2) dst2[bu * 8 + tid] = a1;
      }
    }
  }
  } else {
    const long gtid0 = (long)blockIdx.x * 256 + tid, gstr0 = (long)gridDim.x * 256;
    u16* xb = (u16*)(P.ws + O_CONCAT);
    for (long i = gtid0; i < (long)M_ * 1024 / 8; i += gstr0) {
      const float4 a = *(const float4*)(P.x + i * 8), b = *(const float4*)(P.x + i * 8 + 4);
      *(uint4*)(xb + i * 8) = make_uint4(pack2(a.x, a.y), pack2(a.z, a.w), pack2(b.x, b.y), pack2(b.z, b.w));
    }
  }
  }
  const long gtid = (long)blockIdx.x * 256 + tid, gstr = (long)gridDim.x * 256;
  float* rc = (float*)(P.ws + O_ROPE_C);
  float* rs = (float*)(P.ws + O_ROPE_S);
  for (long i = gtid; i < 8192 * 16; i += gstr) {
    int pos = (int)(i >> 4), f = (int)(i & 15);
    float inv = powf(10000.0f, -(float)f / 16.0f);
    float ang = (float)pos * inv;
    rc[i] = cosf(ang); rs[i] = sinf(ang);
  }
  float* st = (float*)(P.ws + O_STATS);
  for (long i = gtid; i < (long)3 * M_ * 2; i += gstr) st[i] = 0.f;
  { float* sq = (float*)(P.ws + O_SSQ); for (long i = gtid; i < (long)2 * M_; i += gstr) sq[i] = 0.f; }
  if (gtid < 64) ((int*)(P.ws + O_CTR))[gtid] = 0;
}

constexpr int LDS_BUF = 32768;
constexpr int LDS_RS_OFF = 2 * LDS_BUF;

template <int AMODE, int FAKE = 0>
DI void gemm_mainloop(f32x4 (&acc)[4][4], unsigned char* smem, const void* A, long lda, int m0, int K,
                      const u16* Bt, int n0, const float* stats, bool ns, int tid) {
  const int lane = tid & 63, wave = tid >> 6, wm = wave >> 1, wn = wave & 1;
  const int l16 = lane & 15, lq = lane >> 4;
  const int crow = tid >> 3, cch = tid & 7;
  int gtok0 = 0;
  const int nk = K >> 6;
  const int swz = (cch ^ (crow & 7)) * 8;
  const unsigned boff = ((unsigned)(n0 + crow) * (unsigned)K + (unsigned)cch * 8u) * 2u;
  const unsigned bstrb = 64u * (unsigned)K;
  unsigned aoff = 0u; const unsigned astrb = 64u * (unsigned)lda;
  if constexpr (AMODE == 0) aoff = ((unsigned)(m0 + crow) * (unsigned)lda + (unsigned)cch * 8u) * 2u;
  if constexpr (AMODE == 3) { const int r_ = m0 + crow; const int bg_ = r_ >> 9; gtok0 = (r_ & 511) * 16;
    aoff = ((unsigned)(bg_ >> 1) * (unsigned)T_ * 128u + (unsigned)(bg_ & 1) * 64u + (unsigned)cch * 8u) * 2u; }
  const unsigned gch = (unsigned)(cch ^ (crow & 7)) * 16u;
  const unsigned boffd = ((unsigned)(n0 + crow) * (unsigned)K) * 2u + gch;
  unsigned aoffd = 0u;
  if constexpr (AMODE == 0) aoffd = ((unsigned)(m0 + crow) * (unsigned)lda) * 2u + gch;
  if constexpr (AMODE == 3) { const int r_ = m0 + crow; const int bg_ = r_ >> 9;
    aoffd = ((unsigned)(bg_ >> 1) * (unsigned)T_ * 128u + (unsigned)(bg_ & 1) * 64u) * 2u + gch; }
  const int wbase = __builtin_amdgcn_readfirstlane(wave) * 1024;
#define GP(base_, off_) ((const unsigned*)((const char*)(base_) + (unsigned)(off_)))
#define LP(BUF, off_) ((unsigned*)(smem + (BUF) * LDS_BUF + wbase + (off_)))
#define D_LOAD(BUF, ks) { const unsigned qb_ = boffd + (unsigned)(ks) * 128u; \
    __builtin_amdgcn_global_load_lds(GP(Bt, qb_), LP(BUF, 16384), 16, 0, 0); \
    __builtin_amdgcn_global_load_lds(GP(Bt, qb_ + bstrb), LP(BUF, 16384 + 4096), 16, 0, 0); \
    __builtin_amdgcn_global_load_lds(GP(Bt, qb_ + 2u * bstrb), LP(BUF, 16384 + 8192), 16, 0, 0); \
    __builtin_amdgcn_global_load_lds(GP(Bt, qb_ + 3u * bstrb), LP(BUF, 16384 + 12288), 16, 0, 0); \
    if constexpr (AMODE == 0) { const unsigned qa_ = aoffd + (unsigned)(ks) * 128u; \
      __builtin_amdgcn_global_load_lds(GP(A, qa_), LP(BUF, 0), 16, 0, 0); \
      __builtin_amdgcn_global_load_lds(GP(A, qa_ + astrb), LP(BUF, 4096), 16, 0, 0); \
      __builtin_amdgcn_global_load_lds(GP(A, qa_ + 2u * astrb), LP(BUF, 8192), 16, 0, 0); \
      __builtin_amdgcn_global_load_lds(GP(A, qa_ + 3u * astrb), LP(BUF, 12288), 16, 0, 0); } \
    else { \
      __builtin_amdgcn_global_load_lds(GP(A, aoffd + (unsigned)min(gtok0 + (ks), T_ - 1) * 256u), LP(BUF, 0), 16, 0, 0); \
      __builtin_amdgcn_global_load_lds(GP(A, aoffd + (unsigned)min(gtok0 + 512 + (ks), T_ - 1) * 256u), LP(BUF, 4096), 16, 0, 0); \
      __builtin_amdgcn_global_load_lds(GP(A, aoffd + (unsigned)min(gtok0 + 1024 + (ks), T_ - 1) * 256u), LP(BUF, 8192), 16, 0, 0); \
      __builtin_amdgcn_global_load_lds(GP(A, aoffd + (unsigned)min(gtok0 + 1536 + (ks), T_ - 1) * 256u), LP(BUF, 12288), 16, 0, 0); } }
#define D_SYNC() { asm volatile("s_waitcnt vmcnt(0)" ::: "memory"); asm volatile("s_waitcnt lgkmcnt(0)" ::: "memory"); __builtin_amdgcn_s_barrier(); asm volatile("" ::: "memory"); }
#define G_ROW(mi, fa_) \
      if (ns) { acc[mi][0] = MFMA16(fa_, fb0, acc[mi][0]); acc[mi][1] = MFMA16(fa_, fb1, acc[mi][1]); acc[mi][2] = MFMA16(fa_, fb2, acc[mi][2]); acc[mi][3] = MFMA16(fa_, fb3, acc[mi][3]); } \
      else    { acc[mi][0] = MFMA16(fb0, fa_, acc[mi][0]); acc[mi][1] = MFMA16(fb1, fa_, acc[mi][1]); acc[mi][2] = MFMA16(fb2, fa_, acc[mi][2]); acc[mi][3] = MFMA16(fb3, fa_, acc[mi][3]); }
#define G_HALF(BUF, kk) { \
      const int co = (((kk) * 4 + lq) ^ (l16 & 7)) * 8; \
      const u16* pa = (const u16*)(smem + (BUF) * LDS_BUF) + (wm * 64 + l16) * 64 + co; \
      const u16* pb = (const u16*)(smem + (BUF) * LDS_BUF) + 8192 + (wn * 64 + l16) * 64 + co; \
      const bf16x8 fa0 = *(const bf16x8*)pa, fa1 = *(const bf16x8*)(pa + 16 * 64), fa2 = *(const bf16x8*)(pa + 32 * 64), fa3 = *(const bf16x8*)(pa + 48 * 64); \
      const bf16x8 fb0 = *(const bf16x8*)pb, fb1 = *(const bf16x8*)(pb + 16 * 64), fb2 = *(const bf16x8*)(pb + 32 * 64), fb3 = *(const bf16x8*)(pb + 48 * 64); \
      G_ROW(0, fa0) G_ROW(1, fa1) G_ROW(2, fa2) G_ROW(3, fa3) }
#define R_STEP(CUR, ks) { \
    if ((ks) + 1 < nk && FAKE != 1) D_LOAD((CUR) ^ 1, (ks) + 1) \
    __builtin_amdgcn_sched_barrier(0); \
    if (FAKE != 2) { G_HALF(CUR, 0) G_HALF(CUR, 1) } \
    D_SYNC() }
  __syncthreads();
  D_LOAD(0, 0)
  D_SYNC()
  for (int ks = 0; ks < nk; ks += 2) {
    R_STEP(0, ks)
    if (ks + 1 < nk) R_STEP(1, ks + 1)
  }
#undef GP
#undef LP
#undef D_LOAD
#undef D_SYNC
#undef G_ROW
#undef G_HALF
#undef R_STEP
}

constexpr int LDS_BIG = 24576;
template <int FAKE = 0>
DI void gemm_mainloop_big(f32x4 (&acc)[8][4], unsigned char* smem, const void* A, long lda, int m0, int K,
                          const u16* Bt, int n0, bool ns, int tid) {
  const int lane = tid & 63, wave = tid >> 6, wm = wave >> 1, wn = wave & 1;
  const int l16 = lane & 15, lq = lane >> 4;
  const int nk = K >> 5;
  const int prow = lane >> 2, ppos = lane & 3;
  const unsigned gch = (unsigned)(ppos ^ ((4 - ((lane >> 4) & 3)) & 3)) * 16u;
  const unsigned aoffd = ((unsigned)(m0 + 16 * wave + prow) * (unsigned)lda) * 2u + gch;
  const unsigned boffd = ((unsigned)(n0 + 16 * wave + prow) * (unsigned)K) * 2u + gch;
  const unsigned astrb = 128u * (unsigned)lda, bstrb = 128u * (unsigned)K;
  const int wbase = __builtin_amdgcn_readfirstlane(wave) * 1024;
#define GP(base_, off_) ((const unsigned*)((const char*)(base_) + (unsigned)(off_)))
#define LP(BUF, off_) ((unsigned*)(smem + (BUF) * LDS_BIG + wbase + (off_)))
#define D_LOAD(BUF, ks) { const unsigned ko_ = (unsigned)(ks) * 64u; \
    __builtin_amdgcn_global_load_lds(GP(A, aoffd + ko_), LP(BUF, 0), 16, 0, 0); \
    __builtin_amdgcn_global_load_lds(GP(A, aoffd + ko_ + astrb), LP(BUF, 4096), 16, 0, 0); \
    __builtin_amdgcn_global_load_lds(GP(A, aoffd + ko_ + 2u * astrb), LP(BUF, 8192), 16, 0, 0); \
    __builtin_amdgcn_global_load_lds(GP(A, aoffd + ko_ + 3u * astrb), LP(BUF, 12288), 16, 0, 0); \
    __builtin_amdgcn_global_load_lds(GP(Bt, boffd + ko_), LP(BUF, 16384), 16, 0, 0); \
    __builtin_amdgcn_global_load_lds(GP(Bt, boffd + ko_ + bstrb), LP(BUF, 16384 + 4096), 16, 0, 0); }
#define D_SYNC() { asm volatile("s_waitcnt vmcnt(0)" ::: "memory"); asm volatile("s_waitcnt lgkmcnt(0)" ::: "memory"); __builtin_amdgcn_s_barrier(); asm volatile("" ::: "memory"); }
  const int pp = (lq ^ ((4 - ((l16 >> 2) & 3)) & 3)) * 8;
#define B_ROW(mi) { const bf16x8 fa_ = *(const bf16x8*)(pa + (mi) * 16 * 32); \
      if (ns) { acc[mi][0] = MFMA16(fa_, fb0, acc[mi][0]); acc[mi][1] = MFMA16(fa_, fb1, acc[mi][1]); acc[mi][2] = MFMA16(fa_, fb2, acc[mi][2]); acc[mi][3] = MFMA16(fa_, fb3, acc[mi][3]); } \
      else    { acc[mi][0] = MFMA16(fb0, fa_, acc[mi][0]); acc[mi][1] = MFMA16(fb1, fa_, acc[mi][1]); acc[mi][2] = MFMA16(fb2, fa_, acc[mi][2]); acc[mi][3] = MFMA16(fb3, fa_, acc[mi][3]); } }
#define B_COMPUTE(BUF) { \
      const u16* pa = (const u16*)(smem + (BUF) * LDS_BIG) + (wm * 128 + l16) * 32 + pp; \
      const u16* pb = (const u16*)(smem + (BUF) * LDS_BIG + 16384) + (wn * 64 + l16) * 32 + pp; \
      const bf16x8 fb0 = *(const bf16x8*)pb, fb1 = *(const bf16x8*)(pb + 16 * 32), fb2 = *(const bf16x8*)(pb + 32 * 32), fb3 = *(const bf16x8*)(pb + 48 * 32); \
      B_ROW(0) B_ROW(1) B_ROW(2) B_ROW(3) B_ROW(4) B_ROW(5) B_ROW(6) B_ROW(7) }
#define B_STEP(CUR, ks) { \
    if ((ks) + 1 < nk && FAKE != 1) D_LOAD((CUR) ^ 1, (ks) + 1) \
    __builtin_amdgcn_sched_barrier(0); \
    if (FAKE != 2) B_COMPUTE(CUR) \
    D_SYNC() }
  __syncthreads();
  D_LOAD(0, 0)
  D_SYNC()
  for (int ks = 0; ks < nk; ks += 2) {
    B_STEP(0, ks)
    if (ks + 1 < nk) B_STEP(1, ks + 1)
  }
#undef GP
#undef LP
#undef D_LOAD
#undef D_SYNC
#undef B_ROW
#undef B_COMPUTE
#undef B_STEP
}

template <int MI>
DI void zero_acc(f32x4 (&acc)[MI][4]) {
#pragma unroll
  for (int i = 0; i < MI; ++i)
#pragma unroll
    for (int j = 0; j < 4; ++j) acc[i][j] = f32x4{0.f, 0.f, 0.f, 0.f};
}

DI void stat_push(float* stats, int tok, float s1, float s2, int lq) {
  s1 += __shfl_xor(s1, 16); s2 += __shfl_xor(s2, 16);
  s1 += __shfl_xor(s1, 32); s2 += __shfl_xor(s2, 32);
  if (lq == 0) { atomicAdd(stats + 2 * (long)tok, s1); atomicAdd(stats + 2 * (long)tok + 1, s2); }
}

enum { PH_IN = 1, PH_UQ, PH_UKV, PH_C1, PH_C2, PH_OUT, PH_UP, PH_DOWN, PH_PLE };

template <int PH, int FAKE = 0>
DI void gemm_tile(const Params& P, unsigned char* smem, int mt, int nt, int which, int tid_in) {
  int tid = tid_in;
  asm volatile("" : "+v"(tid));
  unsigned char* ws = P.ws;
  const int lane = tid & 63, wave = tid >> 6, wm = wave >> 1, wn = wave & 1;
  const int l16 = lane & 15, lq = lane >> 4;
  constexpr int MI = (PH == PH_OUT || PH == PH_UP || PH == PH_DOWN || PH == PH_PLE) ? 8 : 4;
  constexpr int WR = MI * 16;
  const int m0 = mt * (2 * WR), n0 = nt * 128;
  f32x4 acc[MI][4];
  zero_acc<MI>(acc);
  float* rsq = (float*)(smem + LDS_RS_OFF);

  if constexpr (PH == PH_IN) {
    const bool ns = (nt == 7 || nt == 9);
    gemm_mainloop<0>(acc, smem, (const u16*)(ws + O_CONCAT), 1024, m0, 1024, (const u16*)(ws + O_WT_IN), n0, nullptr, ns, tid);
    const float QSC = 0.125f * LOG2E_;
    unsigned char* swv = smem + wave * 18432;
#pragma unroll
    for (int mi = 0; mi < MI; ++mi) {
      if (!ns) {
        const int tok = m0 + wm * WR + mi * 16 + l16;
        if (nt < 4) {
#pragma unroll
          for (int nj = 0; nj < 4; ++nj) {
            int col = n0 + wn * 64 + nj * 16 + lq * 4;
            f32x4 a = acc[mi][nj];
            *(uint2*)(swv + (mi * 16 + l16) * 144 + nj * 32 + lq * 8) = make_uint2(pack2(a[0] * QSC, a[1] * QSC), pack2(a[2] * QSC, a[3] * QSC));
          }
        } else if (nt == 4 || nt == 5 || nt == 6 || nt == 8 || nt == 12) {
          u16* dst = (u16*)(ws + (nt == 4 ? O_KC : nt == 5 ? O_VC : nt == 6 ? O_KS : nt == 8 ? O_KW : O_CKV));
          float ss = 0.f;
#pragma unroll
          for (int nj = 0; nj < 4; ++nj) {
            int col = wn * 64 + nj * 16 + lq * 4;
            f32x4 a = acc[mi][nj];
            ss += a[0] * a[0] + a[1] * a[1] + a[2] * a[2] + a[3] * a[3];
            *(uint2*)(swv + (mi * 16 + l16) * 144 + nj * 32 + lq * 8) = make_uint2(pack2(a[0], a[1]), pack2(a[2], a[3]));
          }
          if (nt == 12) {
            ss += __shfl_xor(ss, 16); ss += __shfl_xor(ss, 32);
            if (lq == 0) atomicAdd((float*)(ws + O_SSQ) + M_ + tok, ss);
          }
        } else if (nt == 10 || nt == 11) {
          float ss = 0.f;
#pragma unroll
          for (int nj = 0; nj < 4; ++nj) {
            int col = (nt - 10) * 128 + wn * 64 + nj * 16 + lq * 4;
            f32x4 a = acc[mi][nj];
            ss += a[0] * a[0] + a[1] * a[1] + a[2] * a[2] + a[3] * a[3];
            *(uint2*)(swv + (mi * 16 + l16) * 144 + nj * 32 + lq * 8) = make_uint2(pack2(a[0], a[1]), pack2(a[2], a[3]));
          }
          ss += __shfl_xor(ss, 16); ss += __shfl_xor(ss, 32);
          if (lq == 0) atomicAdd((float*)(ws + O_SSQ) + tok, ss);
        } else {
          if (wn == 0) {
            const int pos = tok & (T_ - 1);
            const float4 cs = *(const float4*)((const float*)(ws + O_ROPE_C) + pos * 16 + lq * 4);
            const float4 sn = *(const float4*)((const float*)(ws + O_ROPE_S) + pos * 16 + lq * 4);
            f32x4 x1 = acc[mi][0], x2 = acc[mi][1];
            u16* kp = (u16*)(ws + O_KPE) + (long)tok * 32;
            store4bf(kp + lq * 4, x1[0] * cs.x - x2[0] * sn.x, x1[1] * cs.y - x2[1] * sn.y, x1[2] * cs.z - x2[2] * sn.z, x1[3] * cs.w - x2[3] * sn.w);
            store4bf(kp + 16 + lq * 4, x2[0] * cs.x + x1[0] * sn.x, x2[1] * cs.y + x1[1] * sn.y, x2[2] * cs.z + x1[2] * sn.z, x2[3] * cs.w + x1[3] * sn.w);
            float* gp = (float*)(ws + O_GATES) + (long)tok * 24;
            f32x4 g0 = acc[mi][2], g1 = acc[mi][3];
            *(float4*)(gp + lq * 4) = make_float4(sigmoid_(g0[0]), sigmoid_(g0[1]), sigmoid_(g0[2]), sigmoid_(g0[3]));
            if (lq < 2) *(float4*)(gp + 16 + lq * 4) = make_float4(sigmoid_(g1[0]), sigmoid_(g1[1]), sigmoid_(g1[2]), sigmoid_(g1[3]));
          }
        }
      } else {
        const int tok4 = m0 + wm * WR + mi * 16 + lq * 4;
        const int b = tok4 >> 13, t = tok4 & (T_ - 1);
        u16* dstb = (u16*)(ws + (nt == 7 ? O_VST : O_VWT));
#pragma unroll
        for (int nj = 0; nj < 4; ++nj) {
          int c = wn * 64 + nj * 16 + l16, g = c >> 6, d = c & 63;
          f32x4 a = acc[mi][nj];
          store4bf(dstb + ((long)((b * 2 + g) * 64 + d)) * T_ + t, a[0], a[1], a[2], a[3]);
        }
      }
    }
    if (!ns && nt != 13) {
      asm volatile("s_waitcnt lgkmcnt(0)" ::: "memory");
      u16* dbase; int ldd, coff;
      if (nt < 4) { dbase = (u16*)(ws + O_QN); ldd = 512; coff = n0 + wn * 64; }
      else if (nt == 10 || nt == 11) { dbase = (u16*)(ws + O_CQ); ldd = 256; coff = (nt - 10) * 128 + wn * 64; }
      else { dbase = (u16*)(ws + (nt == 4 ? O_KC : nt == 5 ? O_VC : nt == 6 ? O_KS : nt == 8 ? O_KW : O_CKV)); ldd = 128; coff = wn * 64; }
#pragma unroll
      for (int r = 0; r < 8; ++r) {
        const int row = r * 8 + (lane >> 3), ch = lane & 7;
        const uint4 v = *(const uint4*)(swv + row * 144 + ch * 16);
        *(uint4*)(dbase + (long)(m0 + wm * WR + row) * ldd + coff + ch * 8) = v;
      }
    }
  }

  if constexpr (PH == PH_UQ || PH == PH_UKV) {
    constexpr int K = (PH == PH_UQ) ? 256 : 128;
    const u16* A = (const u16*)(ws + (PH == PH_UQ ? O_CQ : O_CKV));
    __syncthreads();
    if (tid < 128) {
      const float ss = ((const float*)(ws + O_SSQ))[(PH == PH_UQ ? 0 : M_) + m0 + tid];
      rsq[tid] = rsqrtf(ss * (1.f / K) + 1e-6f);
    }
    if constexpr (PH == PH_UQ) {
      gemm_mainloop<0>(acc, smem, A, 256, m0, 256, (const u16*)(ws + O_WT_UQ), n0, nullptr, false, tid);
      const float SC = 0.10206207261596577f * LOG2E_;
#pragma unroll
      for (int mi = 0; mi < MI; ++mi) {
        const int tok = m0 + wm * WR + mi * 16 + l16;
        const float rs = rsq[wm * WR + mi * 16 + l16] * SC;
        const int pos = tok & (T_ - 1);
        const int ct0 = nt * 8 + wn * 4;
#pragma unroll
        for (int njp = 0; njp < 4; njp += 2) {
          f32x4 a = acc[mi][njp], b2 = acc[mi][njp + 1];
          if (((ct0 + njp) % 6) == 4) {
            const float4 cs = *(const float4*)((const float*)(ws + O_ROPE_C) + pos * 16 + lq * 4);
            const float4 sn = *(const float4*)((const float*)(ws + O_ROPE_S) + pos * 16 + lq * 4);
            f32x4 o1, o2;
            o1[0] = a[0] * cs.x - b2[0] * sn.x; o2[0] = b2[0] * cs.x + a[0] * sn.x;
            o1[1] = a[1] * cs.y - b2[1] * sn.y; o2[1] = b2[1] * cs.y + a[1] * sn.y;
            o1[2] = a[2] * cs.z - b2[2] * sn.z; o2[2] = b2[2] * cs.z + a[2] * sn.z;
            o1[3] = a[3] * cs.w - b2[3] * sn.w; o2[3] = b2[3] * cs.w + a[3] * sn.w;
            a = o1; b2 = o2;
          }
          u16* dst = (u16*)(ws + O_QM) + (long)tok * 768 + n0 + wn * 64 + njp * 16 + lq * 4;
          store4bf(dst, a[0] * rs, a[1] * rs, a[2] * rs, a[3] * rs);
          store4bf(dst + 16, b2[0] * rs, b2[1] * rs, b2[2] * rs, b2[3] * rs);
        }
      }
    } else {
      const bool ns = (wn == 1);
      gemm_mainloop<0>(acc, smem, A, 128, m0, 128, (const u16*)(ws + O_WT_UKV), n0, nullptr, ns, tid);
#pragma unroll
      for (int mi = 0; mi < MI; ++mi) {
        if (!ns) {
          const int tok = m0 + wm * WR + mi * 16 + l16;
          const float rs = rsq[wm * WR + mi * 16 + l16];
#pragma unroll
          for (int nj = 0; nj < 4; ++nj) {
            f32x4 a = acc[mi][nj];
            store4bf((u16*)(ws + O_KN) + (long)tok * 512 + nt * 64 + nj * 16 + lq * 4, a[0] * rs, a[1] * rs, a[2] * rs, a[3] * rs);
          }
        } else {
          const int lr = wm * WR + mi * 16 + lq * 4;
          const int tok4 = m0 + lr;
          const int b = tok4 >> 13, t = tok4 & (T_ - 1);
          const float r0 = rsq[lr], r1 = rsq[lr + 1], r2 = rsq[lr + 2], r3 = rsq[lr + 3];
#pragma unroll
          for (int nj = 0; nj < 4; ++nj) {
            int d = nj * 16 + l16;
            f32x4 a = acc[mi][nj];
            store4bf((u16*)(ws + O_VMT) + ((long)((b * 8 + nt) * 64 + d)) * T_ + t, a[0] * r0, a[1] * r1, a[2] * r2, a[3] * r3);
          }
        }
      }
    }
  }

  if constexpr (PH == PH_C1) {
    const u16* A = (const u16*)(ws + (which ? O_VC : O_KC));
    const u16* Bt = (const u16*)(ws + (which ? O_WT_CV1 : O_WT_CK1));
    const float* bias = (const float*)(ws + (which ? O_BIAS1V : O_BIAS1K));
    gemm_mainloop<3>(acc, smem, A, 128, m0, 2048, Bt, n0, nullptr, false, tid);
    u16* hid = (u16*)(ws + O_HID) + (long)which * 8192 * 256;
#pragma unroll
    for (int mi = 0; mi < MI; ++mi) {
      const int row = m0 + wm * WR + mi * 16 + l16;
#pragma unroll
      for (int nj = 0; nj < 4; ++nj) {
        int col = n0 + wn * 64 + nj * 16 + lq * 4;
        const float4 bb = *(const float4*)(bias + col);
        f32x4 a = acc[mi][nj];
        store4bf(hid + (long)row * 256 + col, gelu_tanh_(a[0] + bb.x), gelu_tanh_(a[1] + bb.y), gelu_tanh_(a[2] + bb.z), gelu_tanh_(a[3] + bb.w));
      }
    }
  }

  if constexpr (PH == PH_C2) {
    const u16* A = (const u16*)(ws + O_HID) + (long)which * 8192 * 256;
    const u16* Bt = (const u16*)(ws + (which ? O_WT_CV2 : O_WT_CK2));
    const bool ns = (which == 1);
    gemm_mainloop<0>(acc, smem, A, 256, m0, 256, Bt, 0, nullptr, ns, tid);
    if (wn == 0) {
#pragma unroll
      for (int mi = 0; mi < MI; ++mi) {
        if (!ns) {
          const int row = m0 + wm * WR + mi * 16 + l16;
#pragma unroll
          for (int nj = 0; nj < 4; ++nj) {
            f32x4 a = acc[mi][nj];
            store4bf((u16*)(ws + O_CMPK) + (long)row * 64 + nj * 16 + lq * 4, a[0], a[1], a[2], a[3]);
          }
        } else {
          const int r4 = m0 + wm * WR + mi * 16 + lq * 4;
          const int bg = r4 >> 9, c = r4 & 511;
#pragma unroll
          for (int nj = 0; nj < 4; ++nj) {
            int d = nj * 16 + l16;
            f32x4 a = acc[mi][nj];
            store4bf((u16*)(ws + O_CMPVT) + ((long)(bg * 64 + d)) * 512 + c, a[0], a[1], a[2], a[3]);
          }
        }
      }
    }
  }

  if constexpr (PH == PH_OUT) {
    gemm_mainloop_big<0>(acc, smem, (const u16*)(ws + O_CONCAT), 1024, m0, 1024, (const u16*)(ws + O_WT_OUT), n0, false, tid);
    float* stats = (float*)(ws + O_STATS);
    unsigned char* swv = smem + wave * 18432;
#pragma unroll
    for (int mi = 0; mi < MI; ++mi) {
      const int tok = m0 + wm * WR + mi * 16 + l16;
      float s1 = 0.f, s2 = 0.f;
#pragma unroll
      for (int nj = 0; nj < 4; ++nj) {
        int col = n0 + wn * 64 + nj * 16 + lq * 4;
        const float4 xv = *(const float4*)(P.x + (long)tok * 1024 + col);
        f32x4 a = acc[mi][nj];
        float4 y = make_float4(ALPHA_ * xv.x + a[0], ALPHA_ * xv.y + a[1], ALPHA_ * xv.z + a[2], ALPHA_ * xv.w + a[3]);
        *(uint2*)(swv + (mi * 16 + l16) * 144 + nj * 32 + lq * 8) = make_uint2(pack2(y.x, y.y), pack2(y.z, y.w));
        s1 += y.x + y.y + y.z + y.w;
        s2 += y.x * y.x + y.y * y.y + y.z * y.z + y.w * y.w;
      }
      stat_push(stats, tok, s1, s2, lq);
    }
    asm volatile("s_waitcnt lgkmcnt(0)" ::: "memory");
    {
      u16* yb = (u16*)(ws + O_YB) + (long)(m0 + wm * WR) * 1024 + n0 + wn * 64;
#pragma unroll
      for (int r = 0; r < 16; ++r) {
        const int row = r * 8 + (lane >> 3), ch = lane & 7;
        const uint4 v = *(const uint4*)(swv + row * 144 + ch * 16);
        *(uint4*)(yb + (long)row * 1024 + ch * 8) = v;
      }
    }
  }

  if constexpr (PH == PH_UP) {
    gemm_mainloop_big<FAKE>(acc, smem, (const u16*)(ws + O_YB), 1024, m0, 1024, (const u16*)(ws + O_WT_UP), n0, false, tid);
    if (FAKE != 0 && acc[0][0][0] + acc[3][3][3] + acc[1][2][1] != 123456.75f) return;
    const float* bias = (const float*)(ws + O_BIAS_UP);
    const float* csum = (const float*)(ws + O_CSUM_UP);
    const float* st1 = (const float*)(ws + O_STATS);
    const int cb0 = n0 + wn * 64 + lq * 4;
    const float4 bgv[2] = {*(const float4*)(bias + cb0), *(const float4*)(bias + cb0 + 16)};
    const float4 buv[2] = {*(const float4*)(bias + cb0 + 32), *(const float4*)(bias + cb0 + 48)};
    const float4 cgv[2] = {*(const float4*)(csum + cb0), *(const float4*)(csum + cb0 + 16)};
    const float4 cuv[2] = {*(const float4*)(csum + cb0 + 32), *(const float4*)(csum + cb0 + 48)};
#pragma unroll
    for (int mi = 0; mi < MI; ++mi) {
      const int tok = m0 + wm * WR + mi * 16 + l16;
      const float mean = st1[2 * tok] * (1.f / 1024.f);
      const float rstd = rsqrtf(st1[2 * tok + 1] * (1.f / 1024.f) - mean * mean + 1e-5f);
      unsigned hw[4];
#pragma unroll
      for (int nj = 0; nj < 2; ++nj) {
        const float4 bg = bgv[nj], bu = buv[nj], cg = cgv[nj], cu = cuv[nj];
        f32x4 g = acc[mi][nj], u = acc[mi][nj + 2];
        float h0, h1, h2, h3, v;
        v = rstd * (g[0] - mean * cg.x) + bg.x; h0 = v * sigmoid_(v) * (rstd * (u[0] - mean * cu.x) + bu.x);
        v = rstd * (g[1] - mean * cg.y) + bg.y; h1 = v * sigmoid_(v) * (rstd * (u[1] - mean * cu.y) + bu.y);
        v = rstd * (g[2] - mean * cg.z) + bg.z; h2 = v * sigmoid_(v) * (rstd * (u[2] - mean * cu.z) + bu.z);
        v = rstd * (g[3] - mean * cg.w) + bg.w; h3 = v * sigmoid_(v) * (rstd * (u[3] - mean * cu.w) + bu.w);
        hw[2 * nj] = pack2(h0, h1); hw[2 * nj + 1] = pack2(h2, h3);
      }
      *(uint4*)((u16*)(ws + O_HBUF) + (long)tok * 2816 + nt * 64 + wn * 32 + lq * 8) = make_uint4(hw[0], hw[1], hw[2], hw[3]);
    }
  }

  if constexpr (PH == PH_DOWN) {
    gemm_mainloop_big<0>(acc, smem, (const u16*)(ws + O_HBUF), 2816, m0, 2816, (const u16*)(ws + O_WT_DOWN), n0, false, tid);
    const float* st1 = (const float*)(ws + O_STATS);
    float* st2 = (float*)(ws + O_STATS) + (long)M_ * 2;
    u16* yb = (u16*)(ws + O_YB);
    unsigned char* swv = smem + wave * 18432;
#pragma unroll
    for (int mi = 0; mi < MI; ++mi) {
      const int tok = m0 + wm * WR + mi * 16 + l16;
      const float mean = st1[2 * tok] * (1.f / 1024.f);
      const float rstd = rsqrtf(st1[2 * tok + 1] * (1.f / 1024.f) - mean * mean + 1e-5f);
      float s1 = 0.f, s2 = 0.f;
#pragma unroll
      for (int nj = 0; nj < 4; ++nj) {
        int col = n0 + wn * 64 + nj * 16 + lq * 4;
        const uint2 yq = *(const uint2*)(yb + (long)tok * 1024 + col);
        const float4 yv = make_float4(bflo(yq.x), bfhi(yq.x), bflo(yq.y), bfhi(yq.y));
        const float4 gg = *(const float4*)(P.ln1_g + col);
        const float4 bb = *(const float4*)(P.ln1_b + col);
        f32x4 a = acc[mi][nj];
        float4 y;
        y.x = ALPHA_ * ((yv.x - mean) * rstd * gg.x + bb.x) + a[0];
        y.y = ALPHA_ * ((yv.y - mean) * rstd * gg.y + bb.y) + a[1];
        y.z = ALPHA_ * ((yv.z - mean) * rstd * gg.z + bb.z) + a[2];
        y.w = ALPHA_ * ((yv.w - mean) * rstd * gg.w + bb.w) + a[3];
        *(uint2*)(swv + (mi * 16 + l16) * 144 + nj * 32 + lq * 8) = make_uint2(pack2(y.x, y.y), pack2(y.z, y.w));
        s1 += y.x + y.y + y.z + y.w;
        s2 += y.x * y.x + y.y * y.y + y.z * y.z + y.w * y.w;
      }
      stat_push(st2, tok, s1, s2, lq);
    }
    asm volatile("s_waitcnt lgkmcnt(0)" ::: "memory");
    {
      u16* ydst = (u16*)(ws + O_YB) + (long)(m0 + wm * WR) * 1024 + n0 + wn * 64;
#pragma unroll
      for (int r = 0; r < 16; ++r) {
        const int row = r * 8 + (lane >> 3), ch = lane & 7;
        const uint4 v = *(const uint4*)(swv + row * 144 + ch * 16);
        *(uint4*)(ydst + (long)row * 1024 + ch * 8) = v;
      }
    }
  }

  if constexpr (PH == PH_PLE) {
    const float* st2 = (const float*)(ws + O_STATS) + (long)M_ * 2;
    float* st3 = (float*)(ws + O_STATS) + (long)M_ * 4;
    u16* yb = (u16*)(ws + O_YB);
    unsigned char* swv = smem + wave * 18432;
    gemm_mainloop_big<0>(acc, smem, (const u16*)(ws + O_YB), 1024, m0, 1024, (const u16*)(ws + O_WT_GATE), n0, false, tid);
    const float* bias = (const float*)(ws + O_BIAS_G);
    uint4* gsp4 = (uint4*)(ws + O_HBUF) + (long)(mt * 8 + nt) * 16 * 256;
    const int cg0 = n0 + wn * 64 + lq * 4;
    const float4 gbv[4] = {*(const float4*)(bias + cg0), *(const float4*)(bias + cg0 + 16), *(const float4*)(bias + cg0 + 32), *(const float4*)(bias + cg0 + 48)};
    const float* csg = (const float*)(ws + O_CSUM_G);
    const float4 gcv[4] = {*(const float4*)(csg + cg0), *(const float4*)(csg + cg0 + 16), *(const float4*)(csg + cg0 + 32), *(const float4*)(csg + cg0 + 48)};
#pragma unroll
    for (int mi = 0; mi < MI; ++mi) {
      const int tok = m0 + wm * WR + mi * 16 + l16;
      const float mean_g = st2[2 * tok] * (1.f / 1024.f);
      const float rstd_g = rsqrtf(st2[2 * tok + 1] * (1.f / 1024.f) - mean_g * mean_g + 1e-5f);
      unsigned gw[8];
#pragma unroll
      for (int nj = 0; nj < 4; ++nj) {
        const float4 bb = gbv[nj], cs = gcv[nj];
        f32x4 a = acc[mi][nj];
        gw[2 * nj] = pack2(sigmoid_(rstd_g * (a[0] - mean_g * cs.x) + bb.x), sigmoid_(rstd_g * (a[1] - mean_g * cs.y) + bb.y));
        gw[2 * nj + 1] = pack2(sigmoid_(rstd_g * (a[2] - mean_g * cs.z) + bb.z), sigmoid_(rstd_g * (a[3] - mean_g * cs.w) + bb.w));
      }
      gsp4[(mi * 2 + 0) * 256 + tid] = make_uint4(gw[0], gw[1], gw[2], gw[3]);
      gsp4[(mi * 2 + 1) * 256 + tid] = make_uint4(gw[4], gw[5], gw[6], gw[7]);
    }
    zero_acc<MI>(acc);
    gemm_mainloop_big<0>(acc, smem, (const u16*)(ws + O_PB), 256, m0, 256, (const u16*)(ws + O_WT_PLE), n0, false, tid);
#pragma unroll
    for (int mi = 0; mi < MI; ++mi) {
      const int tok = m0 + wm * WR + mi * 16 + l16;
      const float mean = st2[2 * tok] * (1.f / 1024.f);
      const float rstd = rsqrtf(st2[2 * tok + 1] * (1.f / 1024.f) - mean * mean + 1e-5f);
      float s1 = 0.f, s2 = 0.f;
      const uint4 gqa = gsp4[(mi * 2 + 0) * 256 + tid], gqb = gsp4[(mi * 2 + 1) * 256 + tid];
#pragma unroll
      for (int nj = 0; nj < 4; ++nj) {
        int col = n0 + wn * 64 + nj * 16 + lq * 4;
        const uint2 yq = *(const uint2*)(yb + (long)tok * 1024 + col);
        const float4 yv = make_float4(bflo(yq.x), bfhi(yq.x), bflo(yq.y), bfhi(yq.y));
        const float4 gg = *(const float4*)(P.ln2_g + col);
        const float4 bb = *(const float4*)(P.ln2_b + col);
        f32x4 a = acc[mi][nj];
        const unsigned g01 = (nj == 0) ? gqa.x : (nj == 1) ? gqa.z : (nj == 2) ? gqb.x : gqb.z;
        const unsigned g23 = (nj == 0) ? gqa.y : (nj == 1) ? gqa.w : (nj == 2) ? gqb.y : gqb.w;
        float4 y;
        y.x = ALPHA_ * ((yv.x - mean) * rstd * gg.x + bb.x) + bflo(g01) * a[0];
        y.y = ALPHA_ * ((yv.y - mean) * rstd * gg.y + bb.y) + bfhi(g01) * a[1];
        y.z = ALPHA_ * ((yv.z - mean) * rstd * gg.z + bb.z) + bflo(g23) * a[2];
        y.w = ALPHA_ * ((yv.w - mean) * rstd * gg.w + bb.w) + bfhi(g23) * a[3];
        *(uint2*)(swv + (mi * 16 + l16) * 144 + nj * 32 + lq * 8) = make_uint2(pack2(y.x, y.y), pack2(y.z, y.w));
        s1 += y.x + y.y + y.z + y.w;
        s2 += y.x * y.x + y.y * y.y + y.z * y.z + y.w * y.w;
      }
      stat_push(st3, tok, s1, s2, lq);
    }
    asm volatile("s_waitcnt lgkmcnt(0)" ::: "memory");
    {
      u16* ydst = (u16*)(ws + O_CONCAT) + (long)(m0 + wm * WR) * 1024 + n0 + wn * 64;
#pragma unroll
      for (int r = 0; r < 16; ++r) {
        const int row = r * 8 + (lane >> 3), ch = lane & 7;
        const uint4 v = *(const uint4*)(swv + row * 144 + ch * 16);
        *(uint4*)(ydst + (long)row * 1024 + ch * 8) = v;
      }
    }
  }
}

constexpr int LDS_TOTAL = 4 * 18432 + 512;
constexpr int CTL_OFF = 53248;
constexpr int SEL_OFF = CTL_OFF + 1024;
constexpr int IMP_OFF = 35840;
static_assert(IMP_OFF + 32 * 130 * 4 <= CTL_OFF, "lds");
static_assert(SEL_OFF + 512 <= LDS_TOTAL, "lds");

struct AttnSrc { const u16* K; long ldk; const u16* K2; const u16* V; long ldv; };
enum { AM_MLA = 0, AM_WIN = 1, AM_SLC = 2, AM_CMP = 3 };

template <int MODE, int DQ, bool DO_PV, bool FIXED_M, bool DO_IMP, bool USE_LIST, int FK = 0>
DI void attn_loop(unsigned char* smem, const AttnSrc src, int ntiles, int tile_lo, const int* tlist,
                  const bf16x8 (&qf)[DQ / 16], float& m, float& l, f32x16 (&O)[2], int t, float slope2,
                  unsigned sw0, unsigned sw1, unsigned sw2, unsigned sw3, float inv_l, unsigned* imp, int tid_in) {
  int tid = tid_in;
  asm volatile("" : "+v"(tid));
  constexpr int KST = DQ + 8;
  constexpr int KCH = DQ / 8;
  constexpr int NKL = KCH * 64 / 256;
  constexpr int KBYTES = 64 * KST * 2;
  constexpr int VST = 68;
  constexpr int VBYTES = 64 * VST * 2;
  const int lane = tid & 63, l32 = lane & 31, h = lane >> 5;
  u16* sK0 = (u16*)smem;
  u16* sV0 = (u16*)(smem + 2 * KBYTES);
  uint4 rk0, rk1, rk2, rv0, rv1;
  const int kr0 = tid / KCH, kc0 = tid % KCH;
  const int kr1 = (tid + 256) / KCH, kc1 = (tid + 256) % KCH;
  const int kr2 = (tid + 512) / KCH, kc2 = (tid + 512) % KCH;
  const int vr0 = tid >> 3, vc0 = tid & 7;
#define A_KLD(dst_, row_, ch_, tile_) { \
    if constexpr (MODE == AM_MLA) { \
      if ((ch_) < 8) dst_ = *(const uint4*)(src.K + ((long)(tile_) * 64 + (row_)) * src.ldk + (ch_) * 8); \
      else dst_ = *(const uint4*)(src.K2 + ((long)(tile_) * 64 + (row_)) * 32 + ((ch_) - 8) * 8); \
    } else dst_ = *(const uint4*)(src.K + ((long)(tile_) * 64 + (row_)) * src.ldk + (ch_) * 8); }
#define A_GLOAD(tile_) { \
    A_KLD(rk0, kr0, kc0, tile_) A_KLD(rk1, kr1, kc1, tile_) \
    if constexpr (NKL == 3) A_KLD(rk2, kr2, kc2, tile_) \
    if constexpr (DO_PV) { \
      rv0 = *(const uint4*)(src.V + (long)vr0 * src.ldv + (long)(tile_) * 64 + vc0 * 8); \
      rv1 = *(const uint4*)(src.V + (long)(vr0 + 32) * src.ldv + (long)(tile_) * 64 + vc0 * 8); } }
#define A_LSTORE(buf_) { \
    u16* sK_ = sK0 + (buf_) * (KBYTES / 2); u16* sV_ = sV0 + (buf_) * (VBYTES / 2); \
    *(uint4*)(sK_ + kr0 * KST + kc0 * 8) = rk0; *(uint4*)(sK_ + kr1 * KST + kc1 * 8) = rk1; \
    if constexpr (NKL == 3) *(uint4*)(sK_ + kr2 * KST + kc2 * 8) = rk2; \
    if constexpr (DO_PV) { \
      *(uint2*)(sV_ + vr0 * VST + vc0 * 8) = make_uint2(rv0.x, rv0.y); *(uint2*)(sV_ + vr0 * VST + vc0 * 8 + 4) = make_uint2(rv0.z, rv0.w); \
      *(uint2*)(sV_ + (vr0 + 32) * VST + vc0 * 8) = make_uint2(rv1.x, rv1.y); *(uint2*)(sV_ + (vr0 + 32) * VST + vc0 * 8 + 4) = make_uint2(rv1.z, rv1.w); } }
  __syncthreads();
  if (ntiles > 0) { const int tf = USE_LIST ? tlist[0] : tile_lo; A_GLOAD(tf) A_LSTORE(0) }
  __syncthreads();
  for (int it = 0; it < ntiles; ++it) {
    const int tile = USE_LIST ? tlist[it] : tile_lo + it;
    if (it + 1 < ntiles && FK != 1) { const int tn = USE_LIST ? tlist[it + 1] : tile_lo + it + 1; A_GLOAD(tn) }
    __builtin_amdgcn_sched_barrier(0);
    const u16* sK = sK0 + (it & 1) * (KBYTES / 2);
    const u16* sV = sV0 + (it & 1) * (VBYTES / 2);
    f32x16 S[2];
#pragma unroll
    for (int kb = 0; kb < 2; ++kb) {
#pragma unroll
      for (int i = 0; i < 16; ++i) S[kb][i] = 0.f;
#pragma unroll
      for (int s = 0; s < DQ / 16; ++s) {
        bf16x8 kf = *(const bf16x8*)(sK + (kb * 32 + l32) * KST + s * 16 + h * 8);
        S[kb] = MFMA32(kf, qf[s], S[kb]);
      }
    }
    float c0 = 0.f;
    {
      constexpr int MUL = (MODE == AM_CMP) ? 16 : 1;
      int d0;
      if constexpr (MODE == AM_CMP) d0 = t - 31 - 16 * (tile * 64 + 4 * h);
      else d0 = t - tile * 64 - 4 * h;
      bool need = true;
      if constexpr (MODE == AM_MLA) need = (tile * 64 + 63 > t - l32);
      bool selbit = true;
      if constexpr (MODE == AM_SLC) {
        const int w = tile >> 5;
        const unsigned swd = (w == 0) ? sw0 : (w == 1) ? sw1 : (w == 2) ? sw2 : sw3;
        selbit = (swd >> (tile & 31)) & 1u;
      }
      bool full = false;
      if constexpr (MODE != AM_MLA) {
        const int tw = t - l32;
        if constexpr (MODE == AM_CMP) full = ((tile * 64 + 63) * 16 + 31 <= tw);
        if constexpr (MODE == AM_WIN) full = (tile * 64 + 63 <= tw) && (tw + 31 - tile * 64 < 512);
        if constexpr (MODE == AM_SLC) full = (tile * 64 + 63 <= tw) && __all(selbit);
      }
      const float fd0 = (float)d0;
      if constexpr (MODE != AM_MLA) {
#pragma unroll
        for (int kb = 0; kb < 2; ++kb)
#pragma unroll
          for (int i = 0; i < 16; ++i) {
            const float ci = (float)(MUL * ((i & 3) + 8 * (i >> 2) + 32 * kb));
            S[kb][i] = fmaf(slope2, ci, S[kb][i]);
          }
      }
      c0 = (MODE != AM_MLA) ? -slope2 * fd0 : 0.f;
      if (need && !full) {
#pragma unroll
        for (int kb = 0; kb < 2; ++kb)
#pragma unroll
          for (int i = 0; i < 16; ++i) {
            const float ci = (float)(MUL * ((i & 3) + 8 * (i >> 2) + 32 * kb));
            const float dist = fd0 - ci;
            bool valid = dist >= 0.f;
            if constexpr (MODE == AM_WIN) valid = valid && (dist < 512.f);
            if constexpr (MODE == AM_SLC) valid = valid && selbit;
            S[kb][i] = valid ? S[kb][i] : -INFINITY;
          }
      }
    }
    if constexpr (FK != 2) {
    if constexpr (!FIXED_M) {
      float tmax = -INFINITY;
#pragma unroll
      for (int kb = 0; kb < 2; ++kb)
#pragma unroll
        for (int i = 0; i < 16; ++i) tmax = fmaxf(tmax, S[kb][i]);
      tmax += c0;
      tmax = fmaxf(tmax, __shfl_xor(tmax, 32));
      const bool need = tmax > m + 8.f;
      if (__any(need)) {
        const float mnew = need ? tmax : m;
        const float alpha = ex2(m - mnew);
        m = mnew;
        l *= alpha;
        if constexpr (DO_PV) {
#pragma unroll
          for (int db = 0; db < 2; ++db)
#pragma unroll
            for (int i = 0; i < 16; ++i) O[db][i] *= alpha;
        }
      }
    }
    const float mx = m - c0;
    {
      float ps = 0.f;
#pragma unroll
      for (int kb = 0; kb < 2; ++kb)
#pragma unroll
        for (int i = 0; i < 16; ++i) { float p = ex2(S[kb][i] - mx); S[kb][i] = p; ps += p; }
      l += ps;
    }
    }
    if constexpr (DO_IMP) {
#pragma unroll
      for (int kb = 0; kb < 2; ++kb)
#pragma unroll
        for (int a = 0; a < 4; ++a) {
          const float p0 = S[kb][4 * a] * inv_l, p1 = S[kb][4 * a + 1] * inv_l, p2 = S[kb][4 * a + 2] * inv_l, p3 = S[kb][4 * a + 3] * inv_l;
          const float mainv = 2.f * (p0 + p1 + p2) + p3;
          const int n = tile * 16 + kb * 8 + 2 * a + h;
          atomicAdd(imp + l32 * 130 + n, (unsigned)(mainv * 268435456.f));
          atomicAdd(imp + l32 * 130 + n + 1, (unsigned)(p3 * 268435456.f));
        }
    }
    if (it + 1 < ntiles) { A_LSTORE((it + 1) & 1) }
    if constexpr (DO_PV) {
#pragma unroll
      for (int sp = 0; sp < 4; ++sp) {
        const int kb = sp >> 1, hf = sp & 1;
        unsigned w0 = pack2(S[kb][8 * hf + 0], S[kb][8 * hf + 1]);
        unsigned w1 = pack2(S[kb][8 * hf + 2], S[kb][8 * hf + 3]);
        unsigned w2 = pack2(S[kb][8 * hf + 4], S[kb][8 * hf + 5]);
        unsigned w3 = pack2(S[kb][8 * hf + 6], S[kb][8 * hf + 7]);
        uint4 pw = make_uint4(w0, w1, w2, w3);
        bf16x8 pf = __builtin_bit_cast(bf16x8, pw);
#pragma unroll
        for (int db = 0; db < 2; ++db) {
          const u16* vp = sV + (db * 32 + l32) * VST + 16 * sp + 4 * h;
          s16x4 lo = *(const s16x4*)vp;
          s16x4 hi = *(const s16x4*)(vp + 8);
          bf16x8 vf = __builtin_shufflevector(lo, hi, 0, 1, 2, 3, 4, 5, 6, 7);
          O[db] = MFMA32(vf, pf, O[db]);
        }
      }
    }
    __syncthreads();
  }
  l += __shfl_xor(l, 32);
#undef A_KLD
#undef A_GLOAD
#undef A_LSTORE
}

DI void zero_o(f32x16 (&O)[2]) {
#pragma unroll
  for (int db = 0; db < 2; ++db)
#pragma unroll
    for (int i = 0; i < 16; ++i) O[db][i] = 0.f;
}

template <int FK = 0>
DI void mla_item(const Params& P, unsigned char* smem, int b, int hh, int qt, int tid_in) {
  int tid = tid_in;
  asm volatile("" : "+v"(tid));
  unsigned char* ws = P.ws;
  const int lane = tid & 63, w = tid >> 6, l32 = lane & 31, h = lane >> 5;
  const int t = qt * 128 + w * 32 + l32;
  const long tok = (long)b * T_ + t;
  bf16x8 qf[6];
#pragma unroll
  for (int s = 0; s < 6; ++s) qf[s] = *(const bf16x8*)((const u16*)(ws + O_QM) + tok * 768 + hh * 96 + s * 16 + h * 8);
  float m = -1e30f, l = 0.f;
  f32x16 O[2];
  zero_o(O);
  AttnSrc src;
  src.K = (const u16*)(ws + O_KN) + (long)b * T_ * 512 + hh * 64; src.ldk = 512;
  src.K2 = (const u16*)(ws + O_KPE) + (long)b * T_ * 32;
  src.V = (const u16*)(ws + O_VMT) + ((long)(b * 8 + hh) * 64) * T_; src.ldv = T_;
  attn_loop<AM_MLA, 96, true, false, false, false, FK>(smem, src, 2 * qt + 2, 0, nullptr, qf, m, l, O, t, 0.f, 0, 0, 0, 0, 0.f, nullptr, tid);
  if (FK != 0 && O[0][0] + O[1][5] + l != 123456.75f) return;
  const float lt = l;
  const float inv = lt > 0.f ? 1.f / lt : 0.f;
  u16* dst = (u16*)(ws + O_CONCAT) + tok * 1024 + 512 + hh * 64;
#pragma unroll
  for (int db = 0; db < 2; ++db)
#pragma unroll
    for (int a = 0; a < 4; ++a)
      store4bf(dst + db * 32 + 8 * a + 4 * h, O[db][4 * a] * inv, O[db][4 * a + 1] * inv, O[db][4 * a + 2] * inv, O[db][4 * a + 3] * inv);
}

DI u64 mk_key(int n, unsigned v, int cur) {
  if (n > cur) return 0ull;
  if (n == 0 || n == cur || n == cur - 1) v = 0xFFFFFFFFu;
  return ((u64)v << 8) | (u64)(128 - n);
}

DI void nsa_item(const Params& P, unsigned char* smem, int b, int g, int tt, int tid_in) {
  int tid = tid_in;
  asm volatile("" : "+v"(tid));
  unsigned char* ws = P.ws;
  const int lane = tid & 63, w = tid >> 6, l32 = lane & 31, h = lane >> 5;
  const int t0 = tt * 32;
  const int t = t0 + l32;
  const long tok = (long)b * T_ + t;
  const int head8 = g * 4 + w;
  int* ctl = (int*)(smem + CTL_OFF);
  unsigned* sel = (unsigned*)(smem + SEL_OFF);
  unsigned* imp = (unsigned*)(smem + IMP_OFF);
  bf16x8 qf[4];
#pragma unroll
  for (int s = 0; s < 4; ++s) qf[s] = *(const bf16x8*)((const u16*)(ws + O_QN) + tok * 512 + head8 * 64 + s * 16 + h * 8);
  const float* gp = (const float*)(ws + O_GATES) + tok * 24 + head8 * 3;
  const float g0 = gp[0], g1 = gp[1], g2 = gp[2];
  const float slope2 = LOG2E_ * exp2f(-(float)(head8 + 1));
  __syncthreads();
  for (int i = tid; i < 32 * 130; i += 256) imp[i] = 0u;
  if (tid < 4) ctl[4 + tid] = 0;
  f32x16 O[2];
  float m = -1e30f, l = 0.f;
  float* osp = (float*)(ws + O_Y2) + (long)blockIdx.x * 16384 + tid;
  AttnSrc sc;
  sc.K = (const u16*)(ws + O_CMPK) + ((long)(b * 2 + g) * 512) * 64; sc.ldk = 64; sc.K2 = nullptr;
  sc.V = (const u16*)(ws + O_CMPVT) + ((long)(b * 2 + g) * 64) * 512; sc.ldv = 512;
  const int ntc = (t0 >> 10) + 1;
  attn_loop<AM_CMP, 64, false, false, false, false>(smem, sc, ntc, 0, nullptr, qf, m, l, O, t, slope2, 0, 0, 0, 0, 0.f, nullptr, tid);
  {
    const float lt = l;
    const float inv_l = lt > 0.f ? 1.f / lt : 0.f;
    zero_o(O);
    float l2 = 0.f;
    attn_loop<AM_CMP, 64, true, true, true, false>(smem, sc, ntc, 0, nullptr, qf, m, l2, O, t, slope2, 0, 0, 0, 0, inv_l, imp, tid);
    const float sc0 = g0 * inv_l;
#pragma unroll
    for (int db = 0; db < 2; ++db)
#pragma unroll
      for (int i = 0; i < 16; ++i) osp[(db * 16 + i) * 256] = O[db][i] * sc0;
  }
  for (int tk = 0; tk < 8; ++tk) {
    const int token = w * 8 + tk;
    const int cur = (t0 + token) >> 6;
    const u64 k0 = mk_key(lane, imp[token * 130 + lane], cur);
    const u64 k1 = mk_key(lane + 64, imp[token * 130 + lane + 64], cur);
    u64 thr = 0ull;
    for (int bit = 39; bit >= 0; --bit) {
      const u64 cand = thr | (1ull << bit);
      const int c = __popcll(__ballot(k0 >= cand)) + __popcll(__ballot(k1 >= cand));
      if (c >= 16) thr = cand;
    }
    const u64 m0 = __ballot(k0 >= thr && k0 > 0ull);
    const u64 m1 = __ballot(k1 >= thr && k1 > 0ull);
    if (lane == 0) {
      sel[token * 4 + 0] = (unsigned)m0; sel[token * 4 + 1] = (unsigned)(m0 >> 32);
      sel[token * 4 + 2] = (unsigned)m1; sel[token * 4 + 3] = (unsigned)(m1 >> 32);
      atomicOr((unsigned*)&ctl[4], (unsigned)m0); atomicOr((unsigned*)&ctl[5], (unsigned)(m0 >> 32));
      atomicOr((unsigned*)&ctl[6], (unsigned)m1); atomicOr((unsigned*)&ctl[7], (unsigned)(m1 >> 32));
    }
  }
  __syncthreads();
  if (tid == 0) {
    int c = 0;
    for (int q = 0; q < 4; ++q) {
      unsigned u = (unsigned)ctl[4 + q];
      while (u) { int bp = __ffs(u) - 1; ctl[8 + c] = q * 32 + bp; ++c; u &= u - 1; }
    }
    ctl[1] = c;
  }
  __syncthreads();
  const int nsl = ctl[1];
  const unsigned sw0 = sel[l32 * 4 + 0], sw1 = sel[l32 * 4 + 1], sw2 = sel[l32 * 4 + 2], sw3 = sel[l32 * 4 + 3];
  {
    AttnSrc ss;
    ss.K = (const u16*)(ws + O_KS) + (long)b * T_ * 128 + g * 64; ss.ldk = 128; ss.K2 = nullptr;
    ss.V = (const u16*)(ws + O_VST) + ((long)(b * 2 + g) * 64) * T_; ss.ldv = T_;
    m = -1e30f; l = 0.f; zero_o(O);
    attn_loop<AM_SLC, 64, true, false, false, true>(smem, ss, nsl, 0, ctl + 8, qf, m, l, O, t, slope2, sw0, sw1, sw2, sw3, 0.f, nullptr, tid);
    const float lt = l;
    const float sc1 = lt > 0.f ? g1 / lt : 0.f;
#pragma unroll
    for (int db = 0; db < 2; ++db)
#pragma unroll
      for (int i = 0; i < 16; ++i) osp[8192 + (db * 16 + i) * 256] = O[db][i] * sc1;
  }
  {
    AttnSrc sw;
    sw.K = (const u16*)(ws + O_KW) + (long)b * T_ * 128 + g * 64; sw.ldk = 128; sw.K2 = nullptr;
    sw.V = (const u16*)(ws + O_VWT) + ((long)(b * 2 + g) * 64) * T_; sw.ldv = T_;
    const int lo = (t0 > 511 ? (t0 - 511) : 0) >> 6, hi = (t0 + 31) >> 6;
    m = -1e30f; l = 0.f; zero_o(O);
    attn_loop<AM_WIN, 64, true, false, false, false>(smem, sw, hi - lo + 1, lo, nullptr, qf, m, l, O, t, slope2, 0, 0, 0, 0, 0.f, nullptr, tid);
    const float lt = l;
    const float sc2 = lt > 0.f ? g2 / lt : 0.f;
#pragma unroll
    for (int db = 0; db < 2; ++db)
#pragma unroll
      for (int i = 0; i < 16; ++i) O[db][i] = O[db][i] * sc2 + osp[(db * 16 + i) * 256] + osp[8192 + (db * 16 + i) * 256];
  }
  u16* dst = (u16*)(ws + O_CONCAT) + tok * 1024 + head8 * 64;
#pragma unroll
  for (int db = 0; db < 2; ++db)
#pragma unroll
    for (int a = 0; a < 4; ++a)
      store4bf(dst + db * 32 + 8 * a + 4 * h, O[db][4 * a], O[db][4 * a + 1], O[db][4 * a + 2], O[db][4 * a + 3]);
}

DI void ln_apply_pass(const u16* src, const float* st, u16* dst, int tid, int nb) {
  const int lane = tid & 63;
  for (int row = blockIdx.x * 4 + (tid >> 6); row < M_; row += nb * 4) {
    const float mean = st[2 * row] * (1.f / 1024.f);
    const float rstd = rsqrtf(st[2 * row + 1] * (1.f / 1024.f) - mean * mean + 1e-5f);
    const u16* o = src + (long)row * 1024;
#pragma unroll
    for (int i = 0; i < 2; ++i) {
      const int c = lane * 8 + 512 * i;
      const uint4 v = *(const uint4*)(o + c);
      *(uint4*)(dst + (long)row * 1024 + c) = make_uint4(pack2((bflo(v.x) - mean) * rstd, (bfhi(v.x) - mean) * rstd), pack2((bflo(v.y) - mean) * rstd, (bfhi(v.y) - mean) * rstd),
                                                        pack2((bflo(v.z) - mean) * rstd, (bfhi(v.z) - mean) * rstd), pack2((bflo(v.w) - mean) * rstd, (bfhi(v.w) - mean) * rstd));
    }
  }
}

#ifndef REP
#define REP 0
#endif
#ifndef FAKEV
#define FAKEV 0
#endif
DI void tile_map(int i, int NT, int& mt, int& nt, int mpx = 64) {
  const int xcd = i & 7, j = i >> 3;
  const int ms = j / (8 * NT), r = j - ms * 8 * NT;
  nt = r >> 3;
  mt = xcd * mpx + ms * 8 + (r & 7);
}

template <int PMODE = 0, int FK = 0>
DI void phase4(const Params& P, unsigned char* smem, int tid, int cbase) {
  {
    int* ctr = (int*)(P.ws + O_CTR) + cbase;
    int* ctl = (int*)(smem + CTL_OFF);
    const int xcd = blockIdx.x & 7;
    bool mla_done = false;
    for (;;) {
      __syncthreads();
      if (tid == 0) {
        int it = -1;
        if (!mla_done) { int k = atomicAdd(ctr + xcd, 1); if (k < 512) it = k; }
        if (it < 0) { if (PMODE == 1) it = 8192; else { int j = atomicAdd(ctr + 8, 1); it = (j < 4096) ? 4096 + j : 8192; } }
        ctl[0] = it;
      }
      __syncthreads();
      const int item = ctl[0];
      if (item >= 8192) break;
#ifndef SKIP_MLA
      if (item < 4096) {
        const int qt = 63 - (item & 63), bh = (item >> 6) * 8 + xcd;
        mla_item<FK>(P, smem, bh >> 3, bh & 7, qt, tid);
      }
#endif
      if (item >= 4096) mla_done = true;
#ifndef SKIP_NSA
      if (item >= 4096) {
        const int j = item - 4096;
        const int tt = 255 - (j >> 4), bg = j & 15;
        nsa_item(P, smem, bg >> 1, bg & 1, tt, tid);
      }
#endif
    }
  }
}

#define XB_XCNT(j)  (64 * (j))
#define XB_XSUB(j)  (1024 + 64 * (j))
#define XB_XGEN(j)  (2048 + 64 * (j))
#define XB_TOP      3072
#define XB_TOPGEN   3136
#define XB_WORDS    3200
DI unsigned xb_ld(unsigned* p) { return __hip_atomic_load(p, __ATOMIC_RELAXED, __HIP_MEMORY_SCOPE_AGENT); }
DI unsigned xb_add(unsigned* p, unsigned v) { return __hip_atomic_fetch_add(p, v, __ATOMIC_RELAXED, __HIP_MEMORY_SCOPE_AGENT); }
DI unsigned xb_xcc_id() { return (unsigned)__builtin_amdgcn_s_getreg((3 << 11) | 20) & 0xFu; }
struct XBar { unsigned* bar; unsigned x, nloc, nx; };
DI void gsync(const XBar& b, int tid) {
  asm volatile("s_waitcnt vmcnt(0)" ::: "memory");
  __syncthreads();
  if (tid == 0) {
    unsigned* bar = b.bar;
    __builtin_amdgcn_s_waitcnt(0);
    const unsigned old = xb_add(&bar[XB_XSUB(b.x)], 1u);
    const unsigned gen = old / b.nloc;
    if (old + 1u == (gen + 1u) * b.nloc) {
      __builtin_amdgcn_fence(__ATOMIC_RELEASE, "agent");
      asm volatile("s_waitcnt vmcnt(0)" ::: "memory");
      const unsigned og = xb_add(&bar[XB_TOP], 1u);
      const unsigned tg = og / b.nx;
      if (og + 1u == (tg + 1u) * b.nx) xb_add(&bar[XB_TOPGEN], 1u);
      else while (xb_ld(&bar[XB_TOPGEN]) == tg) __builtin_amdgcn_s_sleep(1);
      __builtin_amdgcn_fence(__ATOMIC_ACQUIRE, "agent");
      xb_add(&bar[XB_XGEN(b.x)], 1u);
      asm volatile("s_waitcnt vmcnt(0)" ::: "memory");
    } else {
      while (xb_ld(&bar[XB_XGEN(b.x)]) == gen) __builtin_amdgcn_s_sleep(1);
      __builtin_amdgcn_fence(__ATOMIC_ACQUIRE, "agent");
      asm volatile("s_waitcnt vmcnt(0)" ::: "memory");
    }
  }
  __syncthreads();
}

__global__ void __launch_bounds__(256, 2) fwd_megakernel(Params P) {
  cg::grid_group grid = cg::this_grid();
  extern __shared__ __attribute__((aligned(16))) unsigned char smem[];
  const int tid = threadIdx.x;
  const int nb = gridDim.x;
  XBar xb; xb.bar = (unsigned*)(P.ws + O_BAR); xb.x = xb_xcc_id(); xb.nloc = 1u; xb.nx = 1u;
  if (tid == 0) (void)xb_add(&xb.bar[XB_XCNT(xb.x)], 1u);

#ifndef SKIP_P0
  phase0(P, smem, tid);
#endif
  if (P.ws == nullptr) grid.sync();
  if (tid == 0) {
    unsigned mine = 0u, cnt = 0u, sum = 0u;
    for (;;) {
      mine = 0u; cnt = 0u; sum = 0u;
#pragma unroll
      for (unsigned j = 0; j < 16; ++j) { const unsigned c = xb_ld(&xb.bar[XB_XCNT(j)]); sum += c; cnt += (c > 0u) ? 1u : 0u; mine = (j == xb.x) ? c : mine; }
      if (sum == gridDim.x) break;
      __builtin_amdgcn_s_sleep(1);
    }
    xb.nloc = mine > 0u ? mine : 1u; xb.nx = cnt > 0u ? cnt : 1u;
  }
  gsync(xb, tid);
#ifndef SKIP_P1
  for (int i = blockIdx.x; i < 512 * 14; i += nb) { int mt, nt; tile_map(i, 14, mt, nt); gemm_tile<PH_IN>(P, smem, mt, nt, 0, tid); }
#if REP == 11
  for (int q = 0; q < 20; ++q) gsync(xb, tid);
#endif
#if REP == 1
  gsync(xb, tid);
  for (int i = blockIdx.x; i < 512 * 14; i += nb) { int mt, nt; tile_map(i, 14, mt, nt); gemm_tile<PH_IN>(P, smem, mt, nt, 0, tid); }
#endif
#endif
  gsync(xb, tid);
#ifndef SKIP_P2
  for (int i = blockIdx.x; i < 256 + 3072 + 4096; i += nb) {
    if (i < 256) gemm_tile<PH_C1>(P, smem, (i >> 1) & 63, i & 1, i >> 7, tid);
    else if (i < 256 + 3072) { int mt, nt; tile_map(i - 256, 6, mt, nt); gemm_tile<PH_UQ>(P, smem, mt, nt, 0, tid); }
    else { int mt, nt; tile_map(i - 256 - 3072, 8, mt, nt); gemm_tile<PH_UKV>(P, smem, mt, nt, 0, tid); }
  }
#endif
#if REP == 2
  gsync(xb, tid);
  for (int i = blockIdx.x; i < 256 + 3072 + 4096; i += nb) {
    if (i < 256) gemm_tile<PH_C1>(P, smem, (i >> 1) & 63, i & 1, i >> 7, tid);
    else if (i < 256 + 3072) { int mt, nt; tile_map(i - 256, 6, mt, nt); gemm_tile<PH_UQ>(P, smem, mt, nt, 0, tid); }
    else { int mt, nt; tile_map(i - 256 - 3072, 8, mt, nt); gemm_tile<PH_UKV>(P, smem, mt, nt, 0, tid); }
  }
#endif
  gsync(xb, tid);
#ifndef SKIP_P3
  for (int i = blockIdx.x; i < 128; i += nb) gemm_tile<PH_C2>(P, smem, i & 63, 0, i >> 6, tid);
#endif
  gsync(xb, tid);
  phase4(P, smem, tid, 0);
#if REP == 4
  gsync(xb, tid);
  phase4<0, 0>(P, smem, tid, 16);
#endif
#if REP == 41
  gsync(xb, tid);
  phase4<1, FAKEV>(P, smem, tid, 16);
#endif
  gsync(xb, tid);
  {
    u16* pb = (u16*)(P.ws + O_PB);
    for (long i = (long)blockIdx.x * 256 + tid; i < (long)M_ * 256 / 8; i += (long)nb * 256) {
      const float4 a = *(const float4*)(P.p + i * 8), b = *(const float4*)(P.p + i * 8 + 4);
      *(uint4*)(pb + i * 8) = make_uint4(pack2(a.x, a.y), pack2(a.z, a.w), pack2(b.x, b.y), pack2(b.z, b.w));
    }
  }
#ifndef SKIP_P5
  for (int i = blockIdx.x; i < 256 * 8; i += nb) { int mt, nt; tile_map(i, 8, mt, nt, 32); gemm_tile<PH_OUT>(P, smem, mt, nt, 0, tid); }
#endif
  gsync(xb, tid);
#ifndef SKIP_P6
  for (int i = blockIdx.x; i < 256 * 44; i += nb) { int mt, nt; tile_map(i, 44, mt, nt, 32); gemm_tile<PH_UP>(P, smem, mt, nt, 0, tid); }
#if REP == 6
  gsync(xb, tid);
  for (int i = blockIdx.x; i < 256 * 44; i += nb) { int mt, nt; tile_map(i, 44, mt, nt, 32); gemm_tile<PH_UP, FAKEV>(P, smem, mt, nt, 0, tid); }
#endif
#endif
  gsync(xb, tid);
#ifndef SKIP_P7
  for (int i = blockIdx.x; i < 256 * 8; i += nb) { int mt, nt; tile_map(i, 8, mt, nt, 32); gemm_tile<PH_DOWN>(P, smem, mt, nt, 0, tid); }
#endif
  gsync(xb, tid);
#ifndef SKIP_P8
  for (int i = blockIdx.x; i < 256 * 8; i += nb) { int mt, nt; tile_map(i, 8, mt, nt, 32); gemm_tile<PH_PLE>(P, smem, mt, nt, 0, tid); }
#endif
  gsync(xb, tid);
  {
    const float* st3 = (const float*)(P.ws + O_STATS) + (long)M_ * 4;
    const int lane = tid & 63;
    for (int row = blockIdx.x * 4 + (tid >> 6); row < M_; row += nb * 4) {
      const float mean = st3[2 * row] * (1.f / 1024.f);
      const float rstd = rsqrtf(st3[2 * row + 1] * (1.f / 1024.f) - mean * mean + 1e-5f);
      float* o = P.out + (long)row * 1024;
      const u16* yb = (const u16*)(P.ws + O_CONCAT) + (long)row * 1024;
#pragma unroll
      for (int i = 0; i < 4; ++i) {
        const int c = lane * 4 + 256 * i;
        const uint2 yq = *(const uint2*)(yb + c);
        float4 v = make_float4(bflo(yq.x), bfhi(yq.x), bflo(yq.y), bfhi(yq.y));
        const float4 gg = *(const float4*)(P.ln3_g + c);
        const float4 bb = *(const float4*)(P.ln3_b + c);
        v.x = (v.x - mean) * rstd * gg.x + bb.x;
        v.y = (v.y - mean) * rstd * gg.y + bb.y;
        v.z = (v.z - mean) * rstd * gg.z + bb.z;
        v.w = (v.w - mean) * rstd * gg.w + bb.w;
        *(float4*)(o + c) = v;
      }
    }
  }
}

extern "C" void kernel_launch(void* const* d_in, const int* in_sizes, int n_in,
                              void* d_out, int out_size, void* d_ws, size_t ws_size,
                              hipStream_t stream) {
  static int grid_blocks = 0;
  if (!grid_blocks) {
    int dev = 0, cus = 0, per_cu = 0;
    (void)hipGetDevice(&dev);
    (void)hipDeviceGetAttribute(&cus, hipDeviceAttributeMultiprocessorCount, dev);
    (void)hipFuncSetAttribute((const void*)fwd_megakernel, hipFuncAttributeMaxDynamicSharedMemorySize, LDS_TOTAL);
    (void)hipOccupancyMaxActiveBlocksPerMultiprocessor(&per_cu, fwd_megakernel, 256, LDS_TOTAL);
    if (per_cu < 1) per_cu = 1;
    if (per_cu > 2) per_cu = 2;
    grid_blocks = cus * per_cu;
    fprintf(stderr, "grid_blocks=%d (cus=%d per_cu=%d) ws_need=%zu ws_size=%zu\n", grid_blocks, cus, per_cu, (size_t)WS_NEED, ws_size);
  }
  if (ws_size < WS_NEED || n_in < 24) { fprintf(stderr, "kernel_launch: workspace too small or bad inputs\n"); return; }
  (void)hipMemsetAsync((unsigned char*)d_ws + O_BAR, 0, 16384, stream);
  Params p{};
  const float** pp = (const float**)&p;
  for (int i = 0; i < 24; ++i) pp[i] = (const float*)d_in[i];
  p.out = (float*)d_out;
  p.ws = (unsigned char*)d_ws;
  void* args[] = {&p};
  hipError_t e = hipLaunchCooperativeKernel((void*)fwd_megakernel, dim3(grid_blocks), dim3(256), args, LDS_TOTAL, stream);
  if (e != hipSuccess) fprintf(stderr, "cooperative launch failed: %s (grid %d)\n", hipGetErrorString(e), grid_blocks);
}
```

```cpp
#include <hip/hip_runtime.h>
#include <hip/hip_cooperative_groups.h>
#include <cstdio>
#include <cstdint>
namespace cg = cooperative_groups;

#define DI __device__ __forceinline__
typedef unsigned short u16;
typedef unsigned long long u64;
typedef __attribute__((ext_vector_type(8))) short bf16x8;
typedef __attribute__((ext_vector_type(4))) short s16x4;
typedef __attribute__((ext_vector_type(4))) float f32x4;
typedef __attribute__((ext_vector_type(16))) float f32x16;
typedef __attribute__((ext_vector_type(2))) __bf16 bf2_t;

constexpr int T_ = 8192;
constexpr int M_ = 65536;
constexpr float ALPHA_ = 1.189207115002721f;
constexpr float LOG2E_ = 1.4426950408889634f;

constexpr size_t AL(size_t x) { return (x + 255) & ~(size_t)255; }
constexpr size_t O_WT_IN   = 0;
constexpr size_t O_WT_UQ   = O_WT_IN   + AL((size_t)1792 * 1024 * 2);
constexpr size_t O_WT_UKV  = O_WT_UQ   + AL((size_t)768 * 256 * 2);
constexpr size_t O_WT_CK1  = O_WT_UKV  + AL((size_t)1024 * 128 * 2);
constexpr size_t O_WT_CV1  = O_WT_CK1  + AL((size_t)256 * 2048 * 2);
constexpr size_t O_WT_CK2  = O_WT_CV1  + AL((size_t)256 * 2048 * 2);
constexpr size_t O_WT_CV2  = O_WT_CK2  + AL((size_t)128 * 256 * 2);
constexpr size_t O_WT_OUT  = O_WT_CV2  + AL((size_t)128 * 256 * 2);
constexpr size_t O_WT_UP   = O_WT_OUT  + AL((size_t)1024 * 1024 * 2);
constexpr size_t O_WT_DOWN = O_WT_UP   + AL((size_t)5632 * 1024 * 2);
constexpr size_t O_WT_GATE = O_WT_DOWN + AL((size_t)1024 * 2816 * 2);
constexpr size_t O_WT_PLE  = O_WT_GATE + AL((size_t)1024 * 1024 * 2);
constexpr size_t O_BIAS1K  = O_WT_PLE  + AL((size_t)1024 * 256 * 2);
constexpr size_t O_BIAS1V  = O_BIAS1K  + AL(256 * 4);
constexpr size_t O_BIAS_UP = O_BIAS1V  + AL(256 * 4);
constexpr size_t O_BIAS_G  = O_BIAS_UP + AL(5632 * 4);
constexpr size_t O_CSUM_UP = O_BIAS_G  + AL(1024 * 4);
constexpr size_t O_CSUM_G  = O_CSUM_UP + AL(5632 * 4);
constexpr size_t O_ROPE_C  = O_CSUM_G  + AL(1024 * 4);
constexpr size_t O_ROPE_S  = O_ROPE_C  + AL((size_t)8192 * 16 * 4);
constexpr size_t O_STATS   = O_ROPE_S  + AL((size_t)8192 * 16 * 4);
constexpr size_t O_SSQ     = O_STATS   + AL((size_t)3 * M_ * 2 * 4);
constexpr size_t O_CTR     = O_SSQ     + AL((size_t)2 * M_ * 4);
constexpr size_t O_BAR     = O_CTR     + 256;
constexpr size_t O_HID     = O_BAR     + 16384;
constexpr size_t O_CMPK    = O_HID     + AL((size_t)2 * 8192 * 256 * 2);
constexpr size_t O_CMPVT   = O_CMPK    + AL((size_t)16 * 512 * 64 * 2);
constexpr size_t O_CONCAT  = O_CMPVT   + AL((size_t)16 * 64 * 512 * 2);
constexpr size_t O_Y2      = O_CONCAT  + AL((size_t)M_ * 1024 * 2);
constexpr size_t O_R1      = O_Y2      + AL((size_t)M_ * 1024 * 4);
constexpr size_t O_QN      = O_R1;
constexpr size_t O_KC      = O_QN   + AL((size_t)M_ * 512 * 2);
constexpr size_t O_VC      = O_KC   + AL((size_t)M_ * 128 * 2);
constexpr size_t O_KS      = O_VC   + AL((size_t)M_ * 128 * 2);
constexpr size_t O_VST     = O_KS   + AL((size_t)M_ * 128 * 2);
constexpr size_t O_KW      = O_VST  + AL((size_t)M_ * 128 * 2);
constexpr size_t O_VWT     = O_KW   + AL((size_t)M_ * 128 * 2);
constexpr size_t O_CQ      = O_VWT  + AL((size_t)M_ * 128 * 2);
constexpr size_t O_CKV     = O_CQ   + AL((size_t)M_ * 256 * 2);
constexpr size_t O_KPE     = O_CKV  + AL((size_t)M_ * 128 * 2);
constexpr size_t O_GATES   = O_KPE  + AL((size_t)M_ * 32 * 2);
constexpr size_t O_QM      = O_GATES + AL((size_t)M_ * 24 * 4);
constexpr size_t O_KN      = O_QM   + AL((size_t)M_ * 768 * 2);
constexpr size_t O_VMT     = O_KN   + AL((size_t)M_ * 512 * 2);
constexpr size_t O_R1_END  = O_VMT  + AL((size_t)M_ * 512 * 2);
constexpr size_t O_HBUF    = O_R1;
constexpr size_t O_PB      = O_R1 + AL((size_t)M_ * 2816 * 2);
static_assert(O_PB + (size_t)M_ * 256 * 2 <= O_R1_END, "PB alias");
static_assert(O_R1_END - O_R1 >= (size_t)M_ * 2816 * 2, "HBUF alias too small");
constexpr size_t O_YB      = O_R1_END;
constexpr size_t WS_NEED   = O_YB + AL((size_t)M_ * 1024 * 2);
static_assert(WS_NEED <= (size_t)1073741824, "workspace budget (4 x largest tensor)");

struct Params {
  const float *x, *p, *w_in, *w_ck1, *w_ck2, *pos_ck, *w_cv1, *w_cv2, *pos_cv, *qn_g, *w_uq, *kvn_g, *w_ukv, *w_out,
      *ln1_g, *ln1_b, *w_up, *w_down, *ln2_g, *ln2_b, *w_pg, *w_ple, *ln3_g, *ln3_b;
  float* out;
  unsigned char* ws;
};

DI unsigned pack2(float a, float b) { bf2_t v; v[0] = (__bf16)a; v[1] = (__bf16)b; return __builtin_bit_cast(unsigned, v); }
DI void store4bf(u16* p, float a, float b, float c, float d) { *(uint2*)p = make_uint2(pack2(a, b), pack2(c, d)); }
DI float bflo(unsigned u) { return __uint_as_float(u << 16); }
DI float bfhi(unsigned u) { return __uint_as_float(u & 0xffff0000u); }
DI float sigmoid_(float x) { return 1.f / (1.f + __expf(-x)); }
DI float gelu_tanh_(float x) {
  float u = 0.7978845608028654f * (x + 0.044715f * x * x * x);
  float e = __expf(2.f * u);
  float th = 1.f - 2.f / (e + 1.f);
  return 0.5f * x * (1.f + th);
}
DI float ex2(float x) { return __builtin_amdgcn_exp2f(x); }
#define MFMA16(a, b, c) __builtin_amdgcn_mfma_f32_16x16x32_bf16((a), (b), (c), 0, 0, 0)
#define MFMA32(a, b, c) __builtin_amdgcn_mfma_f32_32x32x16_bf16((a), (b), (c), 0, 0, 0)

DI int map_in(int n) {
  if (n < 1280) return n;
  if (n < 1536) return 1304 + (n - 1280);
  if (n < 1664) return 1560 + (n - 1536);
  if (n < 1696) return 1688 + (n - 1664);
  if (n < 1720) return 1280 + (n - 1696);
  return -1;
}
DI int map_up(int n) {
  int t = n >> 7, c = n & 127, wc = c >> 6, j = (c >> 4) & 3, i = c & 15;
  int base = 64 * t + wc * 32 + (i >> 2) * 8 + (j & 1) * 4 + (i & 3);
  return (j < 2) ? base : 2816 + base;
}

struct TJob { const float* src; u16* dst; const float* scale; int K, Nsrc, map; };
DI TJob get_tjob(const Params& P, int j) {
  TJob t; t.scale = nullptr; t.map = 0;
  unsigned char* ws = P.ws;
  switch (j) {
    case 0: t.src = P.w_in; t.dst = (u16*)(ws + O_WT_IN); t.K = 1024; t.Nsrc = 1720; t.map = 1; break;
    case 1: t.src = P.w_uq; t.dst = (u16*)(ws + O_WT_UQ); t.K = 256; t.Nsrc = 768; t.scale = P.qn_g; break;
    case 2: t.src = P.w_ukv; t.dst = (u16*)(ws + O_WT_UKV); t.K = 128; t.Nsrc = 1024; t.scale = P.kvn_g; break;
    case 3: t.src = P.w_ck1; t.dst = (u16*)(ws + O_WT_CK1); t.K = 2048; t.Nsrc = 256; break;
    case 4: t.src = P.w_cv1; t.dst = (u16*)(ws + O_WT_CV1); t.K = 2048; t.Nsrc = 256; break;
    case 5: t.src = P.w_ck2; t.dst = (u16*)(ws + O_WT_CK2); t.K = 256; t.Nsrc = 64; break;
    case 6: t.src = P.w_cv2; t.dst = (u16*)(ws + O_WT_CV2); t.K = 256; t.Nsrc = 64; break;
    case 7: t.src = P.w_out; t.dst = (u16*)(ws + O_WT_OUT); t.K = 1024; t.Nsrc = 1024; break;
    case 8: t.src = P.w_up; t.dst = (u16*)(ws + O_WT_UP); t.K = 1024; t.Nsrc = 5632; t.map = 2; t.scale = P.ln1_g; break;
    case 9: t.src = P.w_down; t.dst = (u16*)(ws + O_WT_DOWN); t.K = 2816; t.Nsrc = 1024; break;
    case 10: t.src = P.w_pg; t.dst = (u16*)(ws + O_WT_GATE); t.K = 1024; t.Nsrc = 1024; t.scale = P.ln2_g; break;
    default: t.src = P.w_ple; t.dst = (u16*)(ws + O_WT_PLE); t.K = 256; t.Nsrc = 1024; break;
  }
  return t;
}

DI void phase0(const Params& P, unsigned char* smem, int tid) {
  const int NTL[12] = {448, 48, 32, 128, 128, 4, 4, 256, 1408, 704, 256, 64};
  constexpr int TOT_T = 3480;
  constexpr int TOT_U = TOT_T + 896;
  float* tl = (float*)smem;
  for (int pass = 0; pass < 2; ++pass) {
  if ((pass ^ (int)(blockIdx.x >> 3)) & 1) {
  for (int u = blockIdx.x; u < TOT_U; u += gridDim.x) {
    __syncthreads();
    if (u < TOT_T) {
      int j = 0, ti = u;
#pragma unroll
      for (int q = 0; q < 12; ++q) { if (j == q && ti >= NTL[q]) { ti -= NTL[q]; j = q + 1; } }
      TJob jb = get_tjob(P, j);
      const int nkt = jb.K >> 6;
      const int k0 = (ti % nkt) * 64, n0 = (ti / nkt) * 64;
#pragma unroll
      for (int i = 0; i < 16; ++i) {
        int kk = i * 4 + (tid >> 6), nn = tid & 63;
        int n = n0 + nn;
        int sn = (jb.map == 1) ? map_in(n) : (jb.map == 2 ? map_up(n) : n);
        float v = 0.f;
        if (sn >= 0) v = jb.src[(long)(k0 + kk) * jb.Nsrc + sn];
        if (jb.scale) v *= jb.scale[k0 + kk];
        tl[kk * 65 + nn] = v;
      }
      __syncthreads();
      {
        int n = tid >> 2, kq = tid & 3;
        unsigned w[8];
#pragma unroll
        for (int e = 0; e < 8; ++e) w[e] = pack2(tl[(kq * 16 + 2 * e) * 65 + n], tl[(kq * 16 + 2 * e + 1) * 65 + n]);
        u16* d = jb.dst + (long)(n0 + n) * jb.K + k0 + kq * 16;
        *(uint4*)d = make_uint4(w[0], w[1], w[2], w[3]);
        *(uint4*)(d + 8) = make_uint4(w[4], w[5], w[6], w[7]);
      }
    } else {
      int bu = u - TOT_T;
      const float* vec; const float* vec2 = nullptr; const float* W; float* dst; float* dst2 = nullptr; int K, Nsrc, mp = 0;
      if (bu < 32) { vec = P.pos_ck; W = P.w_ck1; dst = (float*)(P.ws + O_BIAS1K); K = 2048; Nsrc = 256; }
      else if (bu < 64) { bu -= 32; vec = P.pos_cv; W = P.w_cv1; dst = (float*)(P.ws + O_BIAS1V); K = 2048; Nsrc = 256; }
      else if (bu < 768) { bu -= 64; vec = P.ln1_b; vec2 = P.ln1_g; W = P.w_up; dst = (float*)(P.ws + O_BIAS_UP); dst2 = (float*)(P.ws + O_CSUM_UP); K = 1024; Nsrc = 5632; mp = 2; }
      else { bu -= 768; vec = P.ln2_b; vec2 = P.ln2_g; W = P.w_pg; dst = (float*)(P.ws + O_BIAS_G); dst2 = (float*)(P.ws + O_CSUM_G); K = 1024; Nsrc = 1024; }
      int c = tid & 7, kg = tid >> 3;
      int n = bu * 8 + c;
      int sn = (mp == 2) ? map_up(n) : n;
      float sa = 0.f, sb = 0.f;
      if (vec2) {
#pragma unroll 8
        for (int k = kg; k < K; k += 32) { const float w = W[(long)k * Nsrc + sn]; sa += vec[k] * w; sb += vec2[k] * w; }
      } else {
#pragma unroll 8
        for (int k = kg; k < K; k += 32) sa += vec[k] * W[(long)k * Nsrc + sn];
      }
      tl[kg * 8 + c] = sa; tl[256 + kg * 8 + c] = sb;
      __syncthreads();
      if (tid < 8) {
        float a0 = 0.f, a1 = 0.f;
#pragma unroll
        for (int q = 0; q < 32; ++q) { a0 += tl[q * 8 + tid]; a1 += tl[256 + q * 8 + tid]; }
        dst[bu * 8 + tid] = a0;
        if (dst2) dst2[bu * 8 + tid] = a1;
      }
    }
  }
  } else {
    const long gtid0 = (long)blockIdx.x * 256 + tid, gstr0 = (long)gridDim.x * 256;
    u16* xb = (u16*)(P.ws + O_CONCAT);
    for (long i = gtid0; i < (long)M_ * 1024 / 8; i += gstr0) {
      const float4 a = *(const float4*)(P.x + i * 8), b = *(const float4*)(P.x + i * 8 + 4);
      *(uint4*)(xb + i * 8) = make_uint4(pack2(a.x, a.y), pack2(a.z, a.w), pack2(b.x, b.y), pack2(b.z, b.w));
    }
  }
  }
  const long gtid = (long)blockIdx.x * 256 + tid, gstr = (long)gridDim.x * 256;
  float* rc = (float*)(P.ws + O_ROPE_C);
  float* rs = (float*)(P.ws + O_ROPE_S);
  for (long i = gtid; i < 8192 * 16; i += gstr) {
    int pos = (int)(i >> 4), f = (int)(i & 15);
    float inv = powf(10000.0f, -(float)f / 16.0f);
    float ang = (float)pos * inv;
    rc[i] = cosf(ang); rs[i] = sinf(ang);
  }
  float* st = (float*)(P.ws + O_STATS);
  for (long i = gtid; i < (long)3 * M_ * 2; i += gstr) st[i] = 0.f;
  { float* sq = (float*)(P.ws + O_SSQ); for (long i = gtid; i < (long)2 * M_; i += gstr) sq[i] = 0.f; }
  if (gtid < 64) ((int*)(P.ws + O_CTR))[gtid] = 0;
}

constexpr int LDS_BUF = 32768;
constexpr int LDS_RS_OFF = 2 * LDS_BUF;

template <int AMODE, int FAKE = 0>
DI void gemm_mainloop(f32x4 (&acc)[4][4], unsigned char* smem, const void* A, long lda, int m0, int K,
                      const u16* Bt, int n0, const float* stats, bool ns, int tid) {
  const int lane = tid & 63, wave = tid >> 6, wm = wave >> 1, wn = wave & 1;
  const int l16 = lane & 15, lq = lane >> 4;
  const int crow = tid >> 3, cch = tid & 7;
  int gtok0 = 0;
  const int nk = K >> 6;
  const int swz = (cch ^ (crow & 7)) * 8;
  const unsigned boff = ((unsigned)(n0 + crow) * (unsigned)K + (unsigned)cch * 8u) * 2u;
  const unsigned bstrb = 64u * (unsigned)K;
  unsigned aoff = 0u; const unsigned astrb = 64u * (unsigned)lda;
  if constexpr (AMODE == 0) aoff = ((unsigned)(m0 + crow) * (unsigned)lda + (unsigned)cch * 8u) * 2u;
  if constexpr (AMODE == 3) { const int r_ = m0 + crow; const int bg_ = r_ >> 9; gtok0 = (r_ & 511) * 16;
    aoff = ((unsigned)(bg_ >> 1) * (unsigned)T_ * 128u + (unsigned)(bg_ & 1) * 64u + (unsigned)cch * 8u) * 2u; }
  const unsigned gch = (unsigned)(cch ^ (crow & 7)) * 16u;
  const unsigned boffd = ((unsigned)(n0 + crow) * (unsigned)K) * 2u + gch;
  unsigned aoffd = 0u;
  if constexpr (AMODE == 0) aoffd = ((unsigned)(m0 + crow) * (unsigned)lda) * 2u + gch;
  if constexpr (AMODE == 3) { const int r_ = m0 + crow; const int bg_ = r_ >> 9;
    aoffd = ((unsigned)(bg_ >> 1) * (unsigned)T_ * 128u + (unsigned)(bg_ & 1) * 64u) * 2u + gch; }
  const int wbase = __builtin_amdgcn_readfirstlane(wave) * 1024;
#define GP(base_, off_) ((const unsigned*)((const char*)(base_) + (unsigned)(off_)))
#define LP(BUF, off_) ((unsigned*)(smem + (BUF) * LDS_BUF + wbase + (off_)))
#define D_LOAD(BUF, ks) { const unsigned qb_ = boffd + (unsigned)(ks) * 128u; \
    __builtin_amdgcn_global_load_lds(GP(Bt, qb_), LP(BUF, 16384), 16, 0, 0); \
    __builtin_amdgcn_global_load_lds(GP(Bt, qb_ + bstrb), LP(BUF, 16384 + 4096), 16, 0, 0); \
    __builtin_amdgcn_global_load_lds(GP(Bt, qb_ + 2u * bstrb), LP(BUF, 16384 + 8192), 16, 0, 0); \
    __builtin_amdgcn_global_load_lds(GP(Bt, qb_ + 3u * bstrb), LP(BUF, 16384 + 12288), 16, 0, 0); \
    if constexpr (AMODE == 0) { const unsigned qa_ = aoffd + (unsigned)(ks) * 128u; \
      __builtin_amdgcn_global_load_lds(GP(A, qa_), LP(BUF, 0), 16, 0, 0); \
      __builtin_amdgcn_global_load_lds(GP(A, qa_ + astrb), LP(BUF, 4096), 16, 0, 0); \
      __builtin_amdgcn_global_load_lds(GP(A, qa_ + 2u * astrb), LP(BUF, 8192), 16, 0, 0); \
      __builtin_amdgcn_global_load_lds(GP(A, qa_ + 3u * astrb), LP(BUF, 12288), 16, 0, 0); } \
    else { \
      __builtin_amdgcn_global_load_lds(GP(A, aoffd + (unsigned)min(gtok0 + (ks), T_ - 1) * 256u), LP(BUF, 0), 16, 0, 0); \
      __builtin_amdgcn_global_load_lds(GP(A, aoffd + (unsigned)min(gtok0 + 512 + (ks), T_ - 1) * 256u), LP(BUF, 4096), 16, 0, 0); \
      __builtin_amdgcn_global_load_lds(GP(A, aoffd + (unsigned)min(gtok0 + 1024 + (ks), T_ - 1) * 256u), LP(BUF, 8192), 16, 0, 0); \
      __builtin_amdgcn_global_load_lds(GP(A, aoffd + (unsigned)min(gtok0 + 1536 + (ks), T_ - 1) * 256u), LP(BUF, 12288), 16, 0, 0); } }
#define D_SYNC() { asm volatile("s_waitcnt vmcnt(0)" ::: "memory"); asm volatile("s_waitcnt lgkmcnt(0)" ::: "memory"); __builtin_amdgcn_s_barrier(); asm volatile("" ::: "memory"); }
#define G_ROW(mi, fa_) \
      if (ns) { acc[mi][0] = MFMA16(fa_, fb0, acc[mi][0]); acc[mi][1] = MFMA16(fa_, fb1, acc[mi][1]); acc[mi][2] = MFMA16(fa_, fb2, acc[mi][2]); acc[mi][3] = MFMA16(fa_, fb3, acc[mi][3]); } \
      else    { acc[mi][0] = MFMA16(fb0, fa_, acc[mi][0]); acc[mi][1] = MFMA16(fb1, fa_, acc[mi][1]); acc[mi][2] = MFMA16(fb2, fa_, acc[mi][2]); acc[mi][3] = MFMA16(fb3, fa_, acc[mi][3]); }
#define G_HALF(BUF, kk) { \
      const int co = (((kk) * 4 + lq) ^ (l16 & 7)) * 8; \
      const u16* pa = (const u16*)(smem + (BUF) * LDS_BUF) + (wm * 64 + l16) * 64 + co; \
      const u16* pb = (const u16*)(smem + (BUF) * LDS_BUF) + 8192 + (wn * 64 + l16) * 64 + co; \
      const bf16x8 fa0 = *(const bf16x8*)pa, fa1 = *(const bf16x8*)(pa + 16 * 64), fa2 = *(const bf16x8*)(pa + 32 * 64), fa3 = *(const bf16x8*)(pa + 48 * 64); \
      const bf16x8 fb0 = *(const bf16x8*)pb, fb1 = *(const bf16x8*)(pb + 16 * 64), fb2 = *(const bf16x8*)(pb + 32 * 64), fb3 = *(const bf16x8*)(pb + 48 * 64); \
      G_ROW(0, fa0) G_ROW(1, fa1) G_ROW(2, fa2) G_ROW(3, fa3) }
#define R_STEP(CUR, ks) { \
    if ((ks) + 1 < nk && FAKE != 1) D_LOAD((CUR) ^ 1, (ks) + 1) \
    __builtin_amdgcn_sched_barrier(0); \
    if (FAKE != 2) { G_HALF(CUR, 0) G_HALF(CUR, 1) } \
    D_SYNC() }
  __syncthreads();
  D_LOAD(0, 0)
  D_SYNC()
  for (int ks = 0; ks < nk; ks += 2) {
    R_STEP(0, ks)
    if (ks + 1 < nk) R_STEP(1, ks + 1)
  }
#undef GP
#undef LP
#undef D_LOAD
#undef D_SYNC
#undef G_ROW
#undef G_HALF
#undef R_STEP
}

constexpr int LDS_BIG = 24576;
template <int FAKE = 0>
DI void gemm_mainloop_big(f32x4 (&acc)[8][4], unsigned char* smem, const void* A, long lda, int m0, int K,
                          const u16* Bt, int n0, bool ns, int tid) {
  const int lane = tid & 63, wave = tid >> 6, wm = wave >> 1, wn = wave & 1;
  const int l16 = lane & 15, lq = lane >> 4;
  const int nk = K >> 5;
  const int prow = lane >> 2, ppos = lane & 3;
  const unsigned gch = (unsigned)(ppos ^ ((4 - ((lane >> 4) & 3)) & 3)) * 16u;
  const unsigned aoffd = ((unsigned)(m0 + 16 * wave + prow) * (unsigned)lda) * 2u + gch;
  const unsigned boffd = ((unsigned)(n0 + 16 * wave + prow) * (unsigned)K) * 2u + gch;
  const unsigned astrb = 128u * (unsigned)lda, bstrb = 128u * (unsigned)K;
  const int wbase = __builtin_amdgcn_readfirstlane(wave) * 1024;
#define GP(base_, off_) ((const unsigned*)((const char*)(base_) + (unsigned)(off_)))
#define LP(BUF, off_) ((unsigned*)(smem + (BUF) * LDS_BIG + wbase + (off_)))
#define D_LOAD(BUF, ks) { const unsigned ko_ = (unsigned)(ks) * 64u; \
    __builtin_amdgcn_global_load_lds(GP(A, aoffd + ko_), LP(BUF, 0), 16, 0, 0); \
    __builtin_amdgcn_global_load_lds(GP(A, aoffd + ko_ + astrb), LP(BUF, 4096), 16, 0, 0); \
    __builtin_amdgcn_global_load_lds(GP(A, aoffd + ko_ + 2u * astrb), LP(BUF, 8192), 16, 0, 0); \
    __builtin_amdgcn_global_load_lds(GP(A, aoffd + ko_ + 3u * astrb), LP(BUF, 12288), 16, 0, 0); \
    __builtin_amdgcn_global_load_lds(GP(Bt, boffd + ko_), LP(BUF, 16384), 16, 0, 0); \
    __builtin_amdgcn_global_load_lds(GP(Bt, boffd + ko_ + bstrb), LP(BUF, 16384 + 4096), 16, 0, 0); }
#define D_SYNC() { asm volatile("s_waitcnt vmcnt(0)" ::: "memory"); asm volatile("s_waitcnt lgkmcnt(0)" ::: "memory"); __builtin_amdgcn_s_barrier(); asm volatile("" ::: "memory"); }
  const int pp = (lq ^ ((4 - ((l16 >> 2) & 3)) & 3)) * 8;
#define B_ROW(mi) { const bf16x8 fa_ = *(const bf16x8*)(pa + (mi) * 16 * 32); \
      if (ns) { acc[mi][0] = MFMA16(fa_, fb0, acc[mi][0]); acc[mi][1] = MFMA16(fa_, fb1, acc[mi][1]); acc[mi][2] = MFMA16(fa_, fb2, acc[mi][2]); acc[mi][3] = MFMA16(fa_, fb3, acc[mi][3]); } \
      else    { acc[mi][0] = MFMA16(fb0, fa_, acc[mi][0]); acc[mi][1] = MFMA16(fb1, fa_, acc[mi][1]); acc[mi][2] = MFMA16(fb2, fa_, acc[mi][2]); acc[mi][3] = MFMA16(fb3, fa_, acc[mi][3]); } }
#define B_COMPUTE(BUF) { \
      const u16* pa = (const u16*)(smem + (BUF) * LDS_BIG) + (wm * 128 + l16) * 32 + pp; \
      const u16* pb = (const u16*)(smem + (BUF) * LDS_BIG + 16384) + (wn * 64 + l16) * 32 + pp; \
      const bf16x8 fb0 = *(const bf16x8*)pb, fb1 = *(const bf16x8*)(pb + 16 * 32), fb2 = *(const bf16x8*)(pb + 32 * 32), fb3 = *(const bf16x8*)(pb + 48 * 32); \
      B_ROW(0) B_ROW(1) B_ROW(2) B_ROW(3) B_ROW(4) B_ROW(5) B_ROW(6) B_ROW(7) }
#define B_STEP(CUR, ks) { \
    if ((ks) + 1 < nk && FAKE != 1) D_LOAD((CUR) ^ 1, (ks) + 1) \
    __builtin_amdgcn_sched_barrier(0); \
    if (FAKE != 2) B_COMPUTE(CUR) \
    D_SYNC() }
  __syncthreads();
  D_LOAD(0, 0)
  D_SYNC()
  for (int ks = 0; ks < nk; ks += 2) {
    B_STEP(0, ks)
    if (ks + 1 < nk) B_STEP(1, ks + 1)
  }
#undef GP
#undef LP
#undef D_LOAD
#undef D_SYNC
#undef B_ROW
#undef B_COMPUTE
#undef B_STEP
}

template <int MI>
DI void zero_acc(f32x4 (&acc)[MI][4]) {
#pragma unroll
  for (int i = 0; i < MI; ++i)
#pragma unroll
    for (int j = 0; j < 4; ++j) acc[i][j] = f32x4{0.f, 0.f, 0.f, 0.f};
}

DI void stat_push(float* stats, int tok, float s1, float s2, int lq) {
  s1 += __shfl_xor(s1, 16); s2 += __shfl_xor(s2, 16);
  s1 += __shfl_xor(s1, 32); s2 += __shfl_xor(s2, 32);
  if (lq == 0) { atomicAdd(stats + 2 * (long)tok, s1); atomicAdd(stats + 2 * (long)tok + 1, s2); }
}

enum { PH_IN = 1, PH_UQ, PH_UKV, PH_C1, PH_C2, PH_OUT, PH_UP, PH_DOWN, PH_PLE };

template <int PH, int FAKE = 0>
DI void gemm_tile(const Params& P, unsigned char* smem, int mt, int nt, int which, int tid_in) {
  int tid = tid_in;
  asm volatile("" : "+v"(tid));
  unsigned char* ws = P.ws;
  const int lane = tid & 63, wave = tid >> 6, wm = wave >> 1, wn = wave & 1;
  const int l16 = lane & 15, lq = lane >> 4;
  constexpr int MI = (PH == PH_OUT || PH == PH_UP || PH == PH_DOWN || PH == PH_PLE) ? 8 : 4;
  constexpr int WR = MI * 16;
  const int m0 = mt * (2 * WR), n0 = nt * 128;
  f32x4 acc[MI][4];
  zero_acc<MI>(acc);
  float* rsq = (float*)(smem + LDS_RS_OFF);

  if constexpr (PH == PH_IN) {
    const bool ns = (nt == 7 || nt == 9);
    gemm_mainloop<0>(acc, smem, (const u16*)(ws + O_CONCAT), 1024, m0, 1024, (const u16*)(ws + O_WT_IN), n0, nullptr, ns, tid);
    const float QSC = 0.125f * LOG2E_;
    unsigned char* swv = smem + wave * 18432;
#pragma unroll
    for (int mi = 0; mi < MI; ++mi) {
      if (!ns) {
        const int tok = m0 + wm * WR + mi * 16 + l16;
        if (nt < 4) {
#pragma unroll
          for (int nj = 0; nj < 4; ++nj) {
            int col = n0 + wn * 64 + nj * 16 + lq * 4;
            f32x4 a = acc[mi][nj];
            *(uint2*)(swv + (mi * 16 + l16) * 144 + nj * 32 + lq * 8) = make_uint2(pack2(a[0] * QSC, a[1] * QSC), pack2(a[2] * QSC, a[3] * QSC));
          }
        } else if (nt == 4 || nt == 5 || nt == 6 || nt == 8 || nt == 12) {
          u16* dst = (u16*)(ws + (nt == 4 ? O_KC : nt == 5 ? O_VC : nt == 6 ? O_KS : nt == 8 ? O_KW : O_CKV));
          float ss = 0.f;
#pragma unroll
          for (int nj = 0; nj < 4; ++nj) {
            int col = wn * 64 + nj * 16 + lq * 4;
            f32x4 a = acc[mi][nj];
            ss += a[0] * a[0] + a[1] * a[1] + a[2] * a[2] + a[3] * a[3];
            *(uint2*)(swv + (mi * 16 + l16) * 144 + nj * 32 + lq * 8) = make_uint2(pack2(a[0], a[1]), pack2(a[2], a[3]));
          }
          if (nt == 12) {
            ss += __shfl_xor(ss, 16); ss += __shfl_xor(ss, 32);
            if (lq == 0) atomicAdd((float*)(ws + O_SSQ) + M_ + tok, ss);
          }
        } else if (nt == 10 || nt == 11) {
          float ss = 0.f;
#pragma unroll
          for (int nj = 0; nj < 4; ++nj) {
            int col = (nt - 10) * 128 + wn * 64 + nj * 16 + lq * 4;
            f32x4 a = acc[mi][nj];
            ss += a[0] * a[0] + a[1] * a[1] + a[2] * a[2] + a[3] * a[3];
            *(uint2*)(swv + (mi * 16 + l16) * 144 + nj * 32 + lq * 8) = make_uint2(pack2(a[0], a[1]), pack2(a[2], a[3]));
          }
          ss += __shfl_xor(ss, 16); ss += __shfl_xor(ss, 32);
          if (lq == 0) atomicAdd((float*)(ws + O_SSQ) + tok, ss);
        } else {
          if (wn == 0) {
            const int pos = tok & (T_ - 1);
            const float4 cs = *(const float4*)((const float*)(ws + O_ROPE_C) + pos * 16 + lq * 4);
            const float4 sn = *(const float4*)((const float*)(ws + O_ROPE_S) + pos * 16 + lq * 4);
            f32x4 x1 = acc[mi][0], x2 = acc[mi][1];
            u16* kp = (u16*)(ws + O_KPE) + (long)tok * 32;
            store4bf(kp + lq * 4, x1[0] * cs.x - x2[0] * sn.x, x1[1] * cs.y - x2[1] * sn.y, x1[2] * cs.z - x2[2] * sn.z, x1[3] * cs.w - x2[3] * sn.w);
            store4bf(kp + 16 + lq * 4, x2[0] * cs.x + x1[0] * sn.x, x2[1] * cs.y + x1[1] * sn.y, x2[2] * cs.z + x1[2] * sn.z, x2[3] * cs.w + x1[3] * sn.w);
            float* gp = (float*)(ws + O_GATES) + (long)tok * 24;
            f32x4 g0 = acc[mi][2], g1 = acc[mi][3];
            *(float4*)(gp + lq * 4) = make_float4(sigmoid_(g0[0]), sigmoid_(g0[1]), sigmoid_(g0[2]), sigmoid_(g0[3]));
            if (lq < 2) *(float4*)(gp + 16 + lq * 4) = make_float4(sigmoid_(g1[0]), sigmoid_(g1[1]), sigmoid_(g1[2]), sigmoid_(g1[3]));
          }
        }
      } else {
        const int tok4 = m0 + wm * WR + mi * 16 + lq * 4;
        const int b = tok4 >> 13, t = tok4 & (T_ - 1);
        u16* dstb = (u16*)(ws + (nt == 7 ? O_VST : O_VWT));
#pragma unroll
        for (int nj = 0; nj < 4; ++nj) {
          int c = wn * 64 + nj * 16 + l16, g = c >> 6, d = c & 63;
          f32x4 a = acc[mi][nj];
          store4bf(dstb + ((long)((b * 2 + g) * 64 + d)) * T_ + t, a[0], a[1], a[2], a[3]);
        }
      }
    }
    if (!ns && nt != 13) {
      asm volatile("s_waitcnt lgkmcnt(0)" ::: "memory");
      u16* dbase; int ldd, coff;
      if (nt < 4) { dbase = (u16*)(ws + O_QN); ldd = 512; coff = n0 + wn * 64; }
      else if (nt == 10 || nt == 11) { dbase = (u16*)(ws + O_CQ); ldd = 256; coff = (nt - 10) * 128 + wn * 64; }
      else { dbase = (u16*)(ws + (nt == 4 ? O_KC : nt == 5 ? O_VC : nt == 6 ? O_KS : nt == 8 ? O_KW : O_CKV)); ldd = 128; coff = wn * 64; }
#pragma unroll
      for (int r = 0; r < 8; ++r) {
        const int row = r * 8 + (lane >> 3), ch = lane & 7;
        const uint4 v = *(const uint4*)(swv + row * 144 + ch * 16);
        *(uint4*)(dbase + (long)(m0 + wm * WR + row) * ldd + coff + ch * 8) = v;
      }
    }
  }

  if constexpr (PH == PH_UQ || PH == PH_UKV) {
    constexpr int K = (PH == PH_UQ) ? 256 : 128;
    const u16* A = (const u16*)(ws + (PH == PH_UQ ? O_CQ : O_CKV));
    __syncthreads();
    if (tid < 128) {
      const float ss = ((const float*)(ws + O_SSQ))[(PH == PH_UQ ? 0 : M_) + m0 + tid];
      rsq[tid] = rsqrtf(ss * (1.f / K) + 1e-6f);
    }
    if constexpr (PH == PH_UQ) {
      gemm_mainloop<0>(acc, smem, A, 256, m0, 256, (const u16*)(ws + O_WT_UQ), n0, nullptr, false, tid);
      const float SC = 0.10206207261596577f * LOG2E_;
#pragma unroll
      for (int mi = 0; mi < MI; ++mi) {
        const int tok = m0 + wm * WR + mi * 16 + l16;
        const float rs = rsq[wm * WR + mi * 16 + l16] * SC;
        const int pos = tok & (T_ - 1);
        const int ct0 = nt * 8 + wn * 4;
#pragma unroll
        for (int njp = 0; njp < 4; njp += 2) {
          f32x4 a = acc[mi][njp], b2 = acc[mi][njp + 1];
          if (((ct0 + njp) % 6) == 4) {
            const float4 cs = *(const float4*)((const float*)(ws + O_ROPE_C) + pos * 16 + lq * 4);
            const float4 sn = *(const float4*)((const float*)(ws + O_ROPE_S) + pos * 16 + lq * 4);
            f32x4 o1, o2;
            o1[0] = a[0] * cs.x - b2[0] * sn.x; o2[0] = b2[0] * cs.x + a[0] * sn.x;
            o1[1] = a[1] * cs.y - b2[1] * sn.y; o2[1] = b2[1] * cs.y + a[1] * sn.y;
            o1[2] = a[2] * cs.z - b2[2] * sn.z; o2[2] = b2[2] * cs.z + a[2] * sn.z;
            o1[3] = a[3] * cs.w - b2[3] * sn.w; o2[3] = b2[3] * cs.w + a[3] * sn.w;
            a = o1; b2 = o2;
          }
          u16* dst = (u16*)(ws + O_QM) + (long)tok * 768 + n0 + wn * 64 + njp * 16 + lq * 4;
          store4bf(dst, a[0] * rs, a[1] * rs, a[2] * rs, a[3] * rs);
          store4bf(dst + 16, b2[0] * rs, b2[1] * rs, b2[2] * rs, b2[3] * rs);
        }
      }
    } else {
      const bool ns = (wn == 1);
      gemm_mainloop<0>(acc, smem, A, 128, m0, 128, (const u16*)(ws + O_WT_UKV), n0, nullptr, ns, tid);
#pragma unroll
      for (int mi = 0; mi < MI; ++mi) {
        if (!ns) {
          const int tok = m0 + wm * WR + mi * 16 + l16;
          const float rs = rsq[wm * WR + mi * 16 + l16];
#pragma unroll
          for (int nj = 0; nj < 4; ++nj) {
            f32x4 a = acc[mi][nj];
            store4bf((u16*)(ws + O_KN) + (long)tok * 512 + nt * 64 + nj * 16 + lq * 4, a[0] * rs, a[1] * rs, a[2] * rs, a[3] * rs);
          }
        } else {
          const int lr = wm * WR + mi * 16 + lq * 4;
          const int tok4 = m0 + lr;
          const int b = tok4 >> 13, t = tok4 & (T_ - 1);
          const float r0 = rsq[lr], r1 = rsq[lr + 1], r2 = rsq[lr + 2], r3 = rsq[lr + 3];
#pragma unroll
          for (int nj = 0; nj < 4; ++nj) {
            int d = nj * 16 + l16;
            f32x4 a = acc[mi][nj];
            store4bf((u16*)(ws + O_VMT) + ((long)((b * 8 + nt) * 64 + d)) * T_ + t, a[0] * r0, a[1] * r1, a[2] * r2, a[3] * r3);
          }
        }
      }
    }
  }

  if constexpr (PH == PH_C1) {
    const u16* A = (const u16*)(ws + (which ? O_VC : O_KC));
    const u16* Bt = (const u16*)(ws + (which ? O_WT_CV1 : O_WT_CK1));
    const float* bias = (const float*)(ws + (which ? O_BIAS1V : O_BIAS1K));
    gemm_mainloop<3>(acc, smem, A, 128, m0, 2048, Bt, n0, nullptr, false, tid);
    u16* hid = (u16*)(ws + O_HID) + (long)which * 8192 * 256;
#pragma unroll
    for (int mi = 0; mi < MI; ++mi) {
      const int row = m0 + wm * WR + mi * 16 + l16;
#pragma unroll
      for (int nj = 0; nj < 4; ++nj) {
        int col = n0 + wn * 64 + nj * 16 + lq * 4;
        const float4 bb = *(const float4*)(bias + col);
        f32x4 a = acc[mi][nj];
        store4bf(hid + (long)row * 256 + col, gelu_tanh_(a[0] + bb.x), gelu_tanh_(a[1] + bb.y), gelu_tanh_(a[2] + bb.z), gelu_tanh_(a[3] + bb.w));
      }
    }
  }

  if constexpr (PH == PH_C2) {
    const u16* A = (const u16*)(ws + O_HID) + (long)which * 8192 * 256;
    const u16* Bt = (const u16*)(ws + (which ? O_WT_CV2 : O_WT_CK2));
    const bool ns = (which == 1);
    gemm_mainloop<0>(acc, smem, A, 256, m0, 256, Bt, 0, nullptr, ns, tid);
    if (wn == 0) {
#pragma unroll
      for (int mi = 0; mi < MI; ++mi) {
        if (!ns) {
          const int row = m0 + wm * WR + mi * 16 + l16;
#pragma unroll
          for (int nj = 0; nj < 4; ++nj) {
            f32x4 a = acc[mi][nj];
            store4bf((u16*)(ws + O_CMPK) + (long)row * 64 + nj * 16 + lq * 4, a[0], a[1], a[2], a[3]);
          }
        } else {
          const int r4 = m0 + wm * WR + mi * 16 + lq * 4;
          const int bg = r4 >> 9, c = r4 & 511;
#pragma unroll
          for (int nj = 0; nj < 4; ++nj) {
            int d = nj * 16 + l16;
            f32x4 a = acc[mi][nj];
            store4bf((u16*)(ws + O_CMPVT) + ((long)(bg * 64 + d)) * 512 + c, a[0], a[1], a[2], a[3]);
          }
        }
      }
    }
  }

  if constexpr (PH == PH_OUT) {
    gemm_mainloop_big<0>(acc, smem, (const u16*)(ws + O_CONCAT), 1024, m0, 1024, (const u16*)(ws + O_WT_OUT), n0, false, tid);
    float* stats = (float*)(ws + O_STATS);
    unsigned char* swv = smem + wave * 18432;
#pragma unroll
    for (int mi = 0; mi < MI; ++mi) {
      const int tok = m0 + wm * WR + mi * 16 + l16;
      float s1 = 0.f, s2 = 0.f;
#pragma unroll
      for (int nj = 0; nj < 4; ++nj) {
        int col = n0 + wn * 64 + nj * 16 + lq * 4;
        const float4 xv = *(const float4*)(P.x + (long)tok * 1024 + col);
        f32x4 a = acc[mi][nj];
        float4 y = make_float4(ALPHA_ * xv.x + a[0], ALPHA_ * xv.y + a[1], ALPHA_ * xv.z + a[2], ALPHA_ * xv.w + a[3]);
        *(uint2*)(swv + (mi * 16 + l16) * 144 + nj * 32 + lq * 8) = make_uint2(pack2(y.x, y.y), pack2(y.z, y.w));
        s1 += y.x + y.y + y.z + y.w;
        s2 += y.x * y.x + y.y * y.y + y.z * y.z + y.w * y.w;
      }
      stat_push(stats, tok, s1, s2, lq);
    }
    asm volatile("s_waitcnt lgkmcnt(0)" ::: "memory");
    {
      u16* yb = (u16*)(ws + O_YB) + (long)(m0 + wm * WR) * 1024 + n0 + wn * 64;
#pragma unroll
      for (int r = 0; r < 16; ++r) {
        const int row = r * 8 + (lane >> 3), ch = lane & 7;
        const uint4 v = *(const uint4*)(swv + row * 144 + ch * 16);
        *(uint4*)(yb + (long)row * 1024 + ch * 8) = v;
      }
    }
  }

  if constexpr (PH == PH_UP) {
    gemm_mainloop_big<FAKE>(acc, smem, (const u16*)(ws + O_YB), 1024, m0, 1024, (const u16*)(ws + O_WT_UP), n0, false, tid);
    if (FAKE != 0 && acc[0][0][0] + acc[3][3][3] + acc[1][2][1] != 123456.75f) return;
    const float* bias = (const float*)(ws + O_BIAS_UP);
    const float* csum = (const float*)(ws + O_CSUM_UP);
    const float* st1 = (const float*)(ws + O_STATS);
    const int cb0 = n0 + wn * 64 + lq * 4;
    const float4 bgv[2] = {*(const float4*)(bias + cb0), *(const float4*)(bias + cb0 + 16)};
    const float4 buv[2] = {*(const float4*)(bias + cb0 + 32), *(const float4*)(bias + cb0 + 48)};
    const float4 cgv[2] = {*(const float4*)(csum + cb0), *(const float4*)(csum + cb0 + 16)};
    const float4 cuv[2] = {*(const float4*)(csum + cb0 + 32), *(const float4*)(csum + cb0 + 48)};
#pragma unroll
    for (int mi = 0; mi < MI; ++mi) {
      const int tok = m0 + wm * WR + mi * 16 + l16;
      const float mean = st1[2 * tok] * (1.f / 1024.f);
      const float rstd = rsqrtf(st1[2 * tok + 1] * (1.f / 1024.f) - mean * mean + 1e-5f);
      unsigned hw[4];
#pragma unroll
      for (int nj = 0; nj < 2; ++nj) {
        const float4 bg = bgv[nj], bu = buv[nj], cg = cgv[nj], cu = cuv[nj];
        f32x4 g = acc[mi][nj], u = acc[mi][nj + 2];
        float h0, h1, h2, h3, v;
        v = rstd * (g[0] - mean * cg.x) + bg.x; h0 = v * sigmoid_(v) * (rstd * (u[0] - mean * cu.x) + bu.x);
        v = rstd * (g[1] - mean * cg.y) + bg.y; h1 = v * sigmoid_(v) * (rstd * (u[1] - mean * cu.y) + bu.y);
        v = rstd * (g[2] - mean * cg.z) + bg.z; h2 = v * sigmoid_(v) * (rstd * (u[2] - mean * cu.z) + bu.z);
        v = rstd * (g[3] - mean * cg.w) + bg.w; h3 = v * sigmoid_(v) * (rstd * (u[3] - mean * cu.w) + bu.w);
        hw[2 * nj] = pack2(h0, h1); hw[2 * nj + 1] = pack2(h2, h3);
      }
      *(uint4*)((u16*)(ws + O_HBUF) + (long)tok * 2816 + nt * 64 + wn * 32 + lq * 8) = make_uint4(hw[0], hw[1], hw[2], hw[3]);
    }
  }

  if constexpr (PH == PH_DOWN) {
    gemm_mainloop_big<0>(acc, smem, (const u16*)(ws + O_HBUF), 2816, m0, 2816, (const u16*)(ws + O_WT_DOWN), n0, false, tid);
    const float* st1 = (const float*)(ws + O_STATS);
    float* st2 = (float*)(ws + O_STATS) + (long)M_ * 2;
    u16* yb = (u16*)(ws + O_YB);
    unsigned char* swv = smem + wave * 18432;
#pragma unroll
    for (int mi = 0; mi < MI; ++mi) {
      const int tok = m0 + wm * WR + mi * 16 + l16;
      const float mean = st1[2 * tok] * (1.f / 1024.f);
      const float rstd = rsqrtf(st1[2 * tok + 1] * (1.f / 1024.f) - mean * mean + 1e-5f);
      float s1 = 0.f, s2 = 0.f;
#pragma unroll
      for (int nj = 0; nj < 4; ++nj) {
        int col = n0 + wn * 64 + nj * 16 + lq * 4;
        const uint2 yq = *(const uint2*)(yb + (long)tok * 1024 + col);
        const float4 yv = make_float4(bflo(yq.x), bfhi(yq.x), bflo(yq.y), bfhi(yq.y));
        const float4 gg = *(const float4*)(P.ln1_g + col);
        const float4 bb = *(const float4*)(P.ln1_b + col);
        f32x4 a = acc[mi][nj];
        float4 y;
        y.x = ALPHA_ * ((yv.x - mean) * rstd * gg.x + bb.x) + a[0];
        y.y = ALPHA_ * ((yv.y - mean) * rstd * gg.y + bb.y) + a[1];
        y.z = ALPHA_ * ((yv.z - mean) * rstd * gg.z + bb.z) + a[2];
        y.w = ALPHA_ * ((yv.w - mean) * rstd * gg.w + bb.w) + a[3];
        *(uint2*)(swv + (mi * 16 + l16) * 144 + nj * 32 + lq * 8) = make_uint2(pack2(y.x, y.y), pack2(y.z, y.w));
        s1 += y.x + y.y + y.z + y.w;
        s2 += y.x * y.x + y.y * y.y + y.z * y.z + y.w * y.w;
      }
      stat_push(st2, tok, s1, s2, lq);
    }
    asm volatile("s_waitcnt lgkmcnt(0)" ::: "memory");
    {
      u16* ydst = (u16*)(ws + O_YB) + (long)(m0 + wm * WR) * 1024 + n0 + wn * 64;
#pragma unroll
      for (int r = 0; r < 16; ++r) {
        const int row = r * 8 + (lane >> 3), ch = lane & 7;
        const uint4 v = *(const uint4*)(swv + row * 144 + ch * 16);
        *(uint4*)(ydst + (long)row * 1024 + ch * 8) = v;
      }
    }
  }

  if constexpr (PH == PH_PLE) {
    const float* st2 = (const float*)(ws + O_STATS) + (long)M_ * 2;
    float* st3 = (float*)(ws + O_STATS) + (long)M_ * 4;
    u16* yb = (u16*)(ws + O_YB);
    unsigned char* swv = smem + wave * 18432;
    gemm_mainloop_big<0>(acc, smem, (const u16*)(ws + O_YB), 1024, m0, 1024, (const u16*)(ws + O_WT_GATE), n0, false, tid);
    const float* bias = (const float*)(ws + O_BIAS_G);
    uint4* gsp4 = (uint4*)(ws + O_HBUF) + (long)(mt * 8 + nt) * 16 * 256;
    const int cg0 = n0 + wn * 64 + lq * 4;
    const float4 gbv[4] = {*(const float4*)(bias + cg0), *(const float4*)(bias + cg0 + 16), *(const float4*)(bias + cg0 + 32), *(const float4*)(bias + cg0 + 48)};
    const float* csg = (const float*)(ws + O_CSUM_G);
    const float4 gcv[4] = {*(const float4*)(csg + cg0), *(const float4*)(csg + cg0 + 16), *(const float4*)(csg + cg0 + 32), *(const float4*)(csg + cg0 + 48)};
#pragma unroll
    for (int mi = 0; mi < MI; ++mi) {
      const int tok = m0 + wm * WR + mi * 16 + l16;
      const float mean_g = st2[2 * tok] * (1.f / 1024.f);
      const float rstd_g = rsqrtf(st2[2 * tok + 1] * (1.f / 1024.f) - mean_g * mean_g + 1e-5f);
      unsigned gw[8];
#pragma unroll
      for (int nj = 0; nj < 4; ++nj) {
        const float4 bb = gbv[nj], cs = gcv[nj];
        f32x4 a = acc[mi][nj];
        gw[2 * nj] = pack2(sigmoid_(rstd_g * (a[0] - mean_g * cs.x) + bb.x), sigmoid_(rstd_g * (a[1] - mean_g * cs.y) + bb.y));
        gw[2 * nj + 1] = pack2(sigmoid_(rstd_g * (a[2] - mean_g * cs.z) + bb.z), sigmoid_(rstd_g * (a[3] - mean_g * cs.w) + bb.w));
      }
      gsp4[(mi * 2 + 0) * 256 + tid] = make_uint4(gw[0], gw[1], gw[2], gw[3]);
      gsp4[(mi * 2 + 1) * 256 + tid] = make_uint4(gw[4], gw[5], gw[6], gw[7]);
    }
    zero_acc<MI>(acc);
    gemm_mainloop_big<0>(acc, smem, (const u16*)(ws + O_PB), 256, m0, 256, (const u16*)(ws + O_WT_PLE), n0, false, tid);
#pragma unroll
    for (int mi = 0; mi < MI; ++mi) {
      const int tok = m0 + wm * WR + mi * 16 + l16;
      const float mean = st2[2 * tok] * (1.f / 1024.f);
      const float rstd = rsqrtf(st2[2 * tok + 1] * (1.f / 1024.f) - mean * mean + 1e-5f);
      float s1 = 0.f, s2 = 0.f;
      const uint4 gqa = gsp4[(mi * 2 + 0) * 256 + tid], gqb = gsp4[(mi * 2 + 1) * 256 + tid];
#pragma unroll
      for (int nj = 0; nj < 4; ++nj) {
        int col = n0 + wn * 64 + nj * 16 + lq * 4;
        const uint2 yq = *(const uint2*)(yb + (long)tok * 1024 + col);
        const float4 yv = make_float4(bflo(yq.x), bfhi(yq.x), bflo(yq.y), bfhi(yq.y));
        const float4 gg = *(const float4*)(P.ln2_g + col);
        const float4 bb = *(const float4*)(P.ln2_b + col);
        f32x4 a = acc[mi][nj];
        const unsigned g01 = (nj == 0) ? gqa.x : (nj == 1) ? gqa.z : (nj == 2) ? gqb.x : gqb.z;
        const unsigned g23 = (nj == 0) ? gqa.y : (nj == 1) ? gqa.w : (nj == 2) ? gqb.y : gqb.w;
        float4 y;
        y.x = ALPHA_ * ((yv.x - mean) * rstd * gg.x + bb.x) + bflo(g01) * a[0];
        y.y = ALPHA_ * ((yv.y - mean) * rstd * gg.y + bb.y) + bfhi(g01) * a[1];
        y.z = ALPHA_ * ((yv.z - mean) * rstd * gg.z + bb.z) + bflo(g23) * a[2];
        y.w = ALPHA_ * ((yv.w - mean) * rstd * gg.w + bb.w) + bfhi(g23) * a[3];
        *(uint2*)(swv + (mi * 16 + l16) * 144 + nj * 32 + lq * 8) = make_uint2(pack2(y.x, y.y), pack2(y.z, y.w));
        s1 += y.x + y.y + y.z + y.w;
        s2 += y.x * y.x + y.y * y.y + y.z * y.z + y.w * y.w;
      }
      stat_push(st3, tok, s1, s2, lq);
    }
    asm volatile("s_waitcnt lgkmcnt(0)" ::: "memory");
    {
      u16* ydst = (u16*)(ws + O_CONCAT) + (long)(m0 + wm * WR) * 1024 + n0 + wn * 64;
#pragma unroll
      for (int r = 0; r < 16; ++r) {
        const int row = r * 8 + (lane >> 3), ch = lane & 7;
        const uint4 v = *(const uint4*)(swv + row * 144 + ch * 16);
        *(uint4*)(ydst + (long)row * 1024 + ch * 8) = v;
      }
    }
  }
}

constexpr int LDS_TOTAL = 4 * 18432 + 512;
constexpr int CTL_OFF = 53248;
constexpr int SEL_OFF = CTL_OFF + 1024;
constexpr int IMP_OFF = 35840;
static_assert(IMP_OFF + 32 * 130 * 4 <= CTL_OFF, "lds");
static_assert(SEL_OFF + 512 <= LDS_TOTAL, "lds");

struct AttnSrc { const u16* K; long ldk; const u16* K2; const u16* V; long ldv; };
enum { AM_MLA = 0, AM_WIN = 1, AM_SLC = 2, AM_CMP = 3 };

template <int MODE, int DQ, bool DO_PV, bool FIXED_M, bool DO_IMP, bool USE_LIST, int FK = 0>
DI void attn_loop(unsigned char* smem, const AttnSrc src, int ntiles, int tile_lo, const int* tlist,
                  const bf16x8 (&qf)[DQ / 16], float& m, float& l, f32x16 (&O)[2], int t, float slope2,
                  unsigned sw0, unsigned sw1, unsigned sw2, unsigned sw3, float inv_l, unsigned* imp, int tid_in) {
  int tid = tid_in;
  asm volatile("" : "+v"(tid));
  constexpr int KST = DQ + 8;
  constexpr int KCH = DQ / 8;
  constexpr int NKL = KCH * 64 / 256;
  constexpr int KBYTES = 64 * KST * 2;
  constexpr int VST = 68;
  constexpr int VBYTES = 64 * VST * 2;
  const int lane = tid & 63, l32 = lane & 31, h = lane >> 5;
  u16* sK0 = (u16*)smem;
  u16* sV0 = (u16*)(smem + 2 * KBYTES);
  uint4 rk0, rk1, rk2, rv0, rv1;
  const int kr0 = tid / KCH, kc0 = tid % KCH;
  const int kr1 = (tid + 256) / KCH, kc1 = (tid + 256) % KCH;
  const int kr2 = (tid + 512) / KCH, kc2 = (tid + 512) % KCH;
  const int vr0 = tid >> 3, vc0 = tid & 7;
#define A_KLD(dst_, row_, ch_, tile_) { \
    if constexpr (MODE == AM_MLA) { \
      if ((ch_) < 8) dst_ = *(const uint4*)(src.K + ((long)(tile_) * 64 + (row_)) * src.ldk + (ch_) * 8); \
      else dst_ = *(const uint4*)(src.K2 + ((long)(tile_) * 64 + (row_)) * 32 + ((ch_) - 8) * 8); \
    } else dst_ = *(const uint4*)(src.K + ((long)(tile_) * 64 + (row_)) * src.ldk + (ch_) * 8); }
#define A_GLOAD(tile_) { \
    A_KLD(rk0, kr0, kc0, tile_) A_KLD(rk1, kr1, kc1, tile_) \
    if constexpr (NKL == 3) A_KLD(rk2, kr2, kc2, tile_) \
    if constexpr (DO_PV) { \
      rv0 = *(const uint4*)(src.V + (long)vr0 * src.ldv + (long)(tile_) * 64 + vc0 * 8); \
      rv1 = *(const uint4*)(src.V + (long)(vr0 + 32) * src.ldv + (long)(tile_) * 64 + vc0 * 8); } }
#define A_LSTORE(buf_) { \
    u16* sK_ = sK0 + (buf_) * (KBYTES / 2); u16* sV_ = sV0 + (buf_) * (VBYTES / 2); \
    *(uint4*)(sK_ + kr0 * KST + kc0 * 8) = rk0; *(uint4*)(sK_ + kr1 * KST + kc1 * 8) = rk1; \
    if constexpr (NKL == 3) *(uint4*)(sK_ + kr2 * KST + kc2 * 8) = rk2; \
    if constexpr (DO_PV) { \
      *(uint2*)(sV_ + vr0 * VST + vc0 * 8) = make_uint2(rv0.x, rv0.y); *(uint2*)(sV_ + vr0 * VST + vc0 * 8 + 4) = make_uint2(rv0.z, rv0.w); \
      *(uint2*)(sV_ + (vr0 + 32) * VST + vc0 * 8) = make_uint2(rv1.x, rv1.y); *(uint2*)(sV_ + (vr0 + 32) * VST + vc0 * 8 + 4) = make_uint2(rv1.z, rv1.w); } }
  __syncthreads();
  if (ntiles > 0) { const int tf = USE_LIST ? tlist[0] : tile_lo; A_GLOAD(tf) A_LSTORE(0) }
  __syncthreads();
  for (int it = 0; it < ntiles; ++it) {
    const int tile = USE_LIST ? tlist[it] : tile_lo + it;
    if (it + 1 < ntiles && FK != 1) { const int tn = USE_LIST ? tlist[it + 1] : tile_lo + it + 1; A_GLOAD(tn) }
    __builtin_amdgcn_sched_barrier(0);
    const u16* sK = sK0 + (it & 1) * (KBYTES / 2);
    const u16* sV = sV0 + (it & 1) * (VBYTES / 2);
    f32x16 S[2];
#pragma unroll
    for (int kb = 0; kb < 2; ++kb) {
#pragma unroll
      for (int i = 0; i < 16; ++i) S[kb][i] = 0.f;
#pragma unroll
      for (int s = 0; s < DQ / 16; ++s) {
        bf16x8 kf = *(const bf16x8*)(sK + (kb * 32 + l32) * KST + s * 16 + h * 8);
        S[kb] = MFMA32(kf, qf[s], S[kb]);
      }
    }
    float c0 = 0.f;
    {
      constexpr int MUL = (MODE == AM_CMP) ? 16 : 1;
      int d0;
      if constexpr (MODE == AM_CMP) d0 = t - 31 - 16 * (tile * 64 + 4 * h);
      else d0 = t - tile * 64 - 4 * h;
      bool need = true;
      if constexpr (MODE == AM_MLA) need = (tile * 64 + 63 > t - l32);
      bool selbit = true;
      if constexpr (MODE == AM_SLC) {
        const int w = tile >> 5;
        const unsigned swd = (w == 0) ? sw0 : (w == 1) ? sw1 : (w == 2) ? sw2 : sw3;
        selbit = (swd >> (tile & 31)) & 1u;
      }
      bool full = false;
      if constexpr (MODE != AM_MLA) {
        const int tw = t - l32;
        if constexpr (MODE == AM_CMP) full = ((tile * 64 + 63) * 16 + 31 <= tw);
        if constexpr (MODE == AM_WIN) full = (tile * 64 + 63 <= tw) && (tw + 31 - tile * 64 < 512);
        if constexpr (MODE == AM_SLC) full = (tile * 64 + 63 <= tw) && __all(selbit);
      }
      const float fd0 = (float)d0;
      if constexpr (MODE != AM_MLA) {
#pragma unroll
        for (int kb = 0; kb < 2; ++kb)
#pragma unroll
          for (int i = 0; i < 16; ++i) {
            const float ci = (float)(MUL * ((i & 3) + 8 * (i >> 2) + 32 * kb));
            S[kb][i] = fmaf(slope2, ci, S[kb][i]);
          }
      }
      c0 = (MODE != AM_MLA) ? -slope2 * fd0 : 0.f;
      if (need && !full) {
#pragma unroll
        for (int kb = 0; kb < 2; ++kb)
#pragma unroll
          for (int i = 0; i < 16; ++i) {
            const float ci = (float)(MUL * ((i & 3) + 8 * (i >> 2) + 32 * kb));
            const float dist = fd0 - ci;
            bool valid = dist >= 0.f;
            if constexpr (MODE == AM_WIN) valid = valid && (dist < 512.f);
            if constexpr (MODE == AM_SLC) valid = valid && selbit;
            S[kb][i] = valid ? S[kb][i] : -INFINITY;
          }
      }
    }
    if constexpr (FK != 2) {
    if constexpr (!FIXED_M) {
      float tmax = -INFINITY;
#pragma unroll
      for (int kb = 0; kb < 2; ++kb)
#pragma unroll
        for (int i = 0; i < 16; ++i) tmax = fmaxf(tmax, S[kb][i]);
      tmax += c0;
      tmax = fmaxf(tmax, __shfl_xor(tmax, 32));
      const bool need = tmax > m + 8.f;
      if (__any(need)) {
        const float mnew = need ? tmax : m;
        const float alpha = ex2(m - mnew);
        m = mnew;
        l *= alpha;
        if constexpr (DO_PV) {
#pragma unroll
          for (int db = 0; db < 2; ++db)
#pragma unroll
            for (int i = 0; i < 16; ++i) O[db][i] *= alpha;
        }
      }
    }
    const float mx = m - c0;
    {
      float ps = 0.f;
#pragma unroll
      for (int kb = 0; kb < 2; ++kb)
#pragma unroll
        for (int i = 0; i < 16; ++i) { float p = ex2(S[kb][i] - mx); S[kb][i] = p; ps += p; }
      l += ps;
    }
    }
    if constexpr (DO_IMP) {
#pragma unroll
      for (int kb = 0; kb < 2; ++kb)
#pragma unroll
        for (int a = 0; a < 4; ++a) {
          const float p0 = S[kb][4 * a] * inv_l, p1 = S[kb][4 * a + 1] * inv_l, p2 = S[kb][4 * a + 2] * inv_l, p3 = S[kb][4 * a + 3] * inv_l;
          const float mainv = 2.f * (p0 + p1 + p2) + p3;
          const int n = tile * 16 + kb * 8 + 2 * a + h;
          atomicAdd(imp + l32 * 130 + n, (unsigned)(mainv * 268435456.f));
          atomicAdd(imp + l32 * 130 + n + 1, (unsigned)(p3 * 268435456.f));
        }
    }
    if (it + 1 < ntiles) { A_LSTORE((it + 1) & 1) }
    if constexpr (DO_PV) {
#pragma unroll
      for (int sp = 0; sp < 4; ++sp) {
        const int kb = sp >> 1, hf = sp & 1;
        unsigned w0 = pack2(S[kb][8 * hf + 0], S[kb][8 * hf + 1]);
        unsigned w1 = pack2(S[kb][8 * hf + 2], S[kb][8 * hf + 3]);
        unsigned w2 = pack2(S[kb][8 * hf + 4], S[kb][8 * hf + 5]);
        unsigned w3 = pack2(S[kb][8 * hf + 6], S[kb][8 * hf + 7]);
        uint4 pw = make_uint4(w0, w1, w2, w3);
        bf16x8 pf = __builtin_bit_cast(bf16x8, pw);
#pragma unroll
        for (int db = 0; db < 2; ++db) {
          const u16* vp = sV + (db * 32 + l32) * VST + 16 * sp + 4 * h;
          s16x4 lo = *(const s16x4*)vp;
          s16x4 hi = *(const s16x4*)(vp + 8);
          bf16x8 vf = __builtin_shufflevector(lo, hi, 0, 1, 2, 3, 4, 5, 6, 7);
          O[db] = MFMA32(vf, pf, O[db]);
        }
      }
    }
    __syncthreads();
  }
  l += __shfl_xor(l, 32);
#undef A_KLD
#undef A_GLOAD
#undef A_LSTORE
}

DI void zero_o(f32x16 (&O)[2]) {
#pragma unroll
  for (int db = 0; db < 2; ++db)
#pragma unroll
    for (int i = 0; i < 16; ++i) O[db][i] = 0.f;
}

template <int FK = 0>
DI void mla_item(const Params& P, unsigned char* smem, int b, int hh, int qt, int tid_in) {
  int tid = tid_in;
  asm volatile("" : "+v"(tid));
  unsigned char* ws = P.ws;
  const int lane = tid & 63, w = tid >> 6, l32 = lane & 31, h = lane >> 5;
  const int t = qt * 128 + w * 32 + l32;
  const long tok = (long)b * T_ + t;
  bf16x8 qf[6];
#pragma unroll
  for (int s = 0; s < 6; ++s) qf[s] = *(const bf16x8*)((const u16*)(ws + O_QM) + tok * 768 + hh * 96 + s * 16 + h * 8);
  float m = -1e30f, l = 0.f;
  f32x16 O[2];
  zero_o(O);
  AttnSrc src;
  src.K = (const u16*)(ws + O_KN) + (long)b * T_ * 512 + hh * 64; src.ldk = 512;
  src.K2 = (const u16*)(ws + O_KPE) + (long)b * T_ * 32;
  src.V = (const u16*)(ws + O_VMT) + ((long)(b * 8 + hh) * 64) * T_; src.ldv = T_;
  attn_loop<AM_MLA, 96, true, false, false, false, FK>(smem, src, 2 * qt + 2, 0, nullptr, qf, m, l, O, t, 0.f, 0, 0, 0, 0, 0.f, nullptr, tid);
  if (FK != 0 && O[0][0] + O[1][5] + l != 123456.75f) return;
  const float lt = l;
  const float inv = lt > 0.f ? 1.f / lt : 0.f;
  unsigned char* swo = smem + w * 4608;
#pragma unroll
  for (int db = 0; db < 2; ++db)
#pragma unroll
    for (int a = 0; a < 4; ++a)
      *(uint2*)(swo + l32 * 144 + (db * 32 + 8 * a + 4 * h) * 2) = make_uint2(pack2(O[db][4 * a] * inv, O[db][4 * a + 1] * inv), pack2(O[db][4 * a + 2] * inv, O[db][4 * a + 3] * inv));
  asm volatile("s_waitcnt lgkmcnt(0)" ::: "memory");
  {
    u16* dst = (u16*)(ws + O_CONCAT) + ((long)b * T_ + qt * 128 + w * 32) * 1024 + 512 + hh * 64;
#pragma unroll
    for (int r = 0; r < 4; ++r) {
      const int row = r * 8 + (lane >> 3), ch = lane & 7;
      *(uint4*)(dst + (long)row * 1024 + ch * 8) = *(const uint4*)(swo + row * 144 + ch * 16);
    }
  }
}

DI u64 mk_key(int n, unsigned v, int cur) {
  if (n > cur) return 0ull;
  if (n == 0 || n == cur || n == cur - 1) v = 0xFFFFFFFFu;
  return ((u64)v << 8) | (u64)(128 - n);
}

DI void nsa_item(const Params& P, unsigned char* smem, int b, int g, int tt, int tid_in) {
  int tid = tid_in;
  asm volatile("" : "+v"(tid));
  unsigned char* ws = P.ws;
  const int lane = tid & 63, w = tid >> 6, l32 = lane & 31, h = lane >> 5;
  const int t0 = tt * 32;
  const int t = t0 + l32;
  const long tok = (long)b * T_ + t;
  const int head8 = g * 4 + w;
  int* ctl = (int*)(smem + CTL_OFF);
  unsigned* sel = (unsigned*)(smem + SEL_OFF);
  unsigned* imp = (unsigned*)(smem + IMP_OFF);
  bf16x8 qf[4];
#pragma unroll
  for (int s = 0; s < 4; ++s) qf[s] = *(const bf16x8*)((const u16*)(ws + O_QN) + tok * 512 + head8 * 64 + s * 16 + h * 8);
  const float* gp = (const float*)(ws + O_GATES) + tok * 24 + head8 * 3;
  const float g0 = gp[0], g1 = gp[1], g2 = gp[2];
  const float slope2 = LOG2E_ * exp2f(-(float)(head8 + 1));
  __syncthreads();
  for (int i = tid; i < 32 * 130; i += 256) imp[i] = 0u;
  if (tid < 4) ctl[4 + tid] = 0;
  f32x16 O[2];
  float m = -1e30f, l = 0.f;
  float* osp = (float*)(ws + O_Y2) + (long)blockIdx.x * 16384 + tid;
  AttnSrc sc;
  sc.K = (const u16*)(ws + O_CMPK) + ((long)(b * 2 + g) * 512) * 64; sc.ldk = 64; sc.K2 = nullptr;
  sc.V = (const u16*)(ws + O_CMPVT) + ((long)(b * 2 + g) * 64) * 512; sc.ldv = 512;
  const int ntc = (t0 >> 10) + 1;
  attn_loop<AM_CMP, 64, false, false, false, false>(smem, sc, ntc, 0, nullptr, qf, m, l, O, t, slope2, 0, 0, 0, 0, 0.f, nullptr, tid);
  {
    const float lt = l;
    const float inv_l = lt > 0.f ? 1.f / lt : 0.f;
    zero_o(O);
    float l2 = 0.f;
    attn_loop<AM_CMP, 64, true, true, true, false>(smem, sc, ntc, 0, nullptr, qf, m, l2, O, t, slope2, 0, 0, 0, 0, inv_l, imp, tid);
    const float sc0 = g0 * inv_l;
#pragma unroll
    for (int db = 0; db < 2; ++db)
#pragma unroll
      for (int i = 0; i < 16; ++i) osp[(db * 16 + i) * 256] = O[db][i] * sc0;
  }
  for (int tk = 0; tk < 8; ++tk) {
    const int token = w * 8 + tk;
    const int cur = (t0 + token) >> 6;
    const u64 k0 = mk_key(lane, imp[token * 130 + lane], cur);
    const u64 k1 = mk_key(lane + 64, imp[token * 130 + lane + 64], cur);
    u64 thr = 0ull;
    for (int bit = 39; bit >= 0; --bit) {
      const u64 cand = thr | (1ull << bit);
      const int c = __popcll(__ballot(k0 >= cand)) + __popcll(__ballot(k1 >= cand));
      if (c >= 16) thr = cand;
    }
    const u64 m0 = __ballot(k0 >= thr && k0 > 0ull);
    const u64 m1 = __ballot(k1 >= thr && k1 > 0ull);
    if (lane == 0) {
      sel[token * 4 + 0] = (unsigned)m0; sel[token * 4 + 1] = (unsigned)(m0 >> 32);
      sel[token * 4 + 2] = (unsigned)m1; sel[token * 4 + 3] = (unsigned)(m1 >> 32);
      atomicOr((unsigned*)&ctl[4], (unsigned)m0); atomicOr((unsigned*)&ctl[5], (unsigned)(m0 >> 32));
      atomicOr((unsigned*)&ctl[6], (unsigned)m1); atomicOr((unsigned*)&ctl[7], (unsigned)(m1 >> 32));
    }
  }
  __syncthreads();
  if (tid == 0) {
    int c = 0;
    for (int q = 0; q < 4; ++q) {
      unsigned u = (unsigned)ctl[4 + q];
      while (u) { int bp = __ffs(u) - 1; ctl[8 + c] = q * 32 + bp; ++c; u &= u - 1; }
    }
    ctl[1] = c;
  }
  __syncthreads();
  const int nsl = ctl[1];
  const unsigned sw0 = sel[l32 * 4 + 0], sw1 = sel[l32 * 4 + 1], sw2 = sel[l32 * 4 + 2], sw3 = sel[l32 * 4 + 3];
  {
    AttnSrc ss;
    ss.K = (const u16*)(ws + O_KS) + (long)b * T_ * 128 + g * 64; ss.ldk = 128; ss.K2 = nullptr;
    ss.V = (const u16*)(ws + O_VST) + ((long)(b * 2 + g) * 64) * T_; ss.ldv = T_;
    m = -1e30f; l = 0.f; zero_o(O);
    attn_loop<AM_SLC, 64, true, false, false, true>(smem, ss, nsl, 0, ctl + 8, qf, m, l, O, t, slope2, sw0, sw1, sw2, sw3, 0.f, nullptr, tid);
    const float lt = l;
    const float sc1 = lt > 0.f ? g1 / lt : 0.f;
#pragma unroll
    for (int db = 0; db < 2; ++db)
#pragma unroll
      for (int i = 0; i < 16; ++i) osp[8192 + (db * 16 + i) * 256] = O[db][i] * sc1;
  }
  {
    AttnSrc sw;
    sw.K = (const u16*)(ws + O_KW) + (long)b * T_ * 128 + g * 64; sw.ldk = 128; sw.K2 = nullptr;
    sw.V = (const u16*)(ws + O_VWT) + ((long)(b * 2 + g) * 64) * T_; sw.ldv = T_;
    const int lo = (t0 > 511 ? (t0 - 511) : 0) >> 6, hi = (t0 + 31) >> 6;
    m = -1e30f; l = 0.f; zero_o(O);
    attn_loop<AM_WIN, 64, true, false, false, false>(smem, sw, hi - lo + 1, lo, nullptr, qf, m, l, O, t, slope2, 0, 0, 0, 0, 0.f, nullptr, tid);
    const float lt = l;
    const float sc2 = lt > 0.f ? g2 / lt : 0.f;
#pragma unroll
    for (int db = 0; db < 2; ++db)
#pragma unroll
      for (int i = 0; i < 16; ++i) O[db][i] = O[db][i] * sc2 + osp[(db * 16 + i) * 256] + osp[8192 + (db * 16 + i) * 256];
  }
  unsigned char* swo = smem + w * 4608;
#pragma unroll
  for (int db = 0; db < 2; ++db)
#pragma unroll
    for (int a = 0; a < 4; ++a)
      *(uint2*)(swo + l32 * 144 + (db * 32 + 8 * a + 4 * h) * 2) = make_uint2(pack2(O[db][4 * a], O[db][4 * a + 1]), pack2(O[db][4 * a + 2], O[db][4 * a + 3]));
  asm volatile("s_waitcnt lgkmcnt(0)" ::: "memory");
  {
    u16* dst = (u16*)(ws + O_CONCAT) + ((long)b * T_ + t0) * 1024 + head8 * 64;
#pragma unroll
    for (int r = 0; r < 4; ++r) {
      const int row = r * 8 + (lane >> 3), ch = lane & 7;
      *(uint4*)(dst + (long)row * 1024 + ch * 8) = *(const uint4*)(swo + row * 144 + ch * 16);
    }
  }
}

DI void ln_apply_pass(const u16* src, const float* st, u16* dst, int tid, int nb) {
  const int lane = tid & 63;
  for (int row = blockIdx.x * 4 + (tid >> 6); row < M_; row += nb * 4) {
    const float mean = st[2 * row] * (1.f / 1024.f);
    const float rstd = rsqrtf(st[2 * row + 1] * (1.f / 1024.f) - mean * mean + 1e-5f);
    const u16* o = src + (long)row * 1024;
#pragma unroll
    for (int i = 0; i < 2; ++i) {
      const int c = lane * 8 + 512 * i;
      const uint4 v = *(const uint4*)(o + c);
      *(uint4*)(dst + (long)row * 1024 + c) = make_uint4(pack2((bflo(v.x) - mean) * rstd, (bfhi(v.x) - mean) * rstd), pack2((bflo(v.y) - mean) * rstd, (bfhi(v.y) - mean) * rstd),
                                                        pack2((bflo(v.z) - mean) * rstd, (bfhi(v.z) - mean) * rstd), pack2((bflo(v.w) - mean) * rstd, (bfhi(v.w) - mean) * rstd));
    }
  }
}

#ifndef REP
#define REP 0
#endif
#ifndef FAKEV
#define FAKEV 0
#endif
DI void tile_map(int i, int NT, int& mt, int& nt, int mpx = 64) {
  const int xcd = i & 7, j = i >> 3;
  const int ms = j / (8 * NT), r = j - ms * 8 * NT;
  nt = r >> 3;
  mt = xcd * mpx + ms * 8 + (r & 7);
}

template <int PMODE = 0, int FK = 0>
DI void phase4(const Params& P, unsigned char* smem, int tid, int cbase) {
  {
    int* ctr = (int*)(P.ws + O_CTR) + cbase;
    int* ctl = (int*)(smem + CTL_OFF);
    const int xcd = blockIdx.x & 7;
    bool mla_done = false;
    for (;;) {
      __syncthreads();
      if (tid == 0) {
        int it = -1;
        if (!mla_done) { int k = atomicAdd(ctr + xcd, 1); if (k < 512) it = k; }
        if (it < 0) { if (PMODE == 1) it = 8192; else { int j = atomicAdd(ctr + 8, 1); it = (j < 4096) ? 4096 + j : 8192; } }
        ctl[0] = it;
      }
      __syncthreads();
      const int item = ctl[0];
      if (item >= 8192) break;
#ifndef SKIP_MLA
      if (item < 4096) {
        const int qt = 63 - (item & 63), bh = (item >> 6) * 8 + xcd;
        mla_item<FK>(P, smem, bh >> 3, bh & 7, qt, tid);
      }
#endif
      if (item >= 4096) mla_done = true;
#ifndef SKIP_NSA
      if (item >= 4096) {
        const int j = item - 4096;
        const int tt = 255 - (j >> 4), bg = j & 15;
        nsa_item(P, smem, bg >> 1, bg & 1, tt, tid);
      }
#endif
    }
  }
}

#define XB_XCNT(j)  (64 * (j))
#define XB_XSUB(j)  (1024 + 64 * (j))
#define XB_XGEN(j)  (2048 + 64 * (j))
#define XB_TOP      3072
#define XB_TOPGEN   3136
#define XB_WORDS    3200
DI unsigned xb_ld(unsigned* p) { return __hip_atomic_load(p, __ATOMIC_RELAXED, __HIP_MEMORY_SCOPE_AGENT); }
DI unsigned xb_add(unsigned* p, unsigned v) { return __hip_atomic_fetch_add(p, v, __ATOMIC_RELAXED, __HIP_MEMORY_SCOPE_AGENT); }
DI unsigned xb_xcc_id() { return (unsigned)__builtin_amdgcn_s_getreg((3 << 11) | 20) & 0xFu; }
struct XBar { unsigned* bar; unsigned x, nloc, nx; };
DI void gsync(const XBar& b, int tid) {
  asm volatile("s_waitcnt vmcnt(0)" ::: "memory");
  __syncthreads();
  if (tid == 0) {
    unsigned* bar = b.bar;
    __builtin_amdgcn_s_waitcnt(0);
    const unsigned old = xb_add(&bar[XB_XSUB(b.x)], 1u);
    const unsigned gen = old / b.nloc;
    if (old + 1u == (gen + 1u) * b.nloc) {
      __builtin_amdgcn_fence(__ATOMIC_RELEASE, "agent");
      asm volatile("s_waitcnt vmcnt(0)" ::: "memory");
      const unsigned og = xb_add(&bar[XB_TOP], 1u);
      const unsigned tg = og / b.nx;
      if (og + 1u == (tg + 1u) * b.nx) xb_add(&bar[XB_TOPGEN], 1u);
      else while (xb_ld(&bar[XB_TOPGEN]) == tg) __builtin_amdgcn_s_sleep(1);
      __builtin_amdgcn_fence(__ATOMIC_ACQUIRE, "agent");
      xb_add(&bar[XB_XGEN(b.x)], 1u);
      asm volatile("s_waitcnt vmcnt(0)" ::: "memory");
    } else {
      while (xb_ld(&bar[XB_XGEN(b.x)]) == gen) __builtin_amdgcn_s_sleep(1);
      __builtin_amdgcn_fence(__ATOMIC_ACQUIRE, "agent");
      asm volatile("s_waitcnt vmcnt(0)" ::: "memory");
    }
  }
  __syncthreads();
}

__global__ void __launch_bounds__(256, 2) fwd_megakernel(Params P) {
  cg::grid_group grid = cg::this_grid();
  extern __shared__ __attribute__((aligned(16))) unsigned char smem[];
  const int tid = threadIdx.x;
  const int nb = gridDim.x;
  XBar xb; xb.bar = (unsigned*)(P.ws + O_BAR); xb.x = xb_xcc_id(); xb.nloc = 1u; xb.nx = 1u;
  if (tid == 0) (void)xb_add(&xb.bar[XB_XCNT(xb.x)], 1u);

#ifndef SKIP_P0
  phase0(P, smem, tid);
#endif
  if (P.ws == nullptr) grid.sync();
  if (tid == 0) {
    unsigned mine = 0u, cnt = 0u, sum = 0u;
    for (;;) {
      mine = 0u; cnt = 0u; sum = 0u;
#pragma unroll
      for (unsigned j = 0; j < 16; ++j) { const unsigned c = xb_ld(&xb.bar[XB_XCNT(j)]); sum += c; cnt += (c > 0u) ? 1u : 0u; mine = (j == xb.x) ? c : mine; }
      if (sum == gridDim.x) break;
      __builtin_amdgcn_s_sleep(1);
    }
    xb.nloc = mine > 0u ? mine : 1u; xb.nx = cnt > 0u ? cnt : 1u;
  }
  gsync(xb, tid);
#ifndef SKIP_P1
  for (int i = blockIdx.x; i < 512 * 14; i += nb) { int mt, nt; tile_map(i, 14, mt, nt); gemm_tile<PH_IN>(P, smem, mt, nt, 0, tid); }
#if REP == 11
  for (int q = 0; q < 20; ++q) gsync(xb, tid);
#endif
#if REP == 1
  gsync(xb, tid);
  for (int i = blockIdx.x; i < 512 * 14; i += nb) { int mt, nt; tile_map(i, 14, mt, nt); gemm_tile<PH_IN>(P, smem, mt, nt, 0, tid); }
#endif
#endif
  gsync(xb, tid);
#ifndef SKIP_P2
  for (int i = blockIdx.x; i < 256 + 3072 + 4096; i += nb) {
    if (i < 256) gemm_tile<PH_C1>(P, smem, (i >> 1) & 63, i & 1, i >> 7, tid);
    else if (i < 256 + 3072) { int mt, nt; tile_map(i - 256, 6, mt, nt); gemm_tile<PH_UQ>(P, smem, mt, nt, 0, tid); }
    else { int mt, nt; tile_map(i - 256 - 3072, 8, mt, nt); gemm_tile<PH_UKV>(P, smem, mt, nt, 0, tid); }
  }
#endif
#if REP == 2
  gsync(xb, tid);
  for (int i = blockIdx.x; i < 256 + 3072 + 4096; i += nb) {
    if (i < 256) gemm_tile<PH_C1>(P, smem, (i >> 1) & 63, i & 1, i >> 7, tid);
    else if (i < 256 + 3072) { int mt, nt; tile_map(i - 256, 6, mt, nt); gemm_tile<PH_UQ>(P, smem, mt, nt, 0, tid); }
    else { int mt, nt; tile_map(i - 256 - 3072, 8, mt, nt); gemm_tile<PH_UKV>(P, smem, mt, nt, 0, tid); }
  }
#endif
  gsync(xb, tid);
#ifndef SKIP_P3
  for (int i = blockIdx.x; i < 128; i += nb) gemm_tile<PH_C2>(P, smem, i & 63, 0, i >> 6, tid);
#endif
  gsync(xb, tid);
  phase4(P, smem, tid, 0);
#if REP == 4
  gsync(xb, tid);
  phase4<0, 0>(P, smem, tid, 16);
#endif
#if REP == 41
  gsync(xb, tid);
  phase4<1, FAKEV>(P, smem, tid, 16);
#endif
  gsync(xb, tid);
  {
    u16* pb = (u16*)(P.ws + O_PB);
    for (long i = (long)blockIdx.x * 256 + tid; i < (long)M_ * 256 / 8; i += (long)nb * 256) {
      const float4 a = *(const float4*)(P.p + i * 8), b = *(const float4*)(P.p + i * 8 + 4);
      *(uint4*)(pb + i * 8) = make_uint4(pack2(a.x, a.y), pack2(a.z, a.w), pack2(b.x, b.y), pack2(b.z, b.w));
    }
  }
#ifndef SKIP_P5
  for (int i = blockIdx.x; i < 256 * 8; i += nb) { int mt, nt; tile_map(i, 8, mt, nt, 32); gemm_tile<PH_OUT>(P, smem, mt, nt, 0, tid); }
#endif
  gsync(xb, tid);
#ifndef SKIP_P6
  for (int i = blockIdx.x; i < 256 * 44; i += nb) { int mt, nt; tile_map(i, 44, mt, nt, 32); gemm_tile<PH_UP>(P, smem, mt, nt, 0, tid); }
#if REP == 6
  gsync(xb, tid);
  for (int i = blockIdx.x; i < 256 * 44; i += nb) { int mt, nt; tile_map(i, 44, mt, nt, 32); gemm_tile<PH_UP, FAKEV>(P, smem, mt, nt, 0, tid); }
#endif
#endif
  gsync(xb, tid);
#ifndef SKIP_P7
  for (int i = blockIdx.x; i < 256 * 8; i += nb) { int mt, nt; tile_map(i, 8, mt, nt, 32); gemm_tile<PH_DOWN>(P, smem, mt, nt, 0, tid); }
#endif
  gsync(xb, tid);
#ifndef SKIP_P8
  for (int i = blockIdx.x; i < 256 * 8; i += nb) { int mt, nt; tile_map(i, 8, mt, nt, 32); gemm_tile<PH_PLE>(P, smem, mt, nt, 0, tid); }
#endif
  gsync(xb, tid);
  {
    const float* st3 = (const float*)(P.ws + O_STATS) + (long)M_ * 4;
    const int lane = tid & 63;
    for (int row = blockIdx.x * 4 + (tid >> 6); row < M_; row += nb * 4) {
      const float mean = st3[2 * row] * (1.f / 1024.f);
      const float rstd = rsqrtf(st3[2 * row + 1] * (1.f / 1024.f) - mean * mean + 1e-5f);
      float* o = P.out + (long)row * 1024;
      const u16* yb = (const u16*)(P.ws + O_CONCAT) + (long)row * 1024;
#pragma unroll
      for (int i = 0; i < 4; ++i) {
        const int c = lane * 4 + 256 * i;
        const uint2 yq = *(const uint2*)(yb + c);
        float4 v = make_float4(bflo(yq.x), bfhi(yq.x), bflo(yq.y), bfhi(yq.y));
        const float4 gg = *(const float4*)(P.ln3_g + c);
        const float4 bb = *(const float4*)(P.ln3_b + c);
        v.x = (v.x - mean) * rstd * gg.x + bb.x;
        v.y = (v.y - mean) * rstd * gg.y + bb.y;
        v.z = (v.z - mean) * rstd * gg.z + bb.z;
        v.w = (v.w - mean) * rstd * gg.w + bb.w;
        *(float4*)(o + c) = v;
      }
    }
  }
}

extern "C" void kernel_launch(void* const* d_in, const int* in_sizes, int n_in,
                              void* d_out, int out_size, void* d_ws, size_t ws_size,
                              hipStream_t stream) {
  static int grid_blocks = 0;
  if (!grid_blocks) {
    int dev = 0, cus = 0, per_cu = 0;
    (void)hipGetDevice(&dev);
    (void)hipDeviceGetAttribute(&cus, hipDeviceAttributeMultiprocessorCount, dev);
    (void)hipFuncSetAttribute((const void*)fwd_megakernel, hipFuncAttributeMaxDynamicSharedMemorySize, LDS_TOTAL);
    (void)hipOccupancyMaxActiveBlocksPerMultiprocessor(&per_cu, fwd_megakernel, 256, LDS_TOTAL);
    if (per_cu < 1) per_cu = 1;
    if (per_cu > 2) per_cu = 2;
    grid_blocks = cus * per_cu;
    fprintf(stderr, "grid_blocks=%d (cus=%d per_cu=%d) ws_need=%zu ws_size=%zu\n", grid_blocks, cus, per_cu, (size_t)WS_NEED, ws_size);
  }
  if (ws_size < WS_NEED || n_in < 24) { fprintf(stderr, "kernel_launch: workspace too small or bad inputs\n"); return; }
  (void)hipMemsetAsync((unsigned char*)d_ws + O_BAR, 0, 16384, stream);
  Params p{};
  const float** pp = (const float**)&p;
  for (int i = 0; i < 24; ++i) pp[i] = (const float*)d_in[i];
  p.out = (float*)d_out;
  p.ws = (unsigned char*)d_ws;
  void* args[] = {&p};
  hipError_t e = hipLaunchCooperativeKernel((void*)fwd_megakernel, dim3(grid_blocks), dim3(256), args, LDS_TOTAL, stream);
  if (e != hipSuccess) fprintf(stderr, "cooperative launch failed: %s (grid %d)\n", hipGetErrorString(e), grid_blocks);
}
```
